# Optimizing an MI355X kernel written in HIP

```python
import math
import jax
import jax.numpy as jnp
from jax import lax
import numpy as np

D_MODEL = 2048
BATCH = 1
SEQ = 16384
DEPTH = 1

CTX_LEN = 256
GRID_W = 64
N_MOD = 9
D_FF = 5632
RET_HEADS = 8
RET_DK = 128
RET_DV = 256
RET_CHUNK = 128
RET_Q = RET_HEADS * RET_DK
RET_V = RET_HEADS * RET_DV
HY_WIDTH = 2048
HY_BANDS = 16
HY_EMB = 1 + 2 * HY_BANDS
HY_FF = 64
HY_MIN_DECAY = math.log(1e-2) / 0.3
HY_MAX_DECAY = math.log(1e-2) / 1.5
ROPE_BASE = 10000.0
EPS = 1e-6

Q_OFF = 0
K_OFF = Q_OFF + RET_Q
V_OFF = K_OFF + RET_Q
G_OFF = V_OFF + RET_V
HY_OFF = G_OFF + RET_V
GATE_OFF = HY_OFF + 3 * HY_WIDTH
IN_COLS = GATE_OFF + 2 * D_MODEL

kernel_name = 'hybrid_retention_hyena_dit_block'


def rmsnorm(x, g):
    xf = x.astype(jnp.float32)
    y = xf * lax.rsqrt(jnp.mean(xf * xf, axis=-1, keepdims=True) + EPS)
    return (y * g.astype(jnp.float32)).astype(x.dtype)


def modulate(h, shift, scale):
    return h * (1.0 + scale) + shift


def adaln_mods(cvec, w, b):
    m = jax.nn.silu(cvec) @ w + b
    return m.reshape(-1, 1, N_MOD, D_MODEL)


def swiglu(h, w_up, w_down):
    a, g = jnp.split(h @ w_up, 2, axis=-1)
    return (jax.nn.silu(a) * g) @ w_down


def ffn_half(x, mods, slot, g, w_up, w_down):
    h = modulate(rmsnorm(x, g), mods[:, :, 3 * slot], mods[:, :, 3 * slot + 1])
    return x + 0.5 * mods[:, :, 3 * slot + 2] * swiglu(h, w_up, w_down)


def rope_angles(pos, dim):
    inv = ROPE_BASE ** (-jnp.arange(0, dim, 2, dtype=jnp.float32) / dim)
    return pos.astype(jnp.float32)[:, None] * inv[None, :]


def apply_rope(x, ang):
    x1, x2 = jnp.split(x, 2, axis=-1)
    cos = jnp.cos(ang).astype(x.dtype)
    sin = jnp.sin(ang).astype(x.dtype)
    return jnp.concatenate([x1 * cos - x2 * sin, x1 * sin + x2 * cos], axis=-1)


def rope_2d(x, row, col):
    half = x.shape[-1] // 2
    xr, xc = jnp.split(x, 2, axis=-1)
    return jnp.concatenate([apply_rope(xr, rope_angles(row, half)),
                            apply_rope(xc, rope_angles(col, half))], axis=-1)


def split_heads(a, d):
    b, t, _ = a.shape
    return a.reshape(b, t, RET_HEADS, d).transpose(0, 2, 1, 3)


def retention_scan(q, k, v, log_gamma, state0):
    b, h, t, dk = q.shape
    dv = v.shape[-1]
    n = t // RET_CHUNK
    qc = q.reshape(b, h, n, RET_CHUNK, dk)
    kc = k.reshape(b, h, n, RET_CHUNK, dk)
    vc = v.reshape(b, h, n, RET_CHUNK, dv)
    lg = log_gamma.astype(jnp.float32)[:, None]
    idx = jnp.arange(RET_CHUNK, dtype=jnp.float32)
    diff = idx[:, None] - idx[None, :]
    decay = jnp.where(diff >= 0, jnp.exp(lg[:, :, None] * jnp.maximum(diff, 0.0)), 0.0)
    xi = jnp.exp(lg * (idx + 1.0))
    zeta = jnp.exp(lg * (RET_CHUNK - 1.0 - idx))
    chunk_decay = jnp.exp(lg * RET_CHUNK)[None, :, :, None]
    scores = jnp.einsum('bhnqd,bhnkd->bhnqk', qc, kc) * decay[None, :, None]
    inner = jnp.einsum('bhnqk,bhnkv->bhnqv', scores, vc)
    kv = jnp.einsum('bhnkd,hk,bhnkv->nbhdv', kc, zeta, vc)

    def step(state, kv_i):
        return state * chunk_decay + kv_i, state

    final, prev = lax.scan(step, state0, kv)
    cross = jnp.einsum('bhnqd,nbhdv,hq->bhnqv', qc, prev, xi)
    return (inner + cross).reshape(b, h, t, dv), final


def context_states(pkv, log_gamma):
    k = split_heads(pkv[..., :RET_Q], RET_DK)
    v = split_heads(pkv[..., RET_Q:], RET_DV)
    lc = k.shape[2]
    m = jnp.arange(lc, dtype=jnp.float32)
    lg = log_gamma.astype(jnp.float32)[:, :, None]
    w_f = jnp.exp(lg[0] * (lc - 1.0 - m))
    w_b = jnp.exp(lg[1] * m)
    s_f = jnp.einsum('bhtd,ht,bhtv->bhdv', k, w_f, v)
    s_b = jnp.einsum('bhtd,ht,bhtv->bhdv', k, w_b, v)
    return s_f, s_b


def head_group_norm(y, g, b):
    y = y.astype(jnp.float32)
    mu = jnp.mean(y, axis=-1, keepdims=True)
    var = jnp.mean(jnp.square(y - mu), axis=-1, keepdims=True)
    yn = (y - mu) * lax.rsqrt(var + EPS)
    bsz, h, t, dv = y.shape
    yn = yn.transpose(0, 2, 1, 3).reshape(bsz, t, h * dv)
    return yn * g + b


def retention_mix(p, row, col, log_gamma, st_f, st_b, gn_g, gn_b, w_o):
    q = split_heads(p[..., Q_OFF:K_OFF], RET_DK) * (RET_DK ** -0.5)
    k = split_heads(p[..., K_OFF:V_OFF], RET_DK)
    v = split_heads(p[..., V_OFF:G_OFF], RET_DV)
    if row is not None:
        q = rope_2d(q, row, col)
        k = rope_2d(k, row, col)
    y_f, fin_f = retention_scan(q, k, v, log_gamma[0], st_f)
    y_b, fin_b = retention_scan(jnp.flip(q, 2), jnp.flip(k, 2), jnp.flip(v, 2), log_gamma[1], st_b)
    y = head_group_norm(y_f + jnp.flip(y_b, 2), gn_g, gn_b).astype(p.dtype)
    y = jax.nn.silu(p[..., G_OFF:HY_OFF]) * y
    return y @ w_o, fin_f, fin_b


def short_conv3(u, w, b):
    up = jnp.pad(u, ((0, 0), (1, 1), (0, 0)))
    return up[:, :-2] * w[0] + up[:, 1:-1] * w[1] + up[:, 2:] * w[2] + b


def hyena_filter(length, w1, b1, w2, b2, w3, b3, w4, freq, decay_rate):
    f32 = jnp.float32
    t = jnp.linspace(0.0, 1.0, length, dtype=f32)[:, None]
    w = 2.0 * math.pi * jnp.arange(length, dtype=f32)[:, None] / length
    f = jnp.linspace(1e-4, HY_BANDS - 1.0, HY_BANDS, dtype=f32)[None, :]
    feat = jnp.concatenate([t, jnp.cos(f * w), -jnp.sin(f * w)], axis=-1)
    freq = freq.astype(f32)
    h = jnp.sin(freq * (feat @ w1.astype(f32) + b1.astype(f32)))
    h = jnp.sin(freq * (h @ w2.astype(f32) + b2.astype(f32)))
    h = jnp.sin(freq * (h @ w3.astype(f32) + b3.astype(f32)))
    taps = h @ w4.astype(f32)
    window = jnp.exp(-t * jnp.abs(decay_rate.astype(f32))[None, :])
    h_fwd, h_bwd = jnp.split(taps, 2, axis=-1)
    h_fwd = h_fwd * window
    h_bwd = h_bwd * window
    kern = jnp.concatenate([h_fwd, jnp.zeros_like(h_fwd[:1]), jnp.flip(h_bwd[1:], 0)], axis=0)
    return kern * lax.rsqrt(jnp.sum(kern * kern, axis=0, keepdims=True) + EPS)


def fft_long_conv(z, kern):
    length = z.shape[1]
    zf = jnp.fft.rfft(z.astype(jnp.float32), n=2 * length, axis=1)
    kf = jnp.fft.rfft(kern, n=2 * length, axis=0)
    y = jnp.fft.irfft(zf * kf[None], n=2 * length, axis=1)[:, :length]
    return y.astype(z.dtype)


def hyena_mix(p, conv_w, conv_b, w1, b1, w2, b2, w3, b3, w4, freq, decay_rate, skip, w_o):
    u = short_conv3(p[..., HY_OFF:GATE_OFF], conv_w, conv_b)
    x0, x1, v = jnp.split(u, 3, axis=-1)
    kern = hyena_filter(p.shape[1], w1, b1, w2, b2, w3, b3, w4, freq, decay_rate)
    z = x1 * v
    z = fft_long_conv(z, kern) + z * skip
    return (x0 * z) @ w_o


def merge_branches(p, ret_out, hy_out, w_out):
    g_ret, g_hy = jnp.split(jax.nn.sigmoid(p[..., GATE_OFF:]), 2, axis=-1)
    return (g_ret * ret_out + g_hy * hy_out) @ w_out


def setup_inputs(seed: int = 0) -> dict:
    key = jax.random.key(seed)
    ks = jax.random.split(key, 32)
    f32 = jnp.float32

    def nrm(k, shape, scale):
        return jax.random.normal(k, shape, f32) * scale

    x = nrm(ks[0], (BATCH, SEQ, D_MODEL), 1.0)
    c = nrm(ks[1], (BATCH, D_MODEL), 1.0)
    ctx = nrm(ks[2], (BATCH, CTX_LEN, D_MODEL), 1.0)
    c_ctx = nrm(ks[3], (D_MODEL,), 1.0)
    w_ada = nrm(ks[4], (DEPTH, D_MODEL, N_MOD * D_MODEL), 0.5 * D_MODEL ** -0.5)
    b_ada = nrm(ks[5], (DEPTH, N_MOD * D_MODEL), 0.02)
    norm_g = 1.0 + nrm(ks[6], (DEPTH, 3, D_MODEL), 0.1)
    ffn_up = nrm(ks[7], (DEPTH, 2, D_MODEL, 2 * D_FF), D_MODEL ** -0.5)
    ffn_down = nrm(ks[8], (DEPTH, 2, D_FF, D_MODEL), D_FF ** -0.5)
    w_in = nrm(ks[9], (DEPTH, D_MODEL, IN_COLS), D_MODEL ** -0.5)
    expo = -5.0 - jnp.arange(RET_HEADS, dtype=f32) + nrm(ks[10], (DEPTH, 2, RET_HEADS), 0.1)
    ret_log_gamma = jnp.log1p(-jnp.exp2(expo))
    ret_gn_g = 1.0 + nrm(ks[11], (DEPTH, RET_V), 0.1)
    ret_gn_b = nrm(ks[12], (DEPTH, RET_V), 0.02)
    w_ret_o = nrm(ks[13], (DEPTH, RET_V, D_MODEL), RET_V ** -0.5)
    hy_conv_w = nrm(ks[14], (DEPTH, 3, 3 * HY_WIDTH), 3.0 ** -0.5)
    hy_conv_b = nrm(ks[15], (DEPTH, 3 * HY_WIDTH), 0.02)
    hy_ff_w1 = nrm(ks[16], (DEPTH, HY_EMB, HY_FF), HY_EMB ** -0.5)
    hy_ff_b1 = nrm(ks[17], (DEPTH, HY_FF), 0.02)
    hy_ff_w2 = nrm(ks[18], (DEPTH, HY_FF, HY_FF), HY_FF ** -0.5)
    hy_ff_b2 = nrm(ks[19], (DEPTH, HY_FF), 0.02)
    hy_ff_w3 = nrm(ks[20], (DEPTH, HY_FF, HY_FF), HY_FF ** -0.5)
    hy_ff_b3 = nrm(ks[21], (DEPTH, HY_FF), 0.02)
    hy_ff_w4 = nrm(ks[22], (DEPTH, HY_FF, 2 * HY_WIDTH), HY_FF ** -0.5)
    hy_sin_freq = 1.0 + nrm(ks[23], (DEPTH, HY_FF), 0.1)
    hy_decay = (jnp.linspace(HY_MIN_DECAY, HY_MAX_DECAY, HY_WIDTH, dtype=f32)[None, :]
                + nrm(ks[24], (DEPTH, HY_WIDTH), 0.1))
    hy_bias = nrm(ks[25], (DEPTH, HY_WIDTH), 1.0)
    w_hy_o = nrm(ks[26], (DEPTH, HY_WIDTH, D_MODEL), HY_WIDTH ** -0.5)
    w_out = nrm(ks[27], (DEPTH, D_MODEL, D_MODEL), D_MODEL ** -0.5)
    final_norm_g = 1.0 + nrm(ks[28], (D_MODEL,), 0.1)
    return {'x': x, 'c': c, 'ctx': ctx, 'c_ctx': c_ctx, 'w_ada': w_ada, 'b_ada': b_ada,
            'norm_g': norm_g, 'ffn_up': ffn_up, 'ffn_down': ffn_down, 'w_in': w_in,
            'ret_log_gamma': ret_log_gamma, 'ret_gn_g': ret_gn_g, 'ret_gn_b': ret_gn_b,
            'w_ret_o': w_ret_o, 'hy_conv_w': hy_conv_w, 'hy_conv_b': hy_conv_b,
            'hy_ff_w1': hy_ff_w1, 'hy_ff_b1': hy_ff_b1, 'hy_ff_w2': hy_ff_w2, 'hy_ff_b2': hy_ff_b2,
            'hy_ff_w3': hy_ff_w3, 'hy_ff_b3': hy_ff_b3, 'hy_ff_w4': hy_ff_w4,
            'hy_sin_freq': hy_sin_freq, 'hy_decay': hy_decay, 'hy_bias': hy_bias,
            'w_hy_o': w_hy_o, 'w_out': w_out, 'final_norm_g': final_norm_g}


def reference(x, c, ctx, c_ctx, w_ada, b_ada, norm_g, ffn_up, ffn_down, w_in,
              ret_log_gamma, ret_gn_g, ret_gn_b, w_ret_o, hy_conv_w, hy_conv_b,
              hy_ff_w1, hy_ff_b1, hy_ff_w2, hy_ff_b2, hy_ff_w3, hy_ff_b3, hy_ff_w4,
              hy_sin_freq, hy_decay, hy_bias, w_hy_o, w_out, final_norm_g):
    seq_len = x.shape[1]
    rows = seq_len // GRID_W
    row = jnp.repeat(jnp.arange(rows, dtype=jnp.int32), GRID_W)
    col = jnp.tile(jnp.arange(GRID_W, dtype=jnp.int32), rows)

    for l in range(DEPTH):
        last = l == DEPTH - 1
        hy = (hy_conv_w[l], hy_conv_b[l], hy_ff_w1[l], hy_ff_b1[l], hy_ff_w2[l], hy_ff_b2[l],
              hy_ff_w3[l], hy_ff_b3[l], hy_ff_w4[l], hy_sin_freq[l], hy_decay[l], hy_bias[l],
              w_hy_o[l])
        mx = adaln_mods(c, w_ada[l], b_ada[l])
        mc = adaln_mods(c_ctx, w_ada[l], b_ada[l])

        x = ffn_half(x, mx, 0, norm_g[l, 0], ffn_up[l, 0], ffn_down[l, 0])
        ctx = ffn_half(ctx, mc, 0, norm_g[l, 0], ffn_up[l, 0], ffn_down[l, 0])

        hx = modulate(rmsnorm(x, norm_g[l, 1]), mx[:, :, 3], mx[:, :, 4])
        hc = modulate(rmsnorm(ctx, norm_g[l, 1]), mc[:, :, 3], mc[:, :, 4])
        if last:
            st_f, st_b = context_states(hc @ w_in[l][:, K_OFF:G_OFF], ret_log_gamma[l])
        else:
            pc = hc @ w_in[l]
            zero = jnp.zeros((ctx.shape[0], RET_HEADS, RET_DK, RET_DV), jnp.float32)
            ret_c, st_f, st_b = retention_mix(pc, None, None, ret_log_gamma[l], zero, zero,
                                              ret_gn_g[l], ret_gn_b[l], w_ret_o[l])
            hy_c = hyena_mix(pc, *hy)
            ctx = ctx + mc[:, :, 5] * merge_branches(pc, ret_c, hy_c, w_out[l])
            ctx = ffn_half(ctx, mc, 2, norm_g[l, 2], ffn_up[l, 1], ffn_down[l, 1])
        px = hx @ w_in[l]
        ret_x, _, _ = retention_mix(px, row, col, ret_log_gamma[l], st_f, st_b,
                                    ret_gn_g[l], ret_gn_b[l], w_ret_o[l])
        hy_x = hyena_mix(px, *hy)
        x = x + mx[:, :, 5] * merge_branches(px, ret_x, hy_x, w_out[l])

        x = ffn_half(x, mx, 2, norm_g[l, 2], ffn_up[l, 1], ffn_down[l, 1])

    return rmsnorm(x, final_norm_g)
```

```cpp
#include <hip/hip_runtime.h>
#include <hip/hip_cooperative_groups.h>
#include <cstdio>
namespace cg = cooperative_groups;

typedef unsigned short bf16_t;
typedef short bf16x8 __attribute__((ext_vector_type(8)));
typedef float f32x4 __attribute__((ext_vector_type(4)));
typedef unsigned u32x2 __attribute__((ext_vector_type(2)));
typedef unsigned u32x4 __attribute__((ext_vector_type(4)));

__device__ __forceinline__ int fresh_tid() { int t = (int)threadIdx.x; asm volatile("" : "+v"(t)); return t; }
#define TID (fresh_tid() & 255)
#define BID ((int)(blockIdx.x * 2u) + (fresh_tid() >> 8))
#define GSZ ((int)(gridDim.x * 2u))
constexpr int T = 16384, TT = 16640, D = 2048, DFF = 5632;
constexpr long MiB = 1l << 20;
constexpr int NMOD = 18432;
constexpr long OFF_MODSPART = 0;
constexpr long OFF_MODS = 5 * MiB;
constexpr long OFF_SUMSQ = 5 * MiB + 512 * 1024;
constexpr long OFF_ROPE = 6 * MiB;
constexpr long OFF_BAR = 5 * MiB + 768 * 1024;
constexpr long OFF_CTX1 = 7 * MiB;
constexpr long OFF_H3B = 13 * MiB, OFF_W4T = 15 * MiB;
constexpr long OFF_TAPS = 104 * MiB, OFF_TAPS1 = 40 * MiB;
constexpr long OFF_WRO = 16 * MiB, OFF_WHO = 24 * MiB, OFF_WOUT = 32 * MiB;
constexpr long OFF_WBIG = 40 * MiB, OFF_WDOWN = 84 * MiB;
constexpr long OFF_AR = 106 * MiB;
constexpr long OFF_H = 171 * MiB;
constexpr long OFF_Q = 171 * MiB, OFF_K = 203 * MiB, OFF_KTF = 235 * MiB, OFF_KTB = 268 * MiB, OFF_VT = 301 * MiB,
               OFF_SG = 366 * MiB, OFF_KVT = 430 * MiB, OFF_P = 560 * MiB, OFF_Y = 592 * MiB;
constexpr long OFF_RETOUT = 171 * MiB, OFF_GATES = 235 * MiB, OFF_X0 = 363 * MiB, OFF_Z = 427 * MiB, OFF_PHY = 491 * MiB;
constexpr long OFF_S = 491 * MiB, OFF_KC = 40 * MiB;
constexpr long WS_NEED = 683 * MiB;
constexpr int LDS_HALF = 69632;
constexpr int LDS_BYTES = 2 * LDS_HALF;
constexpr int NPH = 32;
#ifndef SKIP_HY
#define SKIP_HY 0
#endif

struct Params {
  const float *x, *c, *ctx, *c_ctx, *w_ada, *b_ada, *norm_g, *ffn_up, *ffn_down, *w_in, *lg, *gn_g, *gn_b, *w_ret_o,
      *conv_w, *conv_b, *w1, *b1, *w2, *b2, *w3, *b3, *w4, *freq, *decay, *skip, *w_hy_o, *w_out, *fin_g;
  float* out;
  char* ws;
};

__device__ __forceinline__ float bf2f(unsigned h) { return __uint_as_float(h << 16); }
typedef float f32x2_t __attribute__((ext_vector_type(2)));
typedef __bf16 bf16x2_t __attribute__((ext_vector_type(2)));
__device__ __forceinline__ unsigned pk2(float lo, float hi) {
  const f32x2_t v = {lo, hi};
  const bf16x2_t b = __builtin_convertvector(v, bf16x2_t);
  return __builtin_bit_cast(unsigned, b);
}
__device__ __forceinline__ bf16_t f2bf(float f) { return (bf16_t)(pk2(f, 0.f) & 0xffffu); }
__device__ __forceinline__ u32x2 pk4(f32x4 v) {
  u32x2 r;
  r.x = pk2(v[0], v[1]);
  r.y = pk2(v[2], v[3]);
  return r;
}
__device__ __forceinline__ float wave_sum(float v) {
#pragma unroll
  for (int o = 32; o > 0; o >>= 1) v += __shfl_xor(v, o);
  return v;
}
__device__ __forceinline__ float silu_f(float v) { return v * __builtin_amdgcn_rcpf(1.f + __expf(-v)); }
__device__ __forceinline__ float sigm_f(float v) { return __builtin_amdgcn_rcpf(1.f + __expf(-v)); }

typedef __attribute__((address_space(3))) unsigned lds_u32_t;
template <bool SWAP>
__device__ __forceinline__ void gemm_acc(f32x4 (&acc)[4][4], const bf16_t* A, long lda, const bf16_t* Bt, long ldb, int K,
                                         bf16_t* lds, const bf16_t* nA = nullptr, const bf16_t* nB = nullptr,
                                         bool primed = false, long nlda = -1, long nldb = -1) {
  const int tid = TID, lane = tid & 63, w = tid >> 6, wm = w >> 1, wn = w & 1;
  char* ldsb = (char*)lds;
  const int chunk = (tid & 7) ^ ((tid >> 4) & 7);
  const int oa = (tid >> 3) * (int)lda + chunk * 8, ob = (tid >> 3) * (int)ldb + chunk * 8;
  const int sa = 32 * (int)lda, sb = 32 * (int)ldb;
  const int nk = K >> 6;
  if (!primed) {
    __syncthreads();
#pragma unroll
    for (int i = 0; i < 4; ++i) {
      __builtin_amdgcn_global_load_lds((const unsigned*)(A + (oa + i * sa)), (lds_u32_t*)(ldsb + tid * 16 + i * 4096), 16, 0, 0);
      __builtin_amdgcn_global_load_lds((const unsigned*)(Bt + (ob + i * sb)), (lds_u32_t*)(ldsb + 16384 + tid * 16 + i * 4096), 16, 0, 0);
    }
  }
  asm volatile("s_waitcnt vmcnt(0)" ::: "memory");
  __syncthreads();
  const int l15 = lane & 15, l4 = lane >> 4;
  const int o0 = l15 * 128 + ((l4 ^ (l15 >> 1)) << 4);
  for (int kt = 0; kt < nk; ++kt) {
    const int cur = kt & 1;
    if (kt + 1 < nk) {
      char* d = ldsb + (cur ^ 1) * 32768 + tid * 16;
#pragma unroll
      for (int i = 0; i < 4; ++i) {
        __builtin_amdgcn_global_load_lds((const unsigned*)(A + (oa + i * sa + (kt + 1) * 64)), (lds_u32_t*)(d + i * 4096), 16, 0, 0);
        __builtin_amdgcn_global_load_lds((const unsigned*)(Bt + (ob + i * sb + (kt + 1) * 64)), (lds_u32_t*)(d + 16384 + i * 4096), 16, 0, 0);
      }
    }
    const char* la = ldsb + cur * 32768 + (64 * wm) * 128;
    const char* lb = ldsb + cur * 32768 + 16384 + (64 * wn) * 128;
#pragma unroll
    for (int ks = 0; ks < 2; ++ks) {
      bf16x8 af[4], bfr[4];
#pragma unroll
      for (int i = 0; i < 4; ++i) {
        af[i] = *(const bf16x8*)(la + i * 2048 + (o0 ^ (ks * 64)));
        bfr[i] = *(const bf16x8*)(lb + i * 2048 + (o0 ^ (ks * 64)));
      }
#pragma unroll
      for (int mi = 0; mi < 4; ++mi)
#pragma unroll
        for (int ni = 0; ni < 4; ++ni) {
          if (SWAP)
            acc[mi][ni] = __builtin_amdgcn_mfma_f32_16x16x32_bf16(bfr[ni], af[mi], acc[mi][ni], 0, 0, 0);
          else
            acc[mi][ni] = __builtin_amdgcn_mfma_f32_16x16x32_bf16(af[mi], bfr[ni], acc[mi][ni], 0, 0, 0);
        }
    }
    asm volatile("s_waitcnt vmcnt(0)" ::: "memory");
    __syncthreads();
  }
  if (nA != nullptr) {
    const int la2 = (nlda < 0) ? (int)lda : (int)nlda, lb2 = (nldb < 0) ? (int)ldb : (int)nldb;
    const int oa2 = (tid >> 3) * la2 + chunk * 8, ob2 = (tid >> 3) * lb2 + chunk * 8;
#pragma unroll
    for (int i = 0; i < 4; ++i) {
      __builtin_amdgcn_global_load_lds((const unsigned*)(nA + (oa2 + i * 32 * la2)), (lds_u32_t*)(ldsb + tid * 16 + i * 4096), 16, 0, 0);
      __builtin_amdgcn_global_load_lds((const unsigned*)(nB + (ob2 + i * 32 * lb2)), (lds_u32_t*)(ldsb + 16384 + tid * 16 + i * 4096), 16, 0, 0);
    }
  }
}
__device__ __forceinline__ void acc_zero(f32x4 (&acc)[4][4]) {
#pragma unroll
  for (int i = 0; i < 4; ++i)
#pragma unroll
    for (int j = 0; j < 4; ++j) acc[i][j] = (f32x4){0.f, 0.f, 0.f, 0.f};
}
__device__ __forceinline__ void tile_map(int t, int ntm, int ntn, int& tm, int& tn) {
  const int GM = 8;
  const int per = GM * ntn;
  const int g = t / per, fm = g * GM;
  const int gsz = (ntm - fm) < GM ? (ntm - fm) : GM;
  const int rem = t - g * per;
  tn = rem / gsz;
  tm = fm + rem % gsz;
}

namespace pg8 {
#define PG8_LAS __attribute__((address_space(3)))
constexpr int BM = 256, BK = 64, HALF = 128, HTB = HALF * BK * 2  , STAGE_BYTES = 8 * HTB, NXCD = 8, WGM = 8;

__host__ __device__ __forceinline__ int lds_byte(int r, int c) { const int st = (r >> 4) * 2 + (c >> 5), rr = r & 15, cc = c & 31, ob = rr * 64 + cc * 2; return st * 1024 + (ob ^ (((ob >> 9) & 1) << 5)); }
__host__ __device__ __forceinline__ void stage_rc(int b, int& R, int& C) { const int st = b / 1024, sb = b % 1024, swz = sb ^ (((sb >> 9) & 1) << 5); R = (st >> 1) * 16 + swz / 64; C = (st & 1) * 32 + (swz % 64) / 2; }
__host__ __device__ __forceinline__ int perm32(int rho) { const int n = rho >> 4, i = rho & 15; return 8 * (i >> 2) + 4 * n + (i & 3); }

struct Unit { int pm, pn; };
struct Gemm { const bf16_t* A; const bf16_t* Bt; int M, N, K; };

struct TileOrder {
  int nM, nN, nwg, G, c, pn0;
  __device__ __forceinline__ void init(int nM_, int nN_, int pn0_, int G_, int c_) { nM = nM_; nN = nN_; nwg = nM_ * nN_; G = G_; c = c_; pn0 = pn0_; }
  __device__ __forceinline__ bool next(int i, Unit& u) const {
    const long L = (long)i * G + c;
    if (L >= nwg) return false;
    int wgid = (int)L;
    { const int q = nwg / NXCD, r = nwg % NXCD, xcd = wgid % NXCD, off = wgid / NXCD; wgid = (xcd < r ? xcd * (q + 1) : r * (q + 1) + (xcd - r) * q) + off; }
    const int nig = WGM * nN, gid = wgid / nig, fm = gid * WGM, gsz = (nM - fm) < WGM ? (nM - fm) : WGM;
    u.pm = fm + ((wgid % nig) % gsz);
    u.pn = pn0 + (wgid % nig) / gsz;
    return true;
  }
  __device__ __forceinline__ void a_ready(const Unit&) const {}
  __device__ __forceinline__ void done(const Unit&) const {}
};

template <class Epi, class Sched>
__device__ __forceinline__ void gemm_phase(PG8_LAS unsigned char* lds, const Gemm g, const Sched& S, const Epi& E) {
    const int tid = threadIdx.x, wid = __builtin_amdgcn_readfirstlane(tid >> 6), lane = tid & 63, wr = wid >> 2, wc = wid & 3, fr = lane & 15, fq = lane >> 4;
    const int K = g.K, nt = K / BK;
#define PG8_STAMP() do { } while (0)
    PG8_STAMP();
    unsigned voffA[2], voffB[2];
#pragma unroll
    for (int i = 0; i < 2; ++i) { int R, C; stage_rc(tid * 16 + i * 8192, R, C); const int Rb = Epi::PERM ? ((R & ~31) + perm32(R & 31)) : R;
        voffA[i] = (unsigned)(R * K + C) * 2u; voffB[i] = (unsigned)(Rb * K + C) * 2u; }
    const size_t kstep = (size_t)(BK * 2);
    const size_t hstep = (size_t)HALF * K * 2;
    const size_t tstep = 2 * hstep;
    const unsigned ldsw = (unsigned)wid * 1024u;
    const int aoff = lds_byte(wr * 64 + fr, fq * 8), boff = lds_byte(wc * 32 + fr, fq * 8);
#define PG8_SA(b, h) (((b) * 2 + (h)) * HTB)
#define PG8_SB(b, h) ((4 + (b) * 2 + (h)) * HTB)
#define PG8_STAGE(bufoff, gbase, voff) do { _Pragma("unroll") for (int _i = 0; _i < 2; ++_i) \
        __builtin_amdgcn_global_load_lds((const unsigned*)((const char*)(gbase) + (voff)[_i]), (PG8_LAS unsigned*)(lds + (bufoff) + ldsw + _i * 8192), 16, 0, 0); } while (0)
#define PG8_LDA(dst, b, h) do { _Pragma("unroll") for (int m = 0; m < 4; ++m) _Pragma("unroll") for (int k = 0; k < 2; ++k) dst[m][k] = *(const PG8_LAS bf16x8*)(lds + PG8_SA(b, h) + aoff + m * 2048 + k * 1024); } while (0)
#define PG8_LDB(dst, b, h) do { _Pragma("unroll") for (int n = 0; n < 2; ++n) _Pragma("unroll") for (int k = 0; k < 2; ++k) dst[n][k] = *(const PG8_LAS bf16x8*)(lds + PG8_SB(b, h) + boff + n * 2048 + k * 1024); } while (0)
#define PG8_MMA(ai, bj, At, Bt) do { __builtin_amdgcn_s_setprio(1); _Pragma("unroll") for (int m = 0; m < 4; ++m) _Pragma("unroll") for (int n = 0; n < 2; ++n) _Pragma("unroll") for (int k = 0; k < 2; ++k) \
        acc[ai][bj][m][n] = __builtin_amdgcn_mfma_f32_16x16x32_bf16(Bt[n][k], At[m][k], acc[ai][bj][m][n], 0, 0, 0); __builtin_amdgcn_s_setprio(0); } while (0)
#define PG8_WAIT_V(n) asm volatile("s_waitcnt vmcnt(" #n ")" ::: "memory")
#define PG8_WAIT_L(n) asm volatile("s_waitcnt lgkmcnt(" #n ")" ::: "memory")
#define PG8_BAR __builtin_amdgcn_s_barrier()
#define PG8_SCHED __builtin_amdgcn_sched_barrier(0)
    Unit cur, nxt; int ui = 0;
    if (!S.next(0, cur)) return;
    f32x4 acc[2][2][4][2];
#pragma unroll
    for (int a = 0; a < 2; ++a)
#pragma unroll
        for (int b = 0; b < 2; ++b)
#pragma unroll
            for (int m = 0; m < 4; ++m)
#pragma unroll
                for (int n = 0; n < 2; ++n) acc[a][b][m][n] = (f32x4){0.f, 0.f, 0.f, 0.f};
    bf16x8 At[4][2], B0[2][2], B1[2][2];
    const char* cA = (const char*)g.A + (size_t)cur.pm * tstep; const char* cB = (const char*)g.Bt + (size_t)cur.pn * tstep;
    S.a_ready(cur);
    PG8_STAGE(PG8_SB(0, 0), cB, voffB); PG8_STAGE(PG8_SA(0, 0), cA, voffA); PG8_STAGE(PG8_SB(0, 1), cB + hstep, voffB); PG8_STAGE(PG8_SA(0, 1), cA + hstep, voffA);
    if (wr == 1) PG8_BAR;
    PG8_WAIT_V(4); PG8_BAR;
    PG8_STAGE(PG8_SB(1, 0), cB + kstep, voffB); PG8_STAGE(PG8_SA(1, 0), cA + kstep, voffA); PG8_STAGE(PG8_SB(1, 1), cB + hstep + kstep, voffB);
    PG8_WAIT_V(6); PG8_BAR;
    PG8_STAMP();
    for (;;) {
        const bool has_next = S.next(ui + 1, nxt);
        const char* nA = has_next ? (const char*)g.A + (size_t)nxt.pm * tstep : cA; const char* nB = has_next ? (const char*)g.Bt + (size_t)nxt.pn * tstep : cB;
        for (int t = 0; t < nt; t += 2) {
            const bool last = (t == nt - 2);
            const char* a1 = cA + (size_t)(t + 1) * kstep;
            const char* a2 = last ? nA : cA + (size_t)(t + 2) * kstep; const char* b2 = last ? nB : cB + (size_t)(t + 2) * kstep;
            const char* a3 = a2 + kstep; const char* b3 = b2 + kstep;
            if (last && has_next) S.a_ready(nxt);
            PG8_LDB(B0, 0, 0); PG8_SCHED; PG8_LDA(At, 0, 0); PG8_STAGE(PG8_SA(1, 1), a1 + hstep, voffA);
            PG8_WAIT_L(8); PG8_BAR; PG8_WAIT_L(0); PG8_MMA(0, 0, At, B0); PG8_BAR; PG8_SCHED;
            PG8_LDB(B1, 0, 1); PG8_STAGE(PG8_SB(0, 0), b2, voffB);
            PG8_BAR; PG8_WAIT_L(0); PG8_MMA(0, 1, At, B1); PG8_BAR;
            PG8_LDA(At, 0, 1); PG8_STAGE(PG8_SA(0, 0), a2, voffA);
            PG8_BAR; PG8_WAIT_L(0); PG8_MMA(1, 0, At, B0); PG8_BAR; PG8_SCHED;
            PG8_STAGE(PG8_SB(0, 1), b2 + hstep, voffB);
            PG8_WAIT_V(6); PG8_BAR; PG8_MMA(1, 1, At, B1); PG8_BAR;
            PG8_LDB(B0, 1, 0); PG8_SCHED; PG8_LDA(At, 1, 0); PG8_STAGE(PG8_SA(0, 1), a2 + hstep, voffA);
            PG8_WAIT_L(8); PG8_BAR; PG8_WAIT_L(0); PG8_MMA(0, 0, At, B0); PG8_BAR; PG8_SCHED;
            PG8_LDB(B1, 1, 1); PG8_STAGE(PG8_SB(1, 0), b3, voffB);
            PG8_BAR; PG8_WAIT_L(0); PG8_MMA(0, 1, At, B1); PG8_BAR;
            PG8_LDA(At, 1, 1); PG8_STAGE(PG8_SA(1, 0), a3, voffA);
            PG8_BAR; PG8_WAIT_L(0); PG8_MMA(1, 0, At, B0); PG8_BAR; PG8_SCHED;
            PG8_STAGE(PG8_SB(1, 1), b3 + hstep, voffB);
            PG8_WAIT_V(6); PG8_BAR; PG8_MMA(1, 1, At, B1); PG8_BAR;
        }
        PG8_STAMP();
        if constexpr (!Epi::AFTER_DRAIN) { E(acc, cur, wr, wc, fr, fq); S.done(cur); }
        PG8_STAMP();
        if (!has_next) break;
#pragma unroll
        for (int a = 0; a < 2; ++a)
#pragma unroll
            for (int b = 0; b < 2; ++b)
#pragma unroll
                for (int m = 0; m < 4; ++m)
#pragma unroll
                    for (int n = 0; n < 2; ++n) acc[a][b][m][n] = (f32x4){0.f, 0.f, 0.f, 0.f};
        cur = nxt; cA = nA; cB = nB; ++ui;
    }
    PG8_WAIT_V(0);
    if (wr == 0) PG8_BAR;
    PG8_BAR;
    if constexpr (Epi::AFTER_DRAIN) { E.fused(acc, cur, wr, wc, fr, fq, lds, wid, lane); S.done(cur); }
    PG8_STAMP();
#undef PG8_STAMP
#undef PG8_SA
#undef PG8_SB
#undef PG8_STAGE
#undef PG8_LDA
#undef PG8_LDB
#undef PG8_MMA
#undef PG8_WAIT_V
#undef PG8_WAIT_L
#undef PG8_BAR
#undef PG8_SCHED
}
}
#define XCD_TILE_LOOP(t, ntiles)                                                                      \
  for (int t0_ = 0; t0_ < (ntiles); t0_ += GSZ)                                                        \
    if (const int t = t0_ + ((BID >> 1) & 7) * (GSZ >> 3) + (((BID >> 4) << 1) | (BID & 1)); t < (ntiles))
__device__ __forceinline__ void conv_weight(const float* src, int K, int ld, int N, bf16_t* dst, int mode, float* sm) {
  const int ntn = N >> 7, ntk = K >> 6;
  const int tid = TID;
  for (int t = BID; t < ntn * ntk; t += GSZ) {
    const int tn = t % ntn, tk = t / ntn;
    const int n0 = tn * 128, k0 = tk * 64;
    __syncthreads();
    {
      const int j = tid & 127, i = tid >> 7;
      const int n = n0 + j;
      int col = n;
      if (mode == 2) {
        const int P = n >> 8, c = n & 255;
        col = (c < 128) ? (128 * P + c) : (DFF + 128 * P + c - 128);
      } else if (mode == 3) {
        if (n < 2048) {
          const int P = n >> 8, c = n & 255, sx = c >> 7, c1 = c & 127;
          col = P * 256 + (c1 >> 6) * 128 + ((c1 >> 5) & 1) * 64 + (c1 & 31) + 32 * sx;
        }
      }
      float v[32];
#pragma unroll
      for (int r = 0; r < 32; ++r) v[r] = src[(long)(k0 + i + 2 * r) * ld + col];
#pragma unroll
      for (int r = 0; r < 32; ++r) sm[(i + 2 * r) * 129 + j] = v[r];
    }
    __syncthreads();
    {
      const int q = tid & 7, jj = tid >> 3;
#pragma unroll
      for (int r = 0; r < 4; ++r) {
        const int nn = jj + 32 * r;
        float v[8];
#pragma unroll
        for (int e = 0; e < 8; ++e) v[e] = sm[(q * 8 + e) * 129 + nn];
        u32x4 o;
        o.x = pk2(v[0], v[1]);
        o.y = pk2(v[2], v[3]);
        o.z = pk2(v[4], v[5]);
        o.w = pk2(v[6], v[7]);
        *(u32x4*)(dst + (long)(n0 + nn) * K + k0 + q * 8) = o;
      }
    }
  }
}

__device__ __forceinline__ void ph_mods_partial(const Params& p, float* sm) {
  float* part = (float*)(p.ws + OFF_MODSPART);
  for (int it = BID; it < 576; it += GSZ) {
    const int ks = it / 18, cch = it % 18;
    __syncthreads();
    if (TID < 128) {
      const int k = ks * 64 + (TID & 63);
      const float v = (TID < 64) ? p.c[k] : p.c_ctx[k];
      sm[TID] = v / (1.f + expf(-v));
    }
    __syncthreads();
    const int n = cch * 1024 + TID * 4;
    f32x4 a0 = (f32x4){0.f, 0.f, 0.f, 0.f}, a1 = a0;
    const float* wp = p.w_ada + (long)(ks * 64) * NMOD + n;
#pragma unroll 8
    for (int k = 0; k < 64; ++k) {
      const f32x4 w = *(const f32x4*)(wp + (long)k * NMOD);
      a0 += w * sm[k];
      a1 += w * sm[64 + k];
    }
    if (ks == 0) {
      const f32x4 bb = *(const f32x4*)(p.b_ada + n);
      a0 += bb;
      a1 += bb;
    }
    float* mods = (float*)(p.ws + OFF_MODS);
#pragma unroll
    for (int r = 0; r < 4; ++r) {
      atomicAdd(mods + n + r, a0[r]);
      atomicAdd(mods + NMOD + n + r, a1[r]);
    }
  }
}
__device__ __forceinline__ void ph_mods_reduce(const Params& p) {
  const float* part = (const float*)(p.ws + OFF_MODSPART);
  float* mods = (float*)(p.ws + OFF_MODS);
  for (int i = BID * 256 + TID; i < 2 * NMOD; i += GSZ * 256) {
    const int v = i / NMOD, n = i % NMOD;
    float s = p.b_ada[n];
    for (int ks = 0; ks < 32; ++ks) s += part[(long)(ks * 2 + v) * NMOD + n];
    mods[i] = s;
  }
}
__device__ __forceinline__ void ph_misc0(const Params& p) {
  float* sumsq = (float*)(p.ws + OFF_SUMSQ);
  float2* rope = (float2*)(p.ws + OFF_ROPE);
  bf16_t* h3 = (bf16_t*)(p.ws + OFF_H3B);
  const int gt = BID * 256 + TID, gs = GSZ * 256;
  for (int i = gt; i < 2048; i += gs) sumsq[i] = 0.f;
  for (int i = gt; i < 256 * 32; i += gs) {
    const int pos = i >> 5, k = i & 31;
    const float inv = exp2f(-(float)k * (13.287712379549449f / 32.f));
    const float ang = (float)pos * inv;
    rope[i] = make_float2(cosf(ang), sinf(ang));
  }
  const int lane = TID & 63;
  const int gw = BID * 4 + (TID >> 6), nw = GSZ * 4;
  const float fq = p.freq[lane];
  for (int j = gw; j < 16384; j += nw) {
    const float wj = (6.2831855f * (float)j) / 16384.f;
    float feat = 0.f;
    if (lane == 0)
      feat = (float)j / 16383.f;
    else if (lane <= 16) {
      const float f = 1e-4f + (float)(lane - 1) * ((15.f - 1e-4f) / 15.f);
      feat = cosf(f * wj);
    } else if (lane <= 32) {
      const float f = 1e-4f + (float)(lane - 17) * ((15.f - 1e-4f) / 15.f);
      feat = -sinf(f * wj);
    }
    float a = p.b1[lane];
    for (int e = 0; e < 33; ++e) a += __shfl(feat, e) * p.w1[e * 64 + lane];
    float h = sinf(fq * a);
    a = p.b2[lane];
    for (int k = 0; k < 64; ++k) a += __shfl(h, k) * p.w2[k * 64 + lane];
    h = sinf(fq * a);
    a = p.b3[lane];
    for (int k = 0; k < 64; ++k) a += __shfl(h, k) * p.w3[k * 64 + lane];
    h = sinf(fq * a);
    h3[j * 64 + lane] = f2bf(h);
  }
}
__device__ __forceinline__ void ph_prenorm(const Params& p, const float* xl, const float* xc, int rows, const float* g, int slot) {
  const float* mods = (const float*)(p.ws + OFF_MODS);
  bf16_t* A = (bf16_t*)(p.ws + OFF_AR);
  const int lane = TID & 63;
  const int gw = BID * 4 + (TID >> 6), nw = GSZ * 4;
  for (int r = gw; r < rows; r += nw) {
    const float* src = (r < T) ? xl + (long)r * D : xc + (long)(r - T) * D;
    const float* md = mods + ((r < T) ? 0 : NMOD);
    f32x4 v[8];
    float ss = 0.f;
#pragma unroll
    for (int i = 0; i < 8; ++i) {
      v[i] = *(const f32x4*)(src + i * 256 + lane * 4);
      ss += v[i][0] * v[i][0] + v[i][1] * v[i][1] + v[i][2] * v[i][2] + v[i][3] * v[i][3];
    }
    ss = wave_sum(ss);
    const float rstd = rsqrtf(ss * (1.f / 2048.f) + 1e-6f);
#pragma unroll
    for (int i = 0; i < 8; ++i) {
      const int c = i * 256 + lane * 4;
      const f32x4 gg = *(const f32x4*)(g + c);
      const f32x4 sh = *(const f32x4*)(md + (3 * slot) * D + c);
      const f32x4 sc = *(const f32x4*)(md + (3 * slot + 1) * D + c);
      const f32x4 y = v[i] * rstd * gg;
      const f32x4 o = y * (1.f + sc) + sh;
      *(u32x2*)(A + (long)r * D + c) = pk4(o);
    }
  }
}
__device__ __forceinline__ void ph_final_norm(const Params& p) {
  const int lane = TID & 63;
  const int gw = BID * 4 + (TID >> 6), nw = GSZ * 4;
  for (int r = gw; r < T; r += nw) {
    float* src = p.out + (long)r * D;
    f32x4 v[8];
    float ss = 0.f;
#pragma unroll
    for (int i = 0; i < 8; ++i) {
      v[i] = *(const f32x4*)(src + i * 256 + lane * 4);
      ss += v[i][0] * v[i][0] + v[i][1] * v[i][1] + v[i][2] * v[i][2] + v[i][3] * v[i][3];
    }
    ss = wave_sum(ss);
    const float rstd = rsqrtf(ss * (1.f / 2048.f) + 1e-6f);
#pragma unroll
    for (int i = 0; i < 8; ++i) {
      const int c = i * 256 + lane * 4;
      const f32x4 gg = *(const f32x4*)(p.fin_g + c);
      *(f32x4*)(src + c) = v[i] * rstd * gg;
    }
  }
}

#define GEMM_IDS                                                                       \
  const int lane = TID & 63, wv = TID >> 6, wm = wv >> 1, wn = wv & 1; \
  const int l15 = lane & 15, l4 = lane >> 4;                                           \
  (void)l15; (void)l4; (void)wm; (void)wn;

__device__ __forceinline__ void ph_gemm_up(const Params& p, int rows, bf16_t* lds) {
  GEMM_IDS
  const bf16_t* A = (const bf16_t*)(p.ws + OFF_AR);
  const bf16_t* Bt = (const bf16_t*)(p.ws + OFF_WBIG);
  bf16_t* H = (bf16_t*)(p.ws + OFF_H);
  const int ntm = rows >> 7, ntn = 88;
  bool primed = false;
  XCD_TILE_LOOP(t, ntm * ntn) {
    int tm, tn;
    tile_map(t, ntm, ntn, tm, tn);
    f32x4 acc[4][4];
    acc_zero(acc);
    const bf16_t *nA = nullptr, *nB = nullptr;
    if (t + (int)GSZ < ntm * ntn) { int tm2, tn2; tile_map(t + GSZ, ntm, ntn, tm2, tn2); nA = A + (long)tm2 * 128 * D; nB = Bt + (long)tn2 * 128 * D; }
    gemm_acc<true>(acc, A + (long)tm * 128 * D, D, Bt + (long)tn * 128 * D, D, D, lds, nA, nB, primed);
    primed = nA != nullptr;
#pragma unroll
    for (int mi = 0; mi < 4; ++mi) {
      const int m = tm * 128 + 64 * wm + 16 * mi + l15;
#pragma unroll
      for (int ni = 0; ni < 2; ++ni) {
        const int hc = (tn * 2 + wn) * 32 + 16 * ni + 4 * l4;
        f32x4 o;
#pragma unroll
        for (int r = 0; r < 4; ++r) o[r] = silu_f(acc[mi][ni][r]) * acc[mi][ni + 2][r];
        *(u32x2*)(H + (long)m * DFF + hc) = pk4(o);
      }
    }
  }
}
__device__ __forceinline__ void ph_gemm_down(const Params& p, int rows, int slot, const float* resl, const float* resc, float* outl, float* outc,
                             bf16_t* lds) {
  GEMM_IDS
  const bf16_t* A = (const bf16_t*)(p.ws + OFF_H);
  const bf16_t* Bt = (const bf16_t*)(p.ws + OFF_WDOWN);
  const float* mods = (const float*)(p.ws + OFF_MODS);
  const int ntm = rows >> 7, ntn = 16;
  bool primed = false;
  XCD_TILE_LOOP(t, ntm * ntn) {
    int tm, tn;
    tile_map(t, ntm, ntn, tm, tn);
    f32x4 acc[4][4];
    acc_zero(acc);
    const bf16_t *nA = nullptr, *nB = nullptr;
    if (t + (int)GSZ < ntm * ntn) { int tm2, tn2; tile_map(t + GSZ, ntm, ntn, tm2, tn2); nA = A + (long)tm2 * 128 * DFF; nB = Bt + (long)tn2 * 128 * DFF; }
    gemm_acc<true>(acc, A + (long)tm * 128 * DFF, DFF, Bt + (long)tn * 128 * DFF, DFF, DFF, lds, nA, nB, primed);
    primed = nA != nullptr;
    const bool lat = tm < 128;
    const float* gate = mods + (lat ? 0 : NMOD) + (3 * slot + 2) * D;
#pragma unroll
    for (int mi = 0; mi < 4; ++mi) {
      const int m = tm * 128 + 64 * wm + 16 * mi + l15;
      const float* rp = lat ? resl + (long)m * D : resc + (long)(m - T) * D;
      float* op = lat ? outl + (long)m * D : outc + (long)(m - T) * D;
#pragma unroll
      for (int ni = 0; ni < 4; ++ni) {
        const int n = tn * 128 + 64 * wn + 16 * ni + 4 * l4;
        const f32x4 gt = *(const f32x4*)(gate + n);
        const f32x4 rs = *(const f32x4*)(rp + n);
        *(f32x4*)(op + n) = rs + 0.5f * gt * acc[mi][ni];
      }
    }
  }
}
__device__ __forceinline__ void ph_gemm_plain(const bf16_t* A, const bf16_t* Bt, bf16_t* C, int M, int N, int K, bf16_t* lds) {
  GEMM_IDS
  const int ntm = M >> 7, ntn = N >> 7;
  bool primed = false;
  XCD_TILE_LOOP(t, ntm * ntn) {
    int tm, tn;
    tile_map(t, ntm, ntn, tm, tn);
    f32x4 acc[4][4];
    acc_zero(acc);
    const bf16_t *nA = nullptr, *nB = nullptr;
    if (t + (int)GSZ < ntm * ntn) { int tm2, tn2; tile_map(t + GSZ, ntm, ntn, tm2, tn2); nA = A + (long)tm2 * 128 * K; nB = Bt + (long)tn2 * 128 * K; }
    gemm_acc<true>(acc, A + (long)tm * 128 * K, K, Bt + (long)tn * 128 * K, K, K, lds, nA, nB, primed);
    primed = nA != nullptr;
#pragma unroll
    for (int mi = 0; mi < 4; ++mi) {
      const int m = tm * 128 + 64 * wm + 16 * mi + l15;
#pragma unroll
      for (int ni = 0; ni < 4; ++ni) {
        const int n = tn * 128 + 64 * wn + 16 * ni + 4 * l4;
        *(u32x2*)(C + (long)m * N + n) = pk4(acc[mi][ni]);
      }
    }
  }
}
__device__ __forceinline__ void ph_gemm_win_a(const Params& p, bf16_t* lds) {
  GEMM_IDS
  const bf16_t* A = (const bf16_t*)(p.ws + OFF_AR);
  const bf16_t* Bt = (const bf16_t*)(p.ws + OFF_WBIG);
  bf16_t* q = (bf16_t*)(p.ws + OFF_Q);
  bf16_t* kk = (bf16_t*)(p.ws + OFF_K);
  bf16_t* kTf = (bf16_t*)(p.ws + OFF_KTF);
  bf16_t* kTb = (bf16_t*)(p.ws + OFF_KTB);
  bf16_t* vT = (bf16_t*)(p.ws + OFF_VT);
  bf16_t* sg = (bf16_t*)(p.ws + OFF_SG);
  const float2* rope = (const float2*)(p.ws + OFF_ROPE);
  const int n_lat = 128 * 48, n_ctx = 2 * 24;
  XCD_TILE_LOOP(t, n_lat + n_ctx) {
    int tm, tn;
    if (t < n_lat)
      tile_map(t, 128, 48, tm, tn);
    else {
      const int u = t - n_lat;
      tm = 128 + u / 24;
      tn = 8 + u % 24;
    }
    f32x4 acc[4][4];
    acc_zero(acc);
    const bf16_t* Ap = A + (long)tm * 128 * D;
    const bf16_t* Bp = Bt + (long)tn * 128 * D;
    if (tn >= 16 && tn < 32) {
      gemm_acc<false>(acc, Ap, D, Bp, D, D, lds);
#pragma unroll
      for (int mi = 0; mi < 4; ++mi) {
        const int m0 = tm * 128 + 64 * wm + 16 * mi + 4 * l4;
#pragma unroll
        for (int ni = 0; ni < 4; ++ni) {
          const int ch = (tn - 16) * 128 + 64 * wn + 16 * ni + l15;
          *(u32x2*)(vT + (long)ch * TT + m0) = pk4(acc[mi][ni]);
        }
      }
    } else {
      gemm_acc<true>(acc, Ap, D, Bp, D, D, lds);
      if (tn < 8) {
        const float scl = 0.08838834764831845f;
#pragma unroll
        for (int mi = 0; mi < 4; ++mi) {
          const int m = tm * 128 + 64 * wm + 16 * mi + l15;
          const int pos = (wn == 0) ? (m >> 6) : (m & 63);
#pragma unroll
          for (int ni = 0; ni < 2; ++ni) {
            const int i0 = 16 * ni + 4 * l4;
            f32x4 o1, o2;
#pragma unroll
            for (int r = 0; r < 4; ++r) {
              const float2 cs = rope[pos * 32 + i0 + r];
              const float x1 = acc[mi][ni][r] * scl, x2 = acc[mi][ni + 2][r] * scl;
              o1[r] = x1 * cs.x - x2 * cs.y;
              o2[r] = x1 * cs.y + x2 * cs.x;
            }
            bf16_t* dp = q + (long)m * 1024 + tn * 128 + 64 * wn + i0;
            *(u32x2*)(dp) = pk4(o1);
            *(u32x2*)(dp + 32) = pk4(o2);
          }
        }
      } else if (tn < 16) {
        const int head = tn - 8;
        const float lgf = p.lg[head], lgb = p.lg[8 + head];
#pragma unroll
        for (int mi = 0; mi < 4; ++mi) {
          const int m = tm * 128 + 64 * wm + 16 * mi + l15;
          const bool lat = m < T;
          const int pos = (wn == 0) ? ((m >> 6) & 255) : (m & 63);
          const int j = m & 127;
          const float zf = __expf(lgf * (float)(127 - j)), zb = __expf(lgb * (float)j);
#pragma unroll
          for (int ni = 0; ni < 2; ++ni) {
            const int i0 = 16 * ni + 4 * l4;
            f32x4 o1, o2;
#pragma unroll
            for (int r = 0; r < 4; ++r) {
              float2 cs = rope[pos * 32 + i0 + r];
              if (!lat) cs = make_float2(1.f, 0.f);
              const float x1 = acc[mi][ni][r], x2 = acc[mi][ni + 2][r];
              o1[r] = x1 * cs.x - x2 * cs.y;
              o2[r] = x1 * cs.y + x2 * cs.x;
            }
            const int cb = head * 128 + 64 * wn + i0;
            if (lat) {
              bf16_t* dp = kk + (long)m * 1024 + cb;
              *(u32x2*)(dp) = pk4(o1);
              *(u32x2*)(dp + 32) = pk4(o2);
            }
#pragma unroll
            for (int r = 0; r < 4; ++r) {
              kTf[(long)(cb + r) * TT + m] = f2bf(o1[r] * zf);
              kTb[(long)(cb + r) * TT + m] = f2bf(o1[r] * zb);
              kTf[(long)(cb + 32 + r) * TT + m] = f2bf(o2[r] * zf);
              kTb[(long)(cb + 32 + r) * TT + m] = f2bf(o2[r] * zb);
            }
          }
        }
      } else {
#pragma unroll
        for (int mi = 0; mi < 4; ++mi) {
          const int m = tm * 128 + 64 * wm + 16 * mi + l15;
#pragma unroll
          for (int ni = 0; ni < 4; ++ni) {
            const int n = (tn - 32) * 128 + 64 * wn + 16 * ni + 4 * l4;
            f32x4 o;
#pragma unroll
            for (int r = 0; r < 4; ++r) o[r] = silu_f(acc[mi][ni][r]);
            *(u32x2*)(sg + (long)m * D + n) = pk4(o);
          }
        }
      }
    }
  }
}
__device__ __forceinline__ void ph_gemm_win_b(const Params& p, bf16_t* lds) {
  GEMM_IDS
  const bf16_t* A = (const bf16_t*)(p.ws + OFF_AR);
  const bf16_t* Bt = (const bf16_t*)(p.ws + OFF_WBIG);
  bf16_t* phy = (bf16_t*)(p.ws + OFF_PHY);
  bf16_t* gates = (bf16_t*)(p.ws + OFF_GATES);
  bool primed = false;
  XCD_TILE_LOOP(t, 128 * 80) {
    int tm, tn;
    tile_map(t, 128, 80, tm, tn);
    tn += 48;
    f32x4 acc[4][4];
    acc_zero(acc);
    const bf16_t *nA = nullptr, *nB = nullptr;
    if (t + (int)GSZ < 128 * 80) { int tm2, tn2; tile_map(t + GSZ, 128, 80, tm2, tn2); tn2 += 48; nA = A + (long)tm2 * 128 * D; nB = Bt + (long)tn2 * 128 * D; }
    gemm_acc<true>(acc, A + (long)tm * 128 * D, D, Bt + (long)tn * 128 * D, D, D, lds, nA, nB, primed);
    primed = nA != nullptr;
#pragma unroll
    for (int mi = 0; mi < 4; ++mi) {
      const int m = tm * 128 + 64 * wm + 16 * mi + l15;
#pragma unroll
      for (int ni = 0; ni < 4; ++ni) {
        const int nl = 64 * wn + 16 * ni + 4 * l4;
        if (tn < 96) {
          *(u32x2*)(phy + (long)m * 6144 + (tn - 48) * 128 + nl) = pk4(acc[mi][ni]);
        } else {
          f32x4 o;
#pragma unroll
          for (int r = 0; r < 4; ++r) o[r] = sigm_f(acc[mi][ni][r]);
          *(u32x2*)(gates + (long)m * 4096 + (tn - 96) * 128 + nl) = pk4(o);
        }
      }
    }
  }
}
__device__ __forceinline__ void ph_ret_kv_p(const Params& p, bf16_t* lds) {
  GEMM_IDS
  const bf16_t* q = (const bf16_t*)(p.ws + OFF_Q);
  const bf16_t* kk = (const bf16_t*)(p.ws + OFF_K);
  const bf16_t* kTf = (const bf16_t*)(p.ws + OFF_KTF);
  const bf16_t* kTb = (const bf16_t*)(p.ws + OFF_KTB);
  const bf16_t* vT = (const bf16_t*)(p.ws + OFF_VT);
  bf16_t* kvT = (bf16_t*)(p.ws + OFF_KVT);
  bf16_t* P = (bf16_t*)(p.ws + OFF_P);
  const int n1 = 130 * 8 * 2 * 2, n2 = 128 * 8;
  bool primed = false;
  for (int t = BID; t < n1; t += GSZ) {
    f32x4 acc[4][4];
    acc_zero(acc);
    {
      const int half = t & 1, d = (t >> 1) & 1, h = (t >> 2) & 7, ci = t >> 5;
      const bf16_t* Ap = vT + (long)(h * 256 + half * 128) * TT + ci * 128;
      const bf16_t* Bp = (d ? kTb : kTf) + (long)(h * 128) * TT + ci * 128;
      const bf16_t *nAp = nullptr, *nBp = nullptr;
      if (t + GSZ < n1) {
        const int t2 = t + GSZ, half2 = t2 & 1, d2 = (t2 >> 1) & 1, h2 = (t2 >> 2) & 7, ci2 = t2 >> 5;
        nAp = vT + (long)(h2 * 256 + half2 * 128) * TT + ci2 * 128;
        nBp = (d2 ? kTb : kTf) + (long)(h2 * 128) * TT + ci2 * 128;
      }
      gemm_acc<true>(acc, Ap, TT, Bp, TT, 128, lds, nAp, nBp, primed);
      primed = nAp != nullptr;
      bf16_t* o = kvT + ((long)(d * 130 + ci) * 8 + h) * 32768 + (long)(half * 128) * 128;
#pragma unroll
      for (int mi = 0; mi < 4; ++mi) {
        const int m = 64 * wm + 16 * mi + l15;
#pragma unroll
        for (int ni = 0; ni < 4; ++ni) {
          const int n = 64 * wn + 16 * ni + 4 * l4;
          *(u32x2*)(o + m * 128 + n) = pk4(acc[mi][ni]);
        }
      }
    }
  }
  bool primed2 = false;
  for (int u = BID; u < n2; u += GSZ) {
    f32x4 acc[4][4];
    acc_zero(acc);
    {
      const int h = u & 7, ci = u >> 3;
      const bf16_t* Ap = q + (long)ci * 128 * 1024 + h * 128;
      const bf16_t* Bp = kk + (long)ci * 128 * 1024 + h * 128;
      const bf16_t *nAp = nullptr, *nBp = nullptr;
      if (u + GSZ < n2) {
        const int u2 = u + GSZ, h2 = u2 & 7, ci2 = u2 >> 3;
        nAp = q + (long)ci2 * 128 * 1024 + h2 * 128;
        nBp = kk + (long)ci2 * 128 * 1024 + h2 * 128;
      }
      gemm_acc<true>(acc, Ap, 1024, Bp, 1024, 128, lds, nAp, nBp, primed2);
      primed2 = nAp != nullptr;
      const float lgf = p.lg[h], nlgb = -p.lg[8 + h];
      bf16_t* o = P + (long)(ci * 8 + h) * 16384;
#pragma unroll
      for (int mi = 0; mi < 4; ++mi) {
        const int a = 64 * wm + 16 * mi + l15;
#pragma unroll
        for (int ni = 0; ni < 4; ++ni) {
          const int b0 = 64 * wn + 16 * ni + 4 * l4;
          f32x4 ov;
#pragma unroll
          for (int r = 0; r < 4; ++r) {
            const int b = b0 + r;
            const int dd = a - b;
            const float dcy = (dd == 0) ? 2.f : __expf((dd > 0 ? lgf : nlgb) * (float)dd);
            ov[r] = acc[mi][ni][r] * dcy;
          }
          *(u32x2*)(o + a * 128 + b0) = pk4(ov);
        }
      }
    }
  }
}
__device__ __forceinline__ void ph_ret_scan(const Params& p) {
  unsigned* kv = (unsigned*)(p.ws + OFF_KVT);
  for (int it = BID * 256 + TID; it < 262144; it += GSZ * 256) {
    const int d = it >> 17, e2 = it & 131071, h = e2 >> 14, off = e2 & 16383;
    const float dec = expf(p.lg[d * 8 + h] * 128.f);
    unsigned* base = kv + ((long)d * 130 * 8 + h) * 16384 + off;
    float s0 = 0.f, s1 = 0.f;
    for (int sb = 0; sb < 130; sb += 10) {
      unsigned vv[10];
#pragma unroll
      for (int k = 0; k < 10; ++k) {
        const int step = sb + k;
        const int ci = (d == 0) ? ((step < 2) ? (128 + step) : (step - 2)) : (129 - step);
        vv[k] = base[(long)ci * 131072];
      }
#pragma unroll
      for (int k = 0; k < 10; ++k) {
        const int step = sb + k;
        const int ci = (d == 0) ? ((step < 2) ? (128 + step) : (step - 2)) : (129 - step);
        base[(long)ci * 131072] = pk2(s0, s1);
        s0 = s0 * dec + bf2f(vv[k] & 0xffffu);
        s1 = s1 * dec + bf2f(vv[k] >> 16);
      }
    }
  }
}
__device__ __forceinline__ void ph_ret_out(const Params& p, char* lds_all) {
  GEMM_IDS
  const int half = fresh_tid() >> 8;
  bf16_t* lds = (bf16_t*)(lds_all + half * LDS_HALF);
  float2* part = (float2*)(lds_all + 65536);
  const bf16_t* q = (const bf16_t*)(p.ws + OFF_Q);
  const bf16_t* vT = (const bf16_t*)(p.ws + OFF_VT);
  const bf16_t* kvT = (const bf16_t*)(p.ws + OFF_KVT);
  const bf16_t* P = (const bf16_t*)(p.ws + OFF_P);
  const bf16_t* sg = (const bf16_t*)(p.ws + OFF_SG);
  bf16_t* Y = (bf16_t*)(p.ws + OFF_Y);
  bool primed = false;
  for (int it = (int)blockIdx.x; it < 1024; it += (int)gridDim.x) {
    const int h = it & 7, ci = it >> 3;
    const float lgf = p.lg[h], lgb = p.lg[8 + h];
    f32x4 acc[4][4];
    acc_zero(acc);
    const bf16_t* Aq = q + (long)ci * 128 * 1024 + h * 128;
    const bf16_t* Sb = kvT + ((long)(130 + ci) * 8 + h) * 32768 + (long)(half * 128) * 128;
    const bf16_t* Sf = kvT + ((long)(ci)*8 + h) * 32768 + (long)(half * 128) * 128;
    const bf16_t* Ap = P + (long)(ci * 8 + h) * 16384;
    const bf16_t* Vp = vT + (long)(h * 256 + half * 128) * TT + ci * 128;
    const bf16_t *nAq = nullptr, *nSb = nullptr;
    if (it + (int)gridDim.x < 1024) {
      const int it2 = it + (int)gridDim.x, h2 = it2 & 7, ci2 = it2 >> 3;
      nAq = q + (long)ci2 * 128 * 1024 + h2 * 128;
      nSb = kvT + ((long)(130 + ci2) * 8 + h2) * 32768 + (long)(half * 128) * 128;
    }
    gemm_acc<true>(acc, Aq, 1024, Sb, 128, 128, lds, Aq, Sf, primed);
#pragma unroll
    for (int mi = 0; mi < 4; ++mi) {
      const int a = 64 * wm + 16 * mi + l15;
      const float ratio = __expf(lgb * (float)(128 - a) - lgf * (float)(a + 1));
#pragma unroll
      for (int ni = 0; ni < 4; ++ni) acc[mi][ni] *= ratio;
    }
    gemm_acc<true>(acc, Aq, 1024, Sf, 128, 128, lds, Ap, Vp, true, 128, TT);
#pragma unroll
    for (int mi = 0; mi < 4; ++mi) {
      const int a = 64 * wm + 16 * mi + l15;
      const float xf = __expf(lgf * (float)(a + 1));
#pragma unroll
      for (int ni = 0; ni < 4; ++ni) acc[mi][ni] *= xf;
    }
    gemm_acc<true>(acc, Ap, 128, Vp, TT, 128, lds, nAq, nSb, true, 1024, 128);
    primed = nAq != nullptr;
#pragma unroll
    for (int mi = 0; mi < 4; ++mi) {
      float s1 = 0.f, s2 = 0.f;
#pragma unroll
      for (int ni = 0; ni < 4; ++ni)
#pragma unroll
        for (int r = 0; r < 4; ++r) {
          const float v = acc[mi][ni][r];
          s1 += v;
          s2 += v * v;
        }
      s1 += __shfl_xor(s1, 16);
      s2 += __shfl_xor(s2, 16);
      s1 += __shfl_xor(s1, 32);
      s2 += __shfl_xor(s2, 32);
      if (l4 == 0) part[(half * 2 + wn) * 128 + 64 * wm + 16 * mi + l15] = make_float2(s1, s2);
    }
    __syncthreads();
#pragma unroll
    for (int mi = 0; mi < 4; ++mi) {
      const int a = 64 * wm + 16 * mi + l15;
      const float2 p0 = part[a], p1 = part[128 + a], p2 = part[256 + a], p3 = part[384 + a];
      const float mean = ((p0.x + p1.x) + (p2.x + p3.x)) * (1.f / 256.f);
      const float ex2 = ((p0.y + p1.y) + (p2.y + p3.y)) * (1.f / 256.f);
      const float rs = rsqrtf(fmaxf(ex2 - mean * mean, 0.f) + 1e-6f);
      const long t = (long)ci * 128 + a;
#pragma unroll
      for (int ni = 0; ni < 4; ++ni) {
        const int c = h * 256 + half * 128 + 64 * wn + 16 * ni + 4 * l4;
        const u32x2 graw = *(const u32x2*)(sg + t * D + c);
        const f32x4 gg = *(const f32x4*)(p.gn_g + c), gb = *(const f32x4*)(p.gn_b + c);
        f32x4 o;
        o[0] = ((acc[mi][ni][0] - mean) * rs * gg[0] + gb[0]) * bf2f(graw.x & 0xffffu);
        o[1] = ((acc[mi][ni][1] - mean) * rs * gg[1] + gb[1]) * bf2f(graw.x >> 16);
        o[2] = ((acc[mi][ni][2] - mean) * rs * gg[2] + gb[2]) * bf2f(graw.y & 0xffffu);
        o[3] = ((acc[mi][ni][3] - mean) * rs * gg[3] + gb[3]) * bf2f(graw.y >> 16);
        *(u32x2*)(Y + t * D + c) = pk4(o);
      }
    }
  }
}
__device__ __forceinline__ void ph_ret_gn(const Params& p) {
  bf16_t* Y = (bf16_t*)(p.ws + OFF_Y);
  const bf16_t* sg = (const bf16_t*)(p.ws + OFF_SG);
  const int lane = TID & 63;
  const int gw = BID * 4 + (TID >> 6), nw = GSZ * 4;
  for (int t = gw; t < T; t += nw) {
    u32x2 raw[8], graw[8];
#pragma unroll
    for (int h = 0; h < 8; ++h) {
      raw[h] = *(const u32x2*)(Y + (long)t * D + h * 256 + lane * 4);
      graw[h] = *(const u32x2*)(sg + (long)t * D + h * 256 + lane * 4);
    }
#pragma unroll
    for (int h = 0; h < 8; ++h) {
      const int c = h * 256 + lane * 4;
      float v[4] = {bf2f(raw[h].x & 0xffffu), bf2f(raw[h].x >> 16), bf2f(raw[h].y & 0xffffu), bf2f(raw[h].y >> 16)};
      const float mean = wave_sum(v[0] + v[1] + v[2] + v[3]) * (1.f / 256.f);
      float q = 0.f;
#pragma unroll
      for (int r = 0; r < 4; ++r) {
        v[r] -= mean;
        q += v[r] * v[r];
      }
      const float rs = rsqrtf(wave_sum(q) * (1.f / 256.f) + 1e-6f);
      const float gv[4] = {bf2f(graw[h].x & 0xffffu), bf2f(graw[h].x >> 16), bf2f(graw[h].y & 0xffffu), bf2f(graw[h].y >> 16)};
      const f32x4 gg = *(const f32x4*)(p.gn_g + c), gb = *(const f32x4*)(p.gn_b + c);
      f32x4 o;
#pragma unroll
      for (int r = 0; r < 4; ++r) o[r] = (v[r] * rs * gg[r] + gb[r]) * gv[r];
      *(u32x2*)(Y + (long)t * D + c) = pk4(o);
    }
  }
}
__device__ __forceinline__ void hy_conv_row(const u32x4 (&rm)[3], const u32x4 (&r0)[3], const u32x4 (&rp)[3], const float (&wv)[3][3][8],
                                            const float (&bv)[3][8], bf16_t* x0p, bf16_t* zp) {
  float u[3][8];
#pragma unroll
  for (int s3 = 0; s3 < 3; ++s3) {
#pragma unroll
    for (int e = 0; e < 8; ++e) u[s3][e] = bv[s3][e];
#pragma unroll
    for (int dt = 0; dt < 3; ++dt) {
      const u32x4 raw = (dt == 0) ? rm[s3] : ((dt == 1) ? r0[s3] : rp[s3]);
      const unsigned rw[4] = {raw.x, raw.y, raw.z, raw.w};
#pragma unroll
      for (int e = 0; e < 4; ++e) {
        u[s3][2 * e] += bf2f(rw[e] & 0xffffu) * wv[s3][dt][2 * e];
        u[s3][2 * e + 1] += bf2f(rw[e] >> 16) * wv[s3][dt][2 * e + 1];
      }
    }
  }
  u32x4 o0, oz;
  o0.x = pk2(u[0][0], u[0][1]);
  o0.y = pk2(u[0][2], u[0][3]);
  o0.z = pk2(u[0][4], u[0][5]);
  o0.w = pk2(u[0][6], u[0][7]);
  oz.x = pk2(u[1][0] * u[2][0], u[1][1] * u[2][1]);
  oz.y = pk2(u[1][2] * u[2][2], u[1][3] * u[2][3]);
  oz.z = pk2(u[1][4] * u[2][4], u[1][5] * u[2][5]);
  oz.w = pk2(u[1][6] * u[2][6], u[1][7] * u[2][7]);
  *(u32x4*)x0p = o0;
  *(u32x4*)zp = oz;
}
__device__ __forceinline__ void ph_hy_conv(const Params& p) {
  const bf16_t* phy = (const bf16_t*)(p.ws + OFF_PHY);
  bf16_t* x0 = (bf16_t*)(p.ws + OFF_X0);
  bf16_t* z = (bf16_t*)(p.ws + OFF_Z);
  const int c0 = TID * 8;
  float wv[3][3][8], bv[3][8];
#pragma unroll
  for (int s3 = 0; s3 < 3; ++s3) {
#pragma unroll
    for (int e = 0; e < 8; ++e) bv[s3][e] = p.conv_b[s3 * 2048 + c0 + e];
#pragma unroll
    for (int dt = 0; dt < 3; ++dt)
#pragma unroll
      for (int e = 0; e < 8; ++e) wv[s3][dt][e] = p.conv_w[dt * 6144 + s3 * 2048 + c0 + e];
  }
  const int nrows = T / GSZ;
  const int t0 = BID * nrows;
  u32x4 w0[3], w1[3], w2[3], w3[3], n0[3], n1[3];
#define HYC_LD(dst, tt)                                                                                   \
  {                                                                                                       \
    const int tt_ = (tt);                                                                                 \
    _Pragma("unroll") for (int s3 = 0; s3 < 3; ++s3)                                                      \
      dst[s3] = (tt_ >= 0 && tt_ < T) ? *(const u32x4*)(phy + (long)tt_ * 6144 + s3 * 2048 + c0) : (u32x4){0u, 0u, 0u, 0u}; \
  }
  HYC_LD(w0, t0 - 1)
  HYC_LD(w1, t0)
  HYC_LD(w2, t0 + 1)
  HYC_LD(w3, t0 + 2)
  for (int k = 0; k < nrows; k += 2) {
    const int t = t0 + k;
    HYC_LD(n0, t + 3)
    HYC_LD(n1, t + 4)
    hy_conv_row(w0, w1, w2, wv, bv, x0 + (long)t * D + c0, z + (long)t * D + c0);
    hy_conv_row(w1, w2, w3, wv, bv, x0 + (long)(t + 1) * D + c0, z + (long)(t + 1) * D + c0);
#pragma unroll
    for (int s3 = 0; s3 < 3; ++s3) { w0[s3] = w2[s3]; w1[s3] = w3[s3]; w2[s3] = n0[s3]; w3[s3] = n1[s3]; }
  }
#undef HYC_LD
}

__device__ __forceinline__ float2 cmul(float2 a, float2 b) { return make_float2(a.x * b.x - a.y * b.y, a.x * b.y + a.y * b.x); }
__device__ __forceinline__ float2 cmulc(float2 a, float2 b) { return make_float2(a.x * b.x + a.y * b.y, a.y * b.x - a.x * b.y); }
__device__ __forceinline__ float2 cadd(float2 a, float2 b) { return make_float2(a.x + b.x, a.y + b.y); }
__device__ __forceinline__ float2 csub(float2 a, float2 b) { return make_float2(a.x - b.x, a.y - b.y); }
__device__ __forceinline__ constexpr float w16c(int m) {
  m &= 15;
  return m == 0 ? 1.f : m == 1 ? 0.92387953251f : m == 2 ? 0.70710678119f : m == 3 ? 0.38268343237f : m == 4 ? 0.f
       : m == 5 ? -0.38268343237f : m == 6 ? -0.70710678119f : m == 7 ? -0.92387953251f : m == 8 ? -1.f
       : m == 9 ? -0.92387953251f : m == 10 ? -0.70710678119f : m == 11 ? -0.38268343237f : m == 12 ? 0.f
       : m == 13 ? 0.38268343237f : m == 14 ? 0.70710678119f : 0.92387953251f;
}
__device__ __forceinline__ constexpr float w16s(int m) { return w16c(m - 4); }
template <int SGN>
__device__ __forceinline__ void dft4(float2& a0, float2& a1, float2& a2, float2& a3) {
  const float2 s02 = cadd(a0, a2), d02 = csub(a0, a2), s13 = cadd(a1, a3), d13 = csub(a1, a3);
  const float2 jd = make_float2(-(float)SGN * d13.y, (float)SGN * d13.x);
  a0 = cadd(s02, s13);
  a1 = cadd(d02, jd);
  a2 = csub(s02, s13);
  a3 = csub(d02, jd);
}
template <int SGN>
__device__ __forceinline__ void dft16(float2 (&v)[16]) {
#pragma unroll
  for (int b = 0; b < 4; ++b) dft4<SGN>(v[b], v[4 + b], v[8 + b], v[12 + b]);
#pragma unroll
  for (int c = 1; c < 4; ++c)
#pragma unroll
    for (int b = 1; b < 4; ++b) {
      const float wr = w16c(b * c), wi = (float)SGN * w16s(b * c);
      const float2 t = v[4 * c + b];
      v[4 * c + b] = make_float2(t.x * wr - t.y * wi, t.x * wi + t.y * wr);
    }
#pragma unroll
  for (int c = 0; c < 4; ++c) dft4<SGN>(v[4 * c], v[4 * c + 1], v[4 * c + 2], v[4 * c + 3]);
}
template <int SGN>
__device__ __forceinline__ void dft8(float2 (&v)[8]) {
  dft4<SGN>(v[0], v[2], v[4], v[6]);
  dft4<SGN>(v[1], v[3], v[5], v[7]);
#pragma unroll
  for (int c = 1; c < 4; ++c) {
    const float wr = w16c(2 * c), wi = (float)SGN * w16s(2 * c);
    const float2 t = v[2 * c + 1];
    v[2 * c + 1] = make_float2(t.x * wr - t.y * wi, t.x * wi + t.y * wr);
  }
#pragma unroll
  for (int c = 0; c < 4; ++c) {
    const float2 t = v[2 * c], u = v[2 * c + 1];
    v[2 * c] = cadd(t, u);
    v[2 * c + 1] = csub(t, u);
  }
}
__device__ __forceinline__ void fft_tw_init(float2* TW) {
  __syncthreads();
  {
    float s, c;
    sincospif((float)TID * (1.f / 128.f), &s, &c);
    TW[TID] = make_float2(c, -s);
  }
  __syncthreads();
}
__device__ __forceinline__ float2 big_tw(int f1, int t2) {
  const float rev = (float)(f1 * t2) * (1.f / 32768.f);
  return make_float2(__builtin_amdgcn_cosf(rev), -__builtin_amdgcn_sinf(rev));
}
__device__ __forceinline__ void ph_taps(const Params& p, int g, bf16_t* lds) {
  GEMM_IDS
  const bf16_t* A = (const bf16_t*)(p.ws + OFF_H3B);
  const bf16_t* W = (const bf16_t*)(p.ws + OFF_W4T);
  bf16_t* TP = (bf16_t*)(p.ws + (g ? OFF_TAPS1 : OFF_TAPS));
  bool primed = false;
  for (int t = BID; t < 128 * 16; t += GSZ) {
    const int tn = t & 15, tm = t >> 4;
    const int wrow = (tn < 8) ? (g * 1024 + tn * 128) : (2048 + g * 1024 + (tn - 8) * 128);
    f32x4 acc[4][4];
    acc_zero(acc);
    const bf16_t *nA = nullptr, *nB = nullptr;
    if (t + GSZ < 128 * 16) {
      const int t2 = t + GSZ, tn2 = t2 & 15, tm2 = t2 >> 4;
      const int wrow2 = (tn2 < 8) ? (g * 1024 + tn2 * 128) : (2048 + g * 1024 + (tn2 - 8) * 128);
      nA = A + (long)tm2 * 128 * 64;
      nB = W + (long)wrow2 * 64;
    }
    gemm_acc<true>(acc, A + (long)tm * 128 * 64, 64, W + (long)wrow * 64, 64, 64, lds, nA, nB, primed);
    primed = nA != nullptr;
#pragma unroll
    for (int mi = 0; mi < 4; ++mi) {
      const int m = tm * 128 + 64 * wm + 16 * mi + l15;
#pragma unroll
      for (int ni = 0; ni < 4; ++ni) {
        const int n = tn * 128 + 64 * wn + 16 * ni + 4 * l4;
        *(u32x2*)(TP + (long)m * 2048 + n) = pk4(acc[mi][ni]);
      }
    }
  }
}
constexpr float KSCALE = 2.0f;
__device__ __forceinline__ void ph_fft_a(const Params& p, int g, char* ldsc) {
  float2* X = (float2*)ldsc;
  float2* TW = (float2*)(ldsc + 65536);
  const bf16_t* z = (const bf16_t*)(p.ws + OFF_Z);
  const bf16_t* TP = (const bf16_t*)(p.ws + (g ? OFF_TAPS1 : OFF_TAPS));
  float* sumsq = (float*)(p.ws + OFF_SUMSQ);
  unsigned* S = (unsigned*)(p.ws + OFF_S);
  const int ch = TID & 31, rg = TID >> 5;
  fft_tw_init(TW);
  for (int it = BID; it < 4096; it += GSZ) {
    const int t2 = it & 127, cc = it >> 7;
    const int c = g * 1024 + cc * 32 + ch;
    __syncthreads();
    {
      const float dec = fabsf(p.decay[c]);
      float ssq = 0.f;
      unsigned short rz[16], rt[32];
#pragma unroll
      for (int i = 0; i < 16; ++i) rz[i] = z[(long)(128 * (rg + 8 * i) + t2) * D + c];
#pragma unroll
      for (int i = 0; i < 32; ++i) {
        const int half = i >> 4, t1 = half * 128 + rg + 8 * (i & 15), j = 128 * t1 + t2;
        int jj = half ? (32768 - j) : j;
        if (jj >= 16384) jj = 0;
        rt[i] = TP[(long)jj * 2048 + half * 1024 + cc * 32 + ch];
      }
#pragma unroll
      for (int i = 0; i < 32; ++i) {
        const int half = i >> 4, t1 = half * 128 + rg + 8 * (i & 15), j = 128 * t1 + t2;
        int jj = half ? (32768 - j) : j;
        const bool zero = (jj >= 16384);
        if (zero) jj = 0;
        float val = bf2f(rt[i]) * __expf(-((float)jj * (1.f / 16383.f)) * dec);
        if (zero) val = 0.f;
        ssq += val * val;
        const float zr = (i < 16) ? bf2f(rz[i & 15]) : 0.f;
        X[t1 * 32 + ch] = make_float2(zr, val * KSCALE);
      }
      ((float*)(ldsc + 65536 + 2048))[TID] = ssq;
    }
    __syncthreads();
    if (TID < 32) {
      const float* red = (const float*)(ldsc + 65536 + 2048);
      float tot = 0.f;
#pragma unroll
      for (int r8 = 0; r8 < 8; ++r8) tot += red[r8 * 32 + TID];
      atomicAdd(&sumsq[c], tot);
    }
#pragma unroll 1
    for (int u = 0; u < 2; ++u) {
      const int j = rg + 8 * u;
      float2 v[16];
#pragma unroll
      for (int k = 0; k < 16; ++k) v[k] = X[(16 * k + j) * 32 + ch];
      dft16<-1>(v);
#pragma unroll
      for (int i = 0; i < 16; ++i) {
        const int q = (i >> 2) + 4 * (i & 3);
        X[(16 * q + j) * 32 + ch] = cmul(v[i], TW[(j * q) & 255]);
      }
    }
    __syncthreads();
#pragma unroll 1
    for (int u = 0; u < 2; ++u) {
      const int q = rg + 8 * u;
      float2 v[16];
#pragma unroll
      for (int j = 0; j < 16; ++j) v[j] = X[(16 * q + j) * 32 + ch];
      dft16<-1>(v);
      float2 twv[16];
      {
        const float2 st = big_tw(16, t2);
        twv[0] = big_tw(q, t2);
#pragma unroll
        for (int pp = 1; pp < 16; ++pp) twv[pp] = cmul(twv[pp - 1], st);
      }
#pragma unroll
      for (int i = 0; i < 16; ++i) {
        const int pp = (i >> 2) + 4 * (i & 3);
        const int r = 16 * q + pp;
        const float2 o = cmul(v[i], twv[pp]);
        S[((long)cc * 32768 + r * 128 + t2) * 32 + ch] = pk2(o.x, o.y);
      }
    }
  }
}
__device__ __forceinline__ void ph_fft_mid(const Params& p, char* lds_all) {
  const int hv = fresh_tid() >> 8;
  char* my = lds_all + hv * LDS_HALF;
  float2* XS = (float2*)my;
  float2* TW = (float2*)(my + 65536);
  unsigned* S = (unsigned*)(p.ws + OFF_S);
  const int ch = TID & 31, rg = TID >> 5;
  fft_tw_init(TW);
  unsigned rs[16];
  {
    const int pi0 = (int)blockIdx.x;
    const int P0 = pi0 & 127, cc0 = pi0 >> 7;
    const int f10 = (P0 == 0) ? (hv ? 128 : 0) : (hv ? 256 - P0 : P0);
    const int r0 = 16 * (f10 & 15) + (f10 >> 4);
    const long gb0 = ((long)cc0 * 32768 + r0 * 128) * 32 + ch;
#pragma unroll
    for (int k = 0; k < 16; ++k) rs[k] = S[gb0 + (8 * k + rg) * 32];
  }
  for (int pi = (int)blockIdx.x; pi < 4096; pi += (int)gridDim.x) {
    const int P = pi & 127, cc = pi >> 7;
    const int f1 = (P == 0) ? (hv ? 128 : 0) : (hv ? 256 - P : P);
    const int r = 16 * (f1 & 15) + (f1 >> 4);
    const long gbase = ((long)cc * 32768 + r * 128) * 32 + ch;
    const float2* XP = (P == 0) ? (const float2*)XS : (const float2*)(lds_all + (hv ^ 1) * LDS_HALF);
    __syncthreads();
    {
      const int j = rg;
      float2 v[16];
#pragma unroll
      for (int k = 0; k < 16; ++k) { const unsigned w_ = rs[k]; v[k] = make_float2(bf2f(w_ & 0xffffu), bf2f(w_ >> 16)); }
      dft16<-1>(v);
#pragma unroll
      for (int i = 0; i < 16; ++i) {
        const int q = (i >> 2) + 4 * (i & 3);
        XS[(8 * q + j) * 32 + ch] = cmul(v[i], TW[(2 * j * q) & 255]);
      }
    }
    {
      const int pin = pi + (int)gridDim.x;
      if (pin < 4096) {
        const int Pn = pin & 127, ccn = pin >> 7;
        const int f1n = (Pn == 0) ? (hv ? 128 : 0) : (hv ? 256 - Pn : Pn);
        const int rn = 16 * (f1n & 15) + (f1n >> 4);
        const long gbn = ((long)ccn * 32768 + rn * 128) * 32 + ch;
#pragma unroll
        for (int k = 0; k < 16; ++k) rs[k] = S[gbn + (8 * k + rg) * 32];
      }
    }
    __syncthreads();
    float2 a[2][8];
#pragma unroll
    for (int u = 0; u < 2; ++u) {
      const int q = rg + 8 * u;
#pragma unroll
      for (int j = 0; j < 8; ++j) a[u][j] = XS[(8 * q + j) * 32 + ch];
      dft8<-1>(a[u]);
#pragma unroll
      for (int pp = 0; pp < 8; ++pp) XS[(8 * q + pp) * 32 + ch] = a[u][2 * (pp & 3) + (pp >> 2)];
    }
    __syncthreads();
    float2 m[2][8];
#pragma unroll
    for (int u = 0; u < 2; ++u) {
      const int q = rg + 8 * u;
      const int sbase = (f1 != 0) ? (127 - 8 * q) : ((q > 0) ? (135 - 8 * q) : 8);
      const float2* xpb = XP + sbase * 32 + ch;
      const float2 bw0 = (f1 == 0 && q == 0) ? XP[ch] : xpb[0];
#pragma unroll
      for (int pp = 0; pp < 8; ++pp) {
        const float2 bw = (pp == 0) ? bw0 : xpb[-32 * pp];
        const float2 aw = a[u][2 * (pp & 3) + (pp >> 2)];
        const float dr = (aw.x * aw.x - aw.y * aw.y) - (bw.x * bw.x - bw.y * bw.y);
        const float di = 2.f * aw.x * aw.y + 2.f * bw.x * bw.y;
        m[u][pp] = make_float2(0.25f * di, -0.25f * dr);
      }
      dft8<1>(m[u]);
    }
    __syncthreads();
#pragma unroll
    for (int u = 0; u < 2; ++u) {
      const int q = rg + 8 * u;
#pragma unroll
      for (int i = 0; i < 8; ++i) {
        const int j = (i >> 1) + 4 * (i & 1);
        XS[(8 * q + j) * 32 + ch] = cmulc(m[u][i], TW[(2 * q * j) & 255]);
      }
    }
    __syncthreads();
    {
      const int j = rg;
      float2 v[16];
#pragma unroll
      for (int q = 0; q < 16; ++q) v[q] = XS[(8 * q + j) * 32 + ch];
      dft16<1>(v);
      float2 twv[16];
      {
        const float2 st = big_tw(f1, 8);
        twv[0] = big_tw(f1, j);
#pragma unroll
        for (int k = 1; k < 16; ++k) twv[k] = cmul(twv[k - 1], st);
      }
#pragma unroll
      for (int i = 0; i < 16; ++i) {
        const int k = (i >> 2) + 4 * (i & 3);
        const int t2 = 8 * k + j;
        const float2 o = cmulc(v[i], twv[k]);
        S[gbase + t2 * 32] = pk2(o.x, o.y);
      }
    }
  }
}
typedef __attribute__((address_space(3))) unsigned lds_cnt_t;
__device__ __forceinline__ void half_barrier(char* my, unsigned& gen) {
  lds_cnt_t* cnt = (lds_cnt_t*)(my + 68608);
  asm volatile("s_waitcnt lgkmcnt(0)" ::: "memory");
  gen += 4u;
  if ((threadIdx.x & 63u) == 0u) __hip_atomic_fetch_add(cnt, 1u, __ATOMIC_RELAXED, __HIP_MEMORY_SCOPE_WORKGROUP);
  unsigned spins = 0;
  while (__hip_atomic_load(cnt, __ATOMIC_RELAXED, __HIP_MEMORY_SCOPE_WORKGROUP) < gen) {
    __builtin_amdgcn_s_sleep(1);
    if (++spins > (1u << 22)) break;
  }
  asm volatile("s_waitcnt lgkmcnt(0)" ::: "memory");
}
__device__ __forceinline__ void ph_fft_c(const Params& p, int g, char* ldsc) {
  float2* X = (float2*)ldsc;
  float2* TW = (float2*)(ldsc + 65536);
  const unsigned* S = (const unsigned*)(p.ws + OFF_S);
  const bf16_t* z = (const bf16_t*)(p.ws + OFF_Z);
  bf16_t* x0 = (bf16_t*)(p.ws + OFF_X0);
  const float* sumsq = (const float*)(p.ws + OFF_SUMSQ);
  const int ch = TID & 31, rg = TID >> 5;
  if (TID == 0) *(lds_cnt_t*)(ldsc + 68608) = 0u;
  unsigned hgen = 0u;
  fft_tw_init(TW);
  unsigned raw[2][16];
  {
    const int it0 = BID;
    const int t20 = it0 & 127, cc0 = it0 >> 7;
#pragma unroll
    for (int u = 0; u < 2; ++u)
#pragma unroll
      for (int pp = 0; pp < 16; ++pp) raw[u][pp] = S[((long)cc0 * 32768 + (16 * (rg + 8 * u) + pp) * 128 + t20) * 32 + ch];
  }
  for (int it = BID; it < 4096; it += GSZ) {
    const int t2 = it & 127, cc = it >> 7;
    const int c = g * 1024 + cc * 32 + ch;
    half_barrier(ldsc, hgen);
    unsigned short zz[2][8], xx[2][8];
#pragma unroll
    for (int u = 0; u < 2; ++u)
#pragma unroll
      for (int k = 0; k < 8; ++k) {
        const long gi = (long)(128 * (16 * k + rg + 8 * u) + t2) * D + c;
        zz[u][k] = z[gi];
        xx[u][k] = x0[gi];
      }
#pragma unroll
    for (int u = 0; u < 2; ++u) {
      const int q = rg + 8 * u;
      float2 v[16];
#pragma unroll
      for (int pp = 0; pp < 16; ++pp) { const unsigned w_ = raw[u][pp]; v[pp] = make_float2(bf2f(w_ & 0xffffu), bf2f(w_ >> 16)); }
      dft16<1>(v);
#pragma unroll
      for (int i = 0; i < 16; ++i) {
        const int j = (i >> 2) + 4 * (i & 3);
        X[(16 * q + j) * 32 + ch] = cmulc(v[i], TW[(q * j) & 255]);
      }
    }
    {
      const int itn = it + GSZ;
      if (itn < 4096) {
        const int t2n = itn & 127, ccn = itn >> 7;
#pragma unroll
        for (int u = 0; u < 2; ++u)
#pragma unroll
          for (int pp = 0; pp < 16; ++pp) raw[u][pp] = S[((long)ccn * 32768 + (16 * (rg + 8 * u) + pp) * 128 + t2n) * 32 + ch];
      }
    }
    half_barrier(ldsc, hgen);
    const float nrm = rsqrtf(sumsq[c] + 1e-6f) * (1.f / (32768.f * KSCALE));
    const float sk = p.skip[c];
#pragma unroll
    for (int u = 0; u < 2; ++u) {
      const int j = rg + 8 * u;
      float2 v[16];
#pragma unroll
      for (int q = 0; q < 16; ++q) v[q] = X[(16 * q + j) * 32 + ch];
      dft16<1>(v);
#pragma unroll
      for (int i = 0; i < 16; ++i) {
        const int k = (i >> 2) + 4 * (i & 3);
        if (k < 8) {
          const int t1 = 16 * k + j;
          const long gi = (long)(128 * t1 + t2) * D + c;
          const float y = v[i].x * nrm + sk * bf2f(zz[u][k]);
          x0[gi] = f2bf(bf2f(xx[u][k]) * y);
        }
      }
    }
  }
}
__device__ __forceinline__ void ph_gemm_hyo(const Params& p, bf16_t* lds) {
  GEMM_IDS
  const bf16_t* A = (const bf16_t*)(p.ws + OFF_X0);
  const bf16_t* Bt = (const bf16_t*)(p.ws + OFF_WHO);
  bf16_t* ro = (bf16_t*)(p.ws + OFF_RETOUT);
  const bf16_t* gates = (const bf16_t*)(p.ws + OFF_GATES);
  bool primed = false;
  XCD_TILE_LOOP(t, 128 * 16) {
    int tm, tn;
    tile_map(t, 128, 16, tm, tn);
    f32x4 acc[4][4];
    acc_zero(acc);
#if !SKIP_HY
    const bf16_t *nA = nullptr, *nB = nullptr;
    if (t + (int)GSZ < 128 * 16) { int tm2, tn2; tile_map(t + GSZ, 128, 16, tm2, tn2); nA = A + (long)tm2 * 128 * D; nB = Bt + (long)tn2 * 128 * D; }
    gemm_acc<true>(acc, A + (long)tm * 128 * D, D, Bt + (long)tn * 128 * D, D, D, lds, nA, nB, primed);
    primed = nA != nullptr;
#endif
#pragma unroll
    for (int mi = 0; mi < 4; ++mi) {
      const int m = tm * 128 + 64 * wm + 16 * mi + l15;
#pragma unroll
      for (int ni = 0; ni < 4; ++ni) {
        const int n = tn * 128 + 64 * wn + 16 * ni + 4 * l4;
        const u32x2 r0 = *(const u32x2*)(ro + (long)m * D + n);
        const u32x2 g0 = *(const u32x2*)(gates + (long)m * 4096 + n);
        const u32x2 g1 = *(const u32x2*)(gates + (long)m * 4096 + 2048 + n);
        f32x4 o;
        o[0] = bf2f(g0.x & 0xffffu) * bf2f(r0.x & 0xffffu) + bf2f(g1.x & 0xffffu) * acc[mi][ni][0];
        o[1] = bf2f(g0.x >> 16) * bf2f(r0.x >> 16) + bf2f(g1.x >> 16) * acc[mi][ni][1];
        o[2] = bf2f(g0.y & 0xffffu) * bf2f(r0.y & 0xffffu) + bf2f(g1.y & 0xffffu) * acc[mi][ni][2];
        o[3] = bf2f(g0.y >> 16) * bf2f(r0.y >> 16) + bf2f(g1.y >> 16) * acc[mi][ni][3];
        *(u32x2*)(ro + (long)m * D + n) = pk4(o);
      }
    }
  }
}
__device__ __forceinline__ void ph_gemm_wout(const Params& p, bf16_t* lds) {
  GEMM_IDS
  const bf16_t* A = (const bf16_t*)(p.ws + OFF_RETOUT);
  const bf16_t* Bt = (const bf16_t*)(p.ws + OFF_WOUT);
  const float* gate = (const float*)(p.ws + OFF_MODS) + 5 * D;
  bool primed = false;
  XCD_TILE_LOOP(t, 128 * 16) {
    int tm, tn;
    tile_map(t, 128, 16, tm, tn);
    f32x4 acc[4][4];
    acc_zero(acc);
    const bf16_t *nA = nullptr, *nB = nullptr;
    if (t + (int)GSZ < 128 * 16) { int tm2, tn2; tile_map(t + GSZ, 128, 16, tm2, tn2); nA = A + (long)tm2 * 128 * D; nB = Bt + (long)tn2 * 128 * D; }
    gemm_acc<true>(acc, A + (long)tm * 128 * D, D, Bt + (long)tn * 128 * D, D, D, lds, nA, nB, primed);
    primed = nA != nullptr;
#pragma unroll
    for (int mi = 0; mi < 4; ++mi) {
      const int m = tm * 128 + 64 * wm + 16 * mi + l15;
#pragma unroll
      for (int ni = 0; ni < 4; ++ni) {
        const int n = tn * 128 + 64 * wn + 16 * ni + 4 * l4;
        float* op = p.out + (long)m * D + n;
        const f32x4 gt = *(const f32x4*)(gate + n);
        const f32x4 rs = *(const f32x4*)(op);
        *(f32x4*)(op) = rs + gt * acc[mi][ni];
      }
    }
  }
}


#define EPI_HEAD static constexpr bool PERM = false, AFTER_DRAIN = false;
typedef const f32x4 (&acc8_t)[2][2][4][2];
struct EpiSwiglu {
  EPI_HEAD
  bf16_t* H;
  __device__ __forceinline__ void operator()(acc8_t acc, const pg8::Unit& u, int wr, int wc, int fr, int fq) const {
#pragma unroll
    for (int ai = 0; ai < 2; ++ai)
#pragma unroll
      for (int m = 0; m < 4; ++m) {
        const int row = u.pm * 256 + ai * 128 + wr * 64 + m * 16 + fr;
#pragma unroll
        for (int n = 0; n < 2; ++n) {
          f32x4 o;
#pragma unroll
          for (int j = 0; j < 4; ++j) o[j] = silu_f(acc[ai][0][m][n][j]) * acc[ai][1][m][n][j];
          *(u32x2*)(H + (long)row * DFF + u.pn * 128 + wc * 32 + n * 16 + fq * 4) = pk4(o);
        }
      }
  }
};
struct EpiDown {
  EPI_HEAD
  const float* res; float* out; const float* gate;
  __device__ __forceinline__ void operator()(acc8_t acc, const pg8::Unit& u, int wr, int wc, int fr, int fq) const {
#pragma unroll
    for (int ai = 0; ai < 2; ++ai)
#pragma unroll
      for (int m = 0; m < 4; ++m) {
        const long ro = (long)(u.pm * 256 + ai * 128 + wr * 64 + m * 16 + fr) * D;
#pragma unroll
        for (int bj = 0; bj < 2; ++bj)
#pragma unroll
          for (int n = 0; n < 2; ++n) {
            const int col = u.pn * 256 + bj * 128 + wc * 32 + n * 16 + fq * 4;
            const f32x4 gt = *(const f32x4*)(gate + col);
            const f32x4 rs = *(const f32x4*)(res + ro + col);
            *(f32x4*)(out + ro + col) = rs + 0.5f * gt * acc[ai][bj][m][n];
          }
      }
  }
};
struct EpiPlain {
  EPI_HEAD
  bf16_t* C; int ldc;
  __device__ __forceinline__ void operator()(acc8_t acc, const pg8::Unit& u, int wr, int wc, int fr, int fq) const {
#pragma unroll
    for (int ai = 0; ai < 2; ++ai)
#pragma unroll
      for (int m = 0; m < 4; ++m) {
        const long ro = (long)(u.pm * 256 + ai * 128 + wr * 64 + m * 16 + fr) * ldc;
#pragma unroll
        for (int bj = 0; bj < 2; ++bj)
#pragma unroll
          for (int n = 0; n < 2; ++n) {
            const int col = u.pn * 256 + bj * 128 + wc * 32 + n * 16 + fq * 4;
            *(u32x2*)(C + ro + col) = pk4(acc[ai][bj][m][n]);
          }
      }
  }
};
struct EpiHyo {
  EPI_HEAD
  bf16_t* ro; const bf16_t* gates;
  __device__ __forceinline__ void operator()(acc8_t acc, const pg8::Unit& u, int wr, int wc, int fr, int fq) const {
#pragma unroll
    for (int ai = 0; ai < 2; ++ai)
#pragma unroll
      for (int m = 0; m < 4; ++m) {
        const long row = u.pm * 256 + ai * 128 + wr * 64 + m * 16 + fr;
#pragma unroll
        for (int bj = 0; bj < 2; ++bj)
#pragma unroll
          for (int n = 0; n < 2; ++n) {
            const int col = u.pn * 256 + bj * 128 + wc * 32 + n * 16 + fq * 4;
            const u32x2 r0 = *(const u32x2*)(ro + row * D + col);
            const u32x2 g0 = *(const u32x2*)(gates + row * 4096 + col);
            const u32x2 g1 = *(const u32x2*)(gates + row * 4096 + 2048 + col);
            const f32x4 a = acc[ai][bj][m][n];
            f32x4 o;
            o[0] = bf2f(g0.x & 0xffffu) * bf2f(r0.x & 0xffffu) + bf2f(g1.x & 0xffffu) * a[0];
            o[1] = bf2f(g0.x >> 16) * bf2f(r0.x >> 16) + bf2f(g1.x >> 16) * a[1];
            o[2] = bf2f(g0.y & 0xffffu) * bf2f(r0.y & 0xffffu) + bf2f(g1.y & 0xffffu) * a[2];
            o[3] = bf2f(g0.y >> 16) * bf2f(r0.y >> 16) + bf2f(g1.y >> 16) * a[3];
            *(u32x2*)(ro + row * D + col) = pk4(o);
          }
      }
  }
};
struct EpiWout {
  EPI_HEAD
  float* out; const float* gate;
  __device__ __forceinline__ void operator()(acc8_t acc, const pg8::Unit& u, int wr, int wc, int fr, int fq) const {
#pragma unroll
    for (int ai = 0; ai < 2; ++ai)
#pragma unroll
      for (int m = 0; m < 4; ++m) {
        const long ro = (long)(u.pm * 256 + ai * 128 + wr * 64 + m * 16 + fr) * D;
#pragma unroll
        for (int bj = 0; bj < 2; ++bj)
#pragma unroll
          for (int n = 0; n < 2; ++n) {
            const int col = u.pn * 256 + bj * 128 + wc * 32 + n * 16 + fq * 4;
            const f32x4 gt = *(const f32x4*)(gate + col);
            const f32x4 rs = *(const f32x4*)(out + ro + col);
            *(f32x4*)(out + ro + col) = rs + gt * acc[ai][bj][m][n];
          }
      }
  }
};
struct EpiWinA {
  EPI_HEAD
  bf16_t *q, *kk, *kTf, *kTb, *vT, *sg; const float2* rope; const float* lg;
  __device__ __forceinline__ void operator()(acc8_t acc, const pg8::Unit& u, int wr, int wc, int fr, int fq) const {
    const int pn = u.pn;
    if (pn < 8) {
      const bool isq = pn < 4;
      const int hh = wc >> 1, hf = wc & 1;
      const int head = 2 * (isq ? pn : pn - 4) + hh;
      const float scl = isq ? 0.08838834764831845f : 1.f;
      const float lgf = lg[head], lgb = lg[8 + head];
#pragma unroll
      for (int ai = 0; ai < 2; ++ai)
#pragma unroll
        for (int m = 0; m < 4; ++m) {
          const int t = u.pm * 256 + ai * 128 + wr * 64 + m * 16 + fr;
          const int pos = hf ? (t & 63) : (t >> 6);
          const int jc = t & 127;
          const float zf = __expf(lgf * (float)(127 - jc)), zb = __expf(lgb * (float)jc);
#pragma unroll
          for (int n = 0; n < 2; ++n) {
            const int i0 = 16 * n + 4 * fq;
            f32x4 o1, o2;
#pragma unroll
            for (int j = 0; j < 4; ++j) {
              const float2 cs = rope[pos * 32 + i0 + j];
              const float x1 = acc[ai][0][m][n][j] * scl, x2 = acc[ai][1][m][n][j] * scl;
              o1[j] = x1 * cs.x - x2 * cs.y;
              o2[j] = x1 * cs.y + x2 * cs.x;
            }
            const int cb = head * 128 + hf * 64 + i0;
            bf16_t* dp = (isq ? q : kk) + (long)t * 1024 + cb;
            *(u32x2*)(dp) = pk4(o1);
            *(u32x2*)(dp + 32) = pk4(o2);
            if (!isq) {
#pragma unroll
              for (int j = 0; j < 4; ++j) {
                kTf[(long)(cb + j) * TT + t] = f2bf(o1[j] * zf);
                kTb[(long)(cb + j) * TT + t] = f2bf(o1[j] * zb);
                kTf[(long)(cb + 32 + j) * TT + t] = f2bf(o2[j] * zf);
                kTb[(long)(cb + 32 + j) * TT + t] = f2bf(o2[j] * zb);
              }
            }
          }
        }
    } else if (pn < 16) {
#pragma unroll
      for (int ai = 0; ai < 2; ++ai)
#pragma unroll
        for (int m = 0; m < 4; ++m) {
          const int t = u.pm * 256 + ai * 128 + wr * 64 + m * 16 + fr;
#pragma unroll
          for (int bj = 0; bj < 2; ++bj)
#pragma unroll
            for (int n = 0; n < 2; ++n) {
              const int ch = (pn - 8) * 256 + bj * 128 + wc * 32 + n * 16 + fq * 4;
#pragma unroll
              for (int j = 0; j < 4; ++j) vT[(long)(ch + j) * TT + t] = f2bf(acc[ai][bj][m][n][j]);
            }
        }
    } else {
#pragma unroll
      for (int ai = 0; ai < 2; ++ai)
#pragma unroll
        for (int m = 0; m < 4; ++m) {
          const long t = u.pm * 256 + ai * 128 + wr * 64 + m * 16 + fr;
#pragma unroll
          for (int bj = 0; bj < 2; ++bj)
#pragma unroll
            for (int n = 0; n < 2; ++n) {
              const int col = (pn - 16) * 256 + bj * 128 + wc * 32 + n * 16 + fq * 4;
              f32x4 o;
#pragma unroll
              for (int j = 0; j < 4; ++j) o[j] = silu_f(acc[ai][bj][m][n][j]);
              *(u32x2*)(sg + t * D + col) = pk4(o);
            }
        }
    }
  }
};
struct EpiWinB {
  EPI_HEAD
  bf16_t *phy, *gates;
  __device__ __forceinline__ void operator()(acc8_t acc, const pg8::Unit& u, int wr, int wc, int fr, int fq) const {
    const int pn = u.pn;
#pragma unroll
    for (int ai = 0; ai < 2; ++ai)
#pragma unroll
      for (int m = 0; m < 4; ++m) {
        const long t = u.pm * 256 + ai * 128 + wr * 64 + m * 16 + fr;
#pragma unroll
        for (int bj = 0; bj < 2; ++bj)
#pragma unroll
          for (int n = 0; n < 2; ++n) {
            const int cl = bj * 128 + wc * 32 + n * 16 + fq * 4;
            if (pn < 48) {
              *(u32x2*)(phy + t * 6144 + (pn - 24) * 256 + cl) = pk4(acc[ai][bj][m][n]);
            } else {
              f32x4 o;
#pragma unroll
              for (int j = 0; j < 4; ++j) o[j] = sigm_f(acc[ai][bj][m][n][j]);
              *(u32x2*)(gates + t * 4096 + (pn - 48) * 256 + cl) = pk4(o);
            }
          }
      }
  }
};
template <class Epi>
__device__ __forceinline__ void big_gemm(char* lds_all, const bf16_t* A, const bf16_t* Bt, int K, int nM, int nN, int pn0, const Epi& E) {
  pg8::Gemm g;
  g.A = A; g.Bt = Bt; g.M = nM * 256; g.N = 0; g.K = K;
  pg8::TileOrder S;
  S.init(nM, nN, pn0, (int)gridDim.x, (int)blockIdx.x);
  pg8::gemm_phase(( __attribute__((address_space(3))) unsigned char*)lds_all, g, S, E);
}

__device__ __forceinline__ void ph_ctx_up(const Params& p, char* lds_all) {
  GEMM_IDS
  const int hv = fresh_tid() >> 8;
  bf16_t* lds = (bf16_t*)(lds_all + hv * LDS_HALF);
  u32x2* xch = (u32x2*)lds_all;
  const bf16_t* A = (const bf16_t*)(p.ws + OFF_AR) + (long)T * D;
  const bf16_t* Bt = (const bf16_t*)(p.ws + OFF_WBIG);
  bf16_t* H = (bf16_t*)(p.ws + OFF_H);
  for (int it = (int)blockIdx.x; it < 88; it += (int)gridDim.x) {
    const int tmc = it / 44, P = it % 44;
    f32x4 acc[4][4];
    acc_zero(acc);
    gemm_acc<true>(acc, A + (long)tmc * 128 * D, D, Bt + (long)(256 * P + 128 * hv) * D, D, D, lds);
    if (hv == 0) {
#pragma unroll
      for (int mi = 0; mi < 4; ++mi)
#pragma unroll
        for (int ni = 0; ni < 4; ++ni) {
          f32x4 o;
#pragma unroll
          for (int r = 0; r < 4; ++r) o[r] = silu_f(acc[mi][ni][r]);
          xch[(mi * 4 + ni) * 256 + TID] = pk4(o);
        }
    }
    __syncthreads();
    if (hv == 1) {
#pragma unroll
      for (int mi = 0; mi < 4; ++mi) {
        const int m = T + tmc * 128 + 64 * wm + 16 * mi + l15;
#pragma unroll
        for (int ni = 0; ni < 4; ++ni) {
          const int n = 128 * P + 64 * wn + 16 * ni + 4 * l4;
          const u32x2 w = xch[(mi * 4 + ni) * 256 + TID];
          f32x4 o;
          o[0] = bf2f(w.x & 0xffffu) * acc[mi][ni][0];
          o[1] = bf2f(w.x >> 16) * acc[mi][ni][1];
          o[2] = bf2f(w.y & 0xffffu) * acc[mi][ni][2];
          o[3] = bf2f(w.y >> 16) * acc[mi][ni][3];
          *(u32x2*)(H + (long)m * DFF + n) = pk4(o);
        }
      }
    }
  }
}
__device__ __forceinline__ void ph_ctx_down(const Params& p, bf16_t* lds) {
  GEMM_IDS
  const bf16_t* A = (const bf16_t*)(p.ws + OFF_H) + (long)T * DFF;
  const bf16_t* Bt = (const bf16_t*)(p.ws + OFF_WDOWN);
  const float* gate = (const float*)(p.ws + OFF_MODS) + NMOD + 2 * D;
  float* outc = (float*)(p.ws + OFF_CTX1);
  for (int it = BID; it < 128; it += GSZ) {
    const int ks = it & 3, tn = (it >> 2) & 15, tmc = it >> 6;
    f32x4 acc[4][4];
    acc_zero(acc);
    gemm_acc<true>(acc, A + (long)tmc * 128 * DFF + ks * 1408, DFF, Bt + (long)tn * 128 * DFF + ks * 1408, DFF, 1408, lds);
#pragma unroll
    for (int mi = 0; mi < 4; ++mi) {
      const int m = tmc * 128 + 64 * wm + 16 * mi + l15;
#pragma unroll
      for (int ni = 0; ni < 4; ++ni) {
        const int n = tn * 128 + 64 * wn + 16 * ni + 4 * l4;
        const f32x4 gt = *(const f32x4*)(gate + n);
#pragma unroll
        for (int r = 0; r < 4; ++r) atomicAdd(outc + (long)m * D + n + r, 0.5f * gt[r] * acc[mi][ni][r]);
      }
    }
  }
}
__device__ __forceinline__ void ph_ctx1_init(const Params& p) {
  f32x4* o = (f32x4*)(p.ws + OFF_CTX1);
  const f32x4* src = (const f32x4*)p.ctx;
  for (int i = BID * 256 + TID; i < 256 * D / 4; i += GSZ * 256) o[i] = src[i];
}
__device__ __forceinline__ void ph_ctx_win(const Params& p, char* lds_all) {
  GEMM_IDS
  const int hv = fresh_tid() >> 8;
  bf16_t* lds = (bf16_t*)(lds_all + hv * LDS_HALF);
  float* xacc = (float*)(lds_all + LDS_HALF);
  const bf16_t* A = (const bf16_t*)(p.ws + OFF_AR) + (long)T * D + hv * 1024;
  const bf16_t* Bt = (const bf16_t*)(p.ws + OFF_WBIG) + hv * 1024;
  bf16_t* kTf = (bf16_t*)(p.ws + OFF_KTF);
  bf16_t* kTb = (bf16_t*)(p.ws + OFF_KTB);
  bf16_t* vT = (bf16_t*)(p.ws + OFF_VT);
  for (int it = (int)blockIdx.x; it < 48; it += (int)gridDim.x) {
    f32x4 acc[4][4];
    acc_zero(acc);
    const bool isk = it < 16;
    const int u2 = it - 16;
    const int tmc = isk ? (it >> 3) : (u2 >> 4);
    const int kt8 = it & 7, tv = u2 & 15;
    if (isk)
      gemm_acc<true>(acc, A + (long)tmc * 128 * D, D, Bt + (long)(1024 + kt8 * 128) * D, D, 1024, lds);
    else
      gemm_acc<false>(acc, A + (long)tmc * 128 * D, D, Bt + (long)(2048 + tv * 128) * D, D, 1024, lds);
    if (hv == 1) {
#pragma unroll
      for (int mi = 0; mi < 4; ++mi)
#pragma unroll
        for (int ni = 0; ni < 4; ++ni) *(f32x4*)(xacc + ((mi * 4 + ni) * 256 + TID) * 4) = acc[mi][ni];
    }
    __syncthreads();
    if (hv == 0) {
#pragma unroll
      for (int mi = 0; mi < 4; ++mi)
#pragma unroll
        for (int ni = 0; ni < 4; ++ni) acc[mi][ni] += *(const f32x4*)(xacc + ((mi * 4 + ni) * 256 + TID) * 4);
      if (isk) {
        const int P = kt8 >> 1, sx = kt8 & 1;
        const int head = 2 * P + wn;
        const float lgf = p.lg[head], lgb = p.lg[8 + head];
#pragma unroll
        for (int mi = 0; mi < 4; ++mi) {
          const int m = T + tmc * 128 + 64 * wm + 16 * mi + l15;
          const int jc = m & 127;
          const float zf = __expf(lgf * (float)(127 - jc)), zb = __expf(lgb * (float)jc);
#pragma unroll
          for (int ni = 0; ni < 4; ++ni) {
            const int hf = ni >> 1, i0 = 16 * (ni & 1) + 4 * l4;
            const int cb = head * 128 + hf * 64 + i0 + 32 * sx;
#pragma unroll
            for (int r = 0; r < 4; ++r) {
              kTf[(long)(cb + r) * TT + m] = f2bf(acc[mi][ni][r] * zf);
              kTb[(long)(cb + r) * TT + m] = f2bf(acc[mi][ni][r] * zb);
            }
          }
        }
      } else {
#pragma unroll
        for (int mi = 0; mi < 4; ++mi) {
          const int m0 = T + tmc * 128 + 64 * wm + 16 * mi + 4 * l4;
#pragma unroll
          for (int ni = 0; ni < 4; ++ni) {
            const int ch = tv * 128 + 64 * wn + 16 * ni + l15;
            *(u32x2*)(vT + (long)ch * TT + m0) = pk4(acc[mi][ni]);
          }
        }
      }
    }
  }
}

#define XB_TMO      128
#define XB_XCNT(j)  (256  + 64 * (j))
#define XB_XSUB(j)  (1280 + 64 * (j))
#define XB_XGEN(j)  (2304 + 64 * (j))
#define XB_TOP      3328
#define XB_TOPGEN   3392
#define XCD_BAR_WORDS 3456
#define XB_SPIN_CAP (1u << 18)
#define LAS __attribute__((address_space(3)))

__device__ __forceinline__ unsigned xb_ld(unsigned* p)              { return __hip_atomic_load(p, __ATOMIC_RELAXED, __HIP_MEMORY_SCOPE_AGENT); }
__device__ __forceinline__ unsigned xb_add(unsigned* p, unsigned v) { return __hip_atomic_fetch_add(p, v, __ATOMIC_RELAXED, __HIP_MEMORY_SCOPE_AGENT); }
__device__ __forceinline__ unsigned xb_xcc_id() { return (unsigned)__builtin_amdgcn_s_getreg((3 << 11) | 20) & 0xFu; }
#define XB_SPIN(cond, bar) do { unsigned _sp = 0; while (cond) { __builtin_amdgcn_s_sleep(1); \
    if ((++_sp & 255u) == 0u) { if (xb_ld(&(bar)[XB_TMO])) break; if (_sp > XB_SPIN_CAP) { atomicAdd(&(bar)[XB_TMO], 1u); break; } } } } while (0)

struct XcdBarrier {
    unsigned* bar; unsigned x;
    volatile LAS unsigned* st;
};

__device__ __forceinline__ XcdBarrier xcd_barrier_post(unsigned* bar, volatile LAS unsigned* st) {
    XcdBarrier b; b.bar = bar; b.x = xb_xcc_id(); b.st = st;
    if (threadIdx.x == 0) (void)xb_add(&bar[XB_XCNT(b.x)], 1u);
    return b;
}
__device__ __forceinline__ void xcd_barrier_complete(unsigned* bar, unsigned x, unsigned& nloc, unsigned& nx) {
    const unsigned G = gridDim.x * gridDim.y * gridDim.z;
    unsigned sum, cnt, mine, sp = 0u;
    for (;;) {
        sum = 0u; cnt = 0u; mine = 0u;
#pragma unroll
        for (unsigned j = 0; j < 16; ++j) { const unsigned c = xb_ld(&bar[XB_XCNT(j)]); sum += c; cnt += (c > 0u) ? 1u : 0u; mine = (j == x) ? c : mine; }
        if (sum == G) break;
        __builtin_amdgcn_s_sleep(1);
        if ((++sp & 255u) == 0u) { if (xb_ld(&bar[XB_TMO])) break; if (sp > XB_SPIN_CAP) { atomicAdd(&bar[XB_TMO], 1u); break; } }
    }
    nloc = mine > 0u ? mine : 1u; nx = cnt > 0u ? cnt : 1u;
}

__device__ __forceinline__ void xcd_barrier(const XcdBarrier& b) {
    asm volatile("s_waitcnt vmcnt(0)" ::: "memory");
    __syncthreads();
    if (threadIdx.x == 0) {
        unsigned* bar = b.bar;
        __builtin_amdgcn_s_waitcnt(0);
        unsigned nloc = b.st[0], nx = b.st[1];
        if (nloc == 0u) { xcd_barrier_complete(bar, b.x, nloc, nx); b.st[0] = nloc; b.st[1] = nx; }
        const unsigned old = xb_add(&bar[XB_XSUB(b.x)], 1u);
        const unsigned gen = old / nloc;
        if (old + 1u == (gen + 1u) * nloc) {
            __builtin_amdgcn_fence(__ATOMIC_RELEASE, "agent");
            asm volatile("s_waitcnt vmcnt(0)" ::: "memory");
            const unsigned og = xb_add(&bar[XB_TOP], 1u);
            const unsigned tg = og / nx;
            if (og + 1u == (tg + 1u) * nx) xb_add(&bar[XB_TOPGEN], 1u);
            else XB_SPIN(xb_ld(&bar[XB_TOPGEN]) == tg, bar);
            __builtin_amdgcn_fence(__ATOMIC_ACQUIRE, "agent");
            xb_add(&bar[XB_XGEN(b.x)], 1u);
            asm volatile("s_waitcnt vmcnt(0)" ::: "memory");
        } else {
            XB_SPIN(xb_ld(&bar[XB_XGEN(b.x)]) == gen, bar);
            __builtin_amdgcn_fence(__ATOMIC_ACQUIRE, "agent");
            asm volatile("s_waitcnt vmcnt(0)" ::: "memory");
        }
    }
    __syncthreads();
}


__device__ __forceinline__ void gbar(unsigned* ctr, unsigned target) {
  asm volatile("s_waitcnt vmcnt(0) lgkmcnt(0)" ::: "memory");
  __syncthreads();
  if (threadIdx.x == 0) {
    __builtin_amdgcn_fence(__ATOMIC_RELEASE, "agent");
    asm volatile("s_waitcnt vmcnt(0)" ::: "memory");
    __hip_atomic_fetch_add(ctr, 1u, __ATOMIC_RELAXED, __HIP_MEMORY_SCOPE_AGENT);
    unsigned spins = 0;
    while (__hip_atomic_load(ctr, __ATOMIC_RELAXED, __HIP_MEMORY_SCOPE_AGENT) < target) {
      __builtin_amdgcn_s_sleep(2);
      if (++spins > (1u << 20)) break;
    }
    __builtin_amdgcn_fence(__ATOMIC_ACQUIRE, "agent");
    asm volatile("s_waitcnt vmcnt(0)" ::: "memory");
  }
  __syncthreads();
}
#ifndef SKIP_HY
#define SKIP_HY 0
#endif
#ifndef ONLY_NORM
#define ONLY_NORM 0
#endif
#ifndef SKIP_MIXER
#define SKIP_MIXER 0
#endif

__global__ void __launch_bounds__(512, 2) mega(Params p, int lo, int hi) {
  __shared__ __attribute__((aligned(1024))) char ldsc_all[LDS_BYTES];
#define ldsc (ldsc_all + (fresh_tid() >> 8) * LDS_HALF)
  cg::grid_group grid = cg::this_grid();
#define lds ((bf16_t*)ldsc)
#define ldsf ((float*)ldsc)
  char* ws = p.ws;
  volatile LAS unsigned* xb_st = (volatile LAS unsigned*)(ldsc_all + LDS_BYTES - 16);
  if (threadIdx.x == 0) { xb_st[0] = 0u; xb_st[1] = 0u; }
  __syncthreads();
  const XcdBarrier xb = xcd_barrier_post((unsigned*)(ws + OFF_BAR), xb_st);
#define PH(k, body) if (lo <= (k) && (k) < hi) { body; if ((k) + 1 < hi) xcd_barrier(xb); }
  if (lo < 0) grid.sync();
  PH(0, ph_mods_partial(p, ldsf))
  PH(2, ph_prenorm(p, p.x, p.ctx, TT, p.norm_g, 0);
        conv_weight(p.ffn_up, 2048, 11264, 11264, (bf16_t*)(ws + OFF_WBIG), 2, ldsf);
        conv_weight(p.ffn_down, 5632, 2048, 2048, (bf16_t*)(ws + OFF_WDOWN), 0, ldsf);
        conv_weight(p.w4, 64, 4096, 4096, (bf16_t*)(ws + OFF_W4T), 0, ldsf);
        conv_weight(p.w_ret_o, 2048, 2048, 2048, (bf16_t*)(ws + OFF_WRO), 0, ldsf);
        conv_weight(p.w_hy_o, 2048, 2048, 2048, (bf16_t*)(ws + OFF_WHO), 0, ldsf);
        conv_weight(p.w_out, 2048, 2048, 2048, (bf16_t*)(ws + OFF_WOUT), 0, ldsf);
        ph_misc0(p))
  PH(3, big_gemm(ldsc_all, (const bf16_t*)(ws + OFF_AR), (const bf16_t*)(ws + OFF_WBIG), 2048, 64, 44, 0, EpiSwiglu{(bf16_t*)(ws + OFF_H)});
        ph_ctx_up(p, ldsc_all); ph_ctx1_init(p))
  PH(4, big_gemm(ldsc_all, (const bf16_t*)(ws + OFF_H), (const bf16_t*)(ws + OFF_WDOWN), 5632, 64, 8, 0, EpiDown{p.x, p.out, (const float*)(ws + OFF_MODS) + 2 * D});
        ph_ctx_down(p, lds))
  PH(5, ph_prenorm(p, p.out, (const float*)(ws + OFF_CTX1), TT, p.norm_g + D, 1);
        conv_weight(p.w_in, 2048, 16384, 16384, (bf16_t*)(ws + OFF_WBIG), 3, ldsf))
#if !SKIP_MIXER
  PH(6, big_gemm(ldsc_all, (const bf16_t*)(ws + OFF_AR), (const bf16_t*)(ws + OFF_WBIG), 2048, 64, 24, 0,
                 EpiWinA{(bf16_t*)(ws + OFF_Q), (bf16_t*)(ws + OFF_K), (bf16_t*)(ws + OFF_KTF), (bf16_t*)(ws + OFF_KTB), (bf16_t*)(ws + OFF_VT), (bf16_t*)(ws + OFF_SG), (const float2*)(ws + OFF_ROPE), p.lg});
        ph_ctx_win(p, ldsc_all))
  PH(7, ph_ret_kv_p(p, lds))
  PH(8, ph_ret_scan(p))
  PH(9, ph_ret_out(p, ldsc_all))
  PH(11, big_gemm(ldsc_all, (const bf16_t*)(ws + OFF_Y), (const bf16_t*)(ws + OFF_WRO), 2048, 64, 8, 0, EpiPlain{(bf16_t*)(ws + OFF_RETOUT), D}))
  PH(12, big_gemm(ldsc_all, (const bf16_t*)(ws + OFF_AR), (const bf16_t*)(ws + OFF_WBIG), 2048, 64, 40, 24, EpiWinB{(bf16_t*)(ws + OFF_PHY), (bf16_t*)(ws + OFF_GATES)}))
#if !SKIP_HY
  PH(13, ph_hy_conv(p); ph_taps(p, 0, lds); ph_taps(p, 1, lds))
#endif
#if !SKIP_HY
  PH(15, ph_fft_a(p, 0, ldsc))
  PH(16, ph_fft_mid(p, ldsc_all))
  PH(17, ph_fft_c(p, 0, ldsc))
  PH(19, ph_fft_a(p, 1, ldsc))
  PH(20, ph_fft_mid(p, ldsc_all))
  PH(21, ph_fft_c(p, 1, ldsc))
#endif
  PH(26, big_gemm(ldsc_all, (const bf16_t*)(ws + OFF_X0), (const bf16_t*)(ws + OFF_WHO), 2048, 64, 8, 0, EpiHyo{(bf16_t*)(ws + OFF_RETOUT), (const bf16_t*)(ws + OFF_GATES)}))
  PH(27, big_gemm(ldsc_all, (const bf16_t*)(ws + OFF_RETOUT), (const bf16_t*)(ws + OFF_WOUT), 2048, 64, 8, 0, EpiWout{p.out, (const float*)(ws + OFF_MODS) + 5 * D}))
#endif
  PH(28, ph_prenorm(p, p.out, p.out, T, p.norm_g + 2 * D, 2);
         conv_weight(p.ffn_up + (long)2048 * 11264, 2048, 11264, 11264, (bf16_t*)(ws + OFF_WBIG), 2, ldsf);
         conv_weight(p.ffn_down + (long)5632 * 2048, 5632, 2048, 2048, (bf16_t*)(ws + OFF_WDOWN), 0, ldsf))
  PH(29, big_gemm(ldsc_all, (const bf16_t*)(ws + OFF_AR), (const bf16_t*)(ws + OFF_WBIG), 2048, 64, 44, 0, EpiSwiglu{(bf16_t*)(ws + OFF_H)}))
  PH(30, big_gemm(ldsc_all, (const bf16_t*)(ws + OFF_H), (const bf16_t*)(ws + OFF_WDOWN), 5632, 64, 8, 0, EpiDown{p.out, p.out, (const float*)(ws + OFF_MODS) + 8 * D}))
  PH(31, ph_final_norm(p))
}

extern "C" void kernel_launch(void* const* d_in, const int* in_sizes, int n_in, void* d_out, int out_size, void* d_ws,
                              size_t ws_size, hipStream_t stream) {
  if (ws_size < (size_t)WS_NEED || n_in < 29) {
    fprintf(stderr, "workspace too small: %zu\n", ws_size);
    return;
  }
  static int grid_blocks = 0;
  if (!grid_blocks) {
    int dev = 0, cus = 0, per_cu = 0;
    hipGetDevice(&dev);
    hipDeviceGetAttribute(&cus, hipDeviceAttributeMultiprocessorCount, dev);
    hipOccupancyMaxActiveBlocksPerMultiprocessor(&per_cu, mega, 512, 0);
    if (per_cu > 1) per_cu = 1;
    if (per_cu < 1) per_cu = 1;
    grid_blocks = cus * per_cu;
  }
  Params p{};
  const float** pp = (const float**)&p;
  for (int i = 0; i < 29; ++i) pp[i] = (const float*)d_in[i];
  p.out = (float*)d_out;
  p.ws = (char*)d_ws;
  hipMemsetAsync((char*)d_ws + OFF_BAR, 0, XCD_BAR_WORDS * 4, stream);
  hipMemsetAsync((char*)d_ws + OFF_MODS, 0, 2 * NMOD * 4, stream);
  int lo = 0, hi = NPH;
  void* args[] = {&p, &lo, &hi};
  hipError_t e = hipLaunchCooperativeKernel((void*)mega, dim3(grid_blocks), dim3(512), args, 0, stream);
  if (e != hipSuccess) fprintf(stderr, "cooperative launch failed: %s (grid %d)\n", hipGetErrorString(e), grid_blocks);
}
```

```cpp
#include <hip/hip_runtime.h>
#include <hip/hip_cooperative_groups.h>
#include <cstdio>
namespace cg = cooperative_groups;

typedef unsigned short bf16_t;
typedef short bf16x8 __attribute__((ext_vector_type(8)));
typedef float f32x4 __attribute__((ext_vector_type(4)));
typedef unsigned u32x2 __attribute__((ext_vector_type(2)));
typedef unsigned u32x4 __attribute__((ext_vector_type(4)));

__device__ __forceinline__ int fresh_tid() { int t = (int)threadIdx.x; asm volatile("" : "+v"(t)); return t; }
#define TID (fresh_tid() & 255)
#define BID ((int)(blockIdx.x * 2u) + (fresh_tid() >> 8))
#define GSZ ((int)(gridDim.x * 2u))
constexpr int T = 16384, TT = 16640, D = 2048, DFF = 5632;
constexpr long MiB = 1l << 20;
constexpr int NMOD = 18432;
constexpr long OFF_MODSPART = 0;
constexpr long OFF_MODS = 5 * MiB;
constexpr long OFF_SUMSQ = 5 * MiB + 512 * 1024;
constexpr long OFF_ROPE = 6 * MiB;
constexpr long OFF_BAR = 5 * MiB + 768 * 1024;
constexpr long OFF_CTX1 = 7 * MiB;
constexpr long OFF_H3B = 13 * MiB, OFF_W4T = 15 * MiB;
constexpr long OFF_TAPS = 104 * MiB, OFF_TAPS1 = 40 * MiB;
constexpr long OFF_WRO = 16 * MiB, OFF_WHO = 24 * MiB, OFF_WOUT = 32 * MiB;
constexpr long OFF_WBIG = 40 * MiB, OFF_WDOWN = 84 * MiB;
constexpr long OFF_AR = 106 * MiB;
constexpr long OFF_H = 171 * MiB;
constexpr long OFF_Q = 171 * MiB, OFF_K = 203 * MiB, OFF_KTF = 235 * MiB, OFF_KTB = 268 * MiB, OFF_VT = 301 * MiB,
               OFF_SG = 366 * MiB, OFF_KVT = 430 * MiB, OFF_P = 560 * MiB, OFF_Y = 592 * MiB;
constexpr long OFF_RETOUT = 171 * MiB, OFF_GATES = 235 * MiB, OFF_X0 = 363 * MiB, OFF_Z = 427 * MiB, OFF_PHY = 491 * MiB;
constexpr long OFF_S = 491 * MiB, OFF_KC = 40 * MiB;
constexpr long WS_NEED = 683 * MiB;
constexpr int LDS_HALF = 69632;
constexpr int LDS_BYTES = 2 * LDS_HALF;
constexpr int NPH = 32;
#ifndef SKIP_HY
#define SKIP_HY 0
#endif

struct Params {
  const float *x, *c, *ctx, *c_ctx, *w_ada, *b_ada, *norm_g, *ffn_up, *ffn_down, *w_in, *lg, *gn_g, *gn_b, *w_ret_o,
      *conv_w, *conv_b, *w1, *b1, *w2, *b2, *w3, *b3, *w4, *freq, *decay, *skip, *w_hy_o, *w_out, *fin_g;
  float* out;
  char* ws;
};

__device__ __forceinline__ float bf2f(unsigned h) { return __uint_as_float(h << 16); }
typedef float f32x2_t __attribute__((ext_vector_type(2)));
typedef __bf16 bf16x2_t __attribute__((ext_vector_type(2)));
__device__ __forceinline__ unsigned pk2(float lo, float hi) {
  const f32x2_t v = {lo, hi};
  const bf16x2_t b = __builtin_convertvector(v, bf16x2_t);
  return __builtin_bit_cast(unsigned, b);
}
__device__ __forceinline__ bf16_t f2bf(float f) { return (bf16_t)(pk2(f, 0.f) & 0xffffu); }
__device__ __forceinline__ u32x2 pk4(f32x4 v) {
  u32x2 r;
  r.x = pk2(v[0], v[1]);
  r.y = pk2(v[2], v[3]);
  return r;
}
__device__ __forceinline__ float wave_sum(float v) {
#pragma unroll
  for (int o = 32; o > 0; o >>= 1) v += __shfl_xor(v, o);
  return v;
}
__device__ __forceinline__ float silu_f(float v) { return v * __builtin_amdgcn_rcpf(1.f + __expf(-v)); }
__device__ __forceinline__ float sigm_f(float v) { return __builtin_amdgcn_rcpf(1.f + __expf(-v)); }

typedef __attribute__((address_space(3))) unsigned lds_u32_t;
template <bool SWAP>
__device__ __forceinline__ void gemm_acc(f32x4 (&acc)[4][4], const bf16_t* A, long lda, const bf16_t* Bt, long ldb, int K,
                                         bf16_t* lds, const bf16_t* nA = nullptr, const bf16_t* nB = nullptr,
                                         bool primed = false, long nlda = -1, long nldb = -1) {
  const int tid = TID, lane = tid & 63, w = tid >> 6, wm = w >> 1, wn = w & 1;
  char* ldsb = (char*)lds;
  const int chunk = (tid & 7) ^ ((tid >> 4) & 7);
  const int oa = (tid >> 3) * (int)lda + chunk * 8, ob = (tid >> 3) * (int)ldb + chunk * 8;
  const int sa = 32 * (int)lda, sb = 32 * (int)ldb;
  const int nk = K >> 6;
  if (!primed) {
    __syncthreads();
#pragma unroll
    for (int i = 0; i < 4; ++i) {
      __builtin_amdgcn_global_load_lds((const unsigned*)(A + (oa + i * sa)), (lds_u32_t*)(ldsb + tid * 16 + i * 4096), 16, 0, 0);
      __builtin_amdgcn_global_load_lds((const unsigned*)(Bt + (ob + i * sb)), (lds_u32_t*)(ldsb + 16384 + tid * 16 + i * 4096), 16, 0, 0);
    }
  }
  asm volatile("s_waitcnt vmcnt(0)" ::: "memory");
  __syncthreads();
  const int l15 = lane & 15, l4 = lane >> 4;
  const int o0 = l15 * 128 + ((l4 ^ (l15 >> 1)) << 4);
  for (int kt = 0; kt < nk; ++kt) {
    const int cur = kt & 1;
    if (kt + 1 < nk) {
      char* d = ldsb + (cur ^ 1) * 32768 + tid * 16;
#pragma unroll
      for (int i = 0; i < 4; ++i) {
        __builtin_amdgcn_global_load_lds((const unsigned*)(A + (oa + i * sa + (kt + 1) * 64)), (lds_u32_t*)(d + i * 4096), 16, 0, 0);
        __builtin_amdgcn_global_load_lds((const unsigned*)(Bt + (ob + i * sb + (kt + 1) * 64)), (lds_u32_t*)(d + 16384 + i * 4096), 16, 0, 0);
      }
    }
    const char* la = ldsb + cur * 32768 + (64 * wm) * 128;
    const char* lb = ldsb + cur * 32768 + 16384 + (64 * wn) * 128;
#pragma unroll
    for (int ks = 0; ks < 2; ++ks) {
      bf16x8 af[4], bfr[4];
#pragma unroll
      for (int i = 0; i < 4; ++i) {
        af[i] = *(const bf16x8*)(la + i * 2048 + (o0 ^ (ks * 64)));
        bfr[i] = *(const bf16x8*)(lb + i * 2048 + (o0 ^ (ks * 64)));
      }
#pragma unroll
      for (int mi = 0; mi < 4; ++mi)
#pragma unroll
        for (int ni = 0; ni < 4; ++ni) {
          if (SWAP)
            acc[mi][ni] = __builtin_amdgcn_mfma_f32_16x16x32_bf16(bfr[ni], af[mi], acc[mi][ni], 0, 0, 0);
          else
            acc[mi][ni] = __builtin_amdgcn_mfma_f32_16x16x32_bf16(af[mi], bfr[ni], acc[mi][ni], 0, 0, 0);
        }
    }
    asm volatile("s_waitcnt vmcnt(0)" ::: "memory");
    __syncthreads();
  }
  if (nA != nullptr) {
    const int la2 = (nlda < 0) ? (int)lda : (int)nlda, lb2 = (nldb < 0) ? (int)ldb : (int)nldb;
    const int oa2 = (tid >> 3) * la2 + chunk * 8, ob2 = (tid >> 3) * lb2 + chunk * 8;
#pragma unroll
    for (int i = 0; i < 4; ++i) {
      __builtin_amdgcn_global_load_lds((const unsigned*)(nA + (oa2 + i * 32 * la2)), (lds_u32_t*)(ldsb + tid * 16 + i * 4096), 16, 0, 0);
      __builtin_amdgcn_global_load_lds((const unsigned*)(nB + (ob2 + i * 32 * lb2)), (lds_u32_t*)(ldsb + 16384 + tid * 16 + i * 4096), 16, 0, 0);
    }
  }
}
__device__ __forceinline__ void acc_zero(f32x4 (&acc)[4][4]) {
#pragma unroll
  for (int i = 0; i < 4; ++i)
#pragma unroll
    for (int j = 0; j < 4; ++j) acc[i][j] = (f32x4){0.f, 0.f, 0.f, 0.f};
}
__device__ __forceinline__ void tile_map(int t, int ntm, int ntn, int& tm, int& tn) {
  const int GM = 8;
  const int per = GM * ntn;
  const int g = t / per, fm = g * GM;
  const int gsz = (ntm - fm) < GM ? (ntm - fm) : GM;
  const int rem = t - g * per;
  tn = rem / gsz;
  tm = fm + rem % gsz;
}

namespace pg8 {
#define PG8_LAS __attribute__((address_space(3)))
constexpr int BM = 256, BK = 64, HALF = 128, HTB = HALF * BK * 2  , STAGE_BYTES = 8 * HTB, NXCD = 8, WGM = 8;

__host__ __device__ __forceinline__ int lds_byte(int r, int c) { const int st = (r >> 4) * 2 + (c >> 5), rr = r & 15, cc = c & 31, ob = rr * 64 + cc * 2; return st * 1024 + (ob ^ (((ob >> 9) & 1) << 5)); }
__host__ __device__ __forceinline__ void stage_rc(int b, int& R, int& C) { const int st = b / 1024, sb = b % 1024, swz = sb ^ (((sb >> 9) & 1) << 5); R = (st >> 1) * 16 + swz / 64; C = (st & 1) * 32 + (swz % 64) / 2; }
__host__ __device__ __forceinline__ int perm32(int rho) { const int n = rho >> 4, i = rho & 15; return 8 * (i >> 2) + 4 * n + (i & 3); }

struct Unit { int pm, pn; };
struct Gemm { const bf16_t* A; const bf16_t* Bt; int M, N, K; };

struct TileOrder {
  int nM, nN, nwg, G, c, pn0;
  __device__ __forceinline__ void init(int nM_, int nN_, int pn0_, int G_, int c_) { nM = nM_; nN = nN_; nwg = nM_ * nN_; G = G_; c = c_; pn0 = pn0_; }
  __device__ __forceinline__ bool next(int i, Unit& u) const {
    const long L = (long)i * G + c;
    if (L >= nwg) return false;
    int wgid = (int)L;
    { const int q = nwg / NXCD, r = nwg % NXCD, xcd = wgid % NXCD, off = wgid / NXCD; wgid = (xcd < r ? xcd * (q + 1) : r * (q + 1) + (xcd - r) * q) + off; }
    const int nig = WGM * nN, gid = wgid / nig, fm = gid * WGM, gsz = (nM - fm) < WGM ? (nM - fm) : WGM;
    u.pm = fm + ((wgid % nig) % gsz);
    u.pn = pn0 + (wgid % nig) / gsz;
    return true;
  }
  __device__ __forceinline__ void a_ready(const Unit&) const {}
  __device__ __forceinline__ void done(const Unit&) const {}
};

template <class Epi, class Sched>
__device__ __forceinline__ void gemm_phase(PG8_LAS unsigned char* lds, const Gemm g, const Sched& S, const Epi& E) {
    const int tid = threadIdx.x, wid = __builtin_amdgcn_readfirstlane(tid >> 6), lane = tid & 63, wr = wid >> 2, wc = wid & 3, fr = lane & 15, fq = lane >> 4;
    const int K = g.K, nt = K / BK;
#define PG8_STAMP() do { } while (0)
    PG8_STAMP();
    unsigned voffA[2], voffB[2];
#pragma unroll
    for (int i = 0; i < 2; ++i) { int R, C; stage_rc(tid * 16 + i * 8192, R, C); const int Rb = Epi::PERM ? ((R & ~31) + perm32(R & 31)) : R;
        voffA[i] = (unsigned)(R * K + C) * 2u; voffB[i] = (unsigned)(Rb * K + C) * 2u; }
    const size_t kstep = (size_t)(BK * 2);
    const size_t hstep = (size_t)HALF * K * 2;
    const size_t tstep = 2 * hstep;
    const unsigned ldsw = (unsigned)wid * 1024u;
    const int aoff = lds_byte(wr * 64 + fr, fq * 8), boff = lds_byte(wc * 32 + fr, fq * 8);
#define PG8_SA(b, h) (((b) * 2 + (h)) * HTB)
#define PG8_SB(b, h) ((4 + (b) * 2 + (h)) * HTB)
#define PG8_STAGE(bufoff, gbase, voff) do { _Pragma("unroll") for (int _i = 0; _i < 2; ++_i) \
        __builtin_amdgcn_global_load_lds((const unsigned*)((const char*)(gbase) + (voff)[_i]), (PG8_LAS unsigned*)(lds + (bufoff) + ldsw + _i * 8192), 16, 0, 0); } while (0)
#define PG8_LDA(dst, b, h) do { _Pragma("unroll") for (int m = 0; m < 4; ++m) _Pragma("unroll") for (int k = 0; k < 2; ++k) dst[m][k] = *(const PG8_LAS bf16x8*)(lds + PG8_SA(b, h) + aoff + m * 2048 + k * 1024); } while (0)
#define PG8_LDB(dst, b, h) do { _Pragma("unroll") for (int n = 0; n < 2; ++n) _Pragma("unroll") for (int k = 0; k < 2; ++k) dst[n][k] = *(const PG8_LAS bf16x8*)(lds + PG8_SB(b, h) + boff + n * 2048 + k * 1024); } while (0)
#define PG8_MMA(ai, bj, At, Bt) do { __builtin_amdgcn_s_setprio(1); _Pragma("unroll") for (int m = 0; m < 4; ++m) _Pragma("unroll") for (int n = 0; n < 2; ++n) _Pragma("unroll") for (int k = 0; k < 2; ++k) \
        acc[ai][bj][m][n] = __builtin_amdgcn_mfma_f32_16x16x32_bf16(Bt[n][k], At[m][k], acc[ai][bj][m][n], 0, 0, 0); __builtin_amdgcn_s_setprio(0); } while (0)
#define PG8_WAIT_V(n) asm volatile("s_waitcnt vmcnt(" #n ")" ::: "memory")
#define PG8_WAIT_L(n) asm volatile("s_waitcnt lgkmcnt(" #n ")" ::: "memory")
#define PG8_BAR __builtin_amdgcn_s_barrier()
#define PG8_SCHED __builtin_amdgcn_sched_barrier(0)
    Unit cur, nxt; int ui = 0;
    if (!S.next(0, cur)) return;
    f32x4 acc[2][2][4][2];
#pragma unroll
    for (int a = 0; a < 2; ++a)
#pragma unroll
        for (int b = 0; b < 2; ++b)
#pragma unroll
            for (int m = 0; m < 4; ++m)
#pragma unroll
                for (int n = 0; n < 2; ++n) acc[a][b][m][n] = (f32x4){0.f, 0.f, 0.f, 0.f};
    bf16x8 At[4][2], B0[2][2], B1[2][2];
    const char* cA = (const char*)g.A + (size_t)cur.pm * tstep; const char* cB = (const char*)g.Bt + (size_t)cur.pn * tstep;
    S.a_ready(cur);
    PG8_STAGE(PG8_SB(0, 0), cB, voffB); PG8_STAGE(PG8_SA(0, 0), cA, voffA); PG8_STAGE(PG8_SB(0, 1), cB + hstep, voffB); PG8_STAGE(PG8_SA(0, 1), cA + hstep, voffA);
    if (wr == 1) PG8_BAR;
    PG8_WAIT_V(4); PG8_BAR;
    PG8_STAGE(PG8_SB(1, 0), cB + kstep, voffB); PG8_STAGE(PG8_SA(1, 0), cA + kstep, voffA); PG8_STAGE(PG8_SB(1, 1), cB + hstep + kstep, voffB);
    PG8_WAIT_V(6); PG8_BAR;
    PG8_STAMP();
    for (;;) {
        const bool has_next = S.next(ui + 1, nxt);
        const char* nA = has_next ? (const char*)g.A + (size_t)nxt.pm * tstep : cA; const char* nB = has_next ? (const char*)g.Bt + (size_t)nxt.pn * tstep : cB;
        for (int t = 0; t < nt; t += 2) {
            const bool last = (t == nt - 2);
            const char* a1 = cA + (size_t)(t + 1) * kstep;
            const char* a2 = last ? nA : cA + (size_t)(t + 2) * kstep; const char* b2 = last ? nB : cB + (size_t)(t + 2) * kstep;
            const char* a3 = a2 + kstep; const char* b3 = b2 + kstep;
            if (last && has_next) S.a_ready(nxt);
            PG8_LDB(B0, 0, 0); PG8_SCHED; PG8_LDA(At, 0, 0); PG8_STAGE(PG8_SA(1, 1), a1 + hstep, voffA);
            PG8_WAIT_L(8); PG8_BAR; PG8_WAIT_L(0); PG8_MMA(0, 0, At, B0); PG8_BAR; PG8_SCHED;
            PG8_LDB(B1, 0, 1); PG8_STAGE(PG8_SB(0, 0), b2, voffB);
            PG8_BAR; PG8_WAIT_L(0); PG8_MMA(0, 1, At, B1); PG8_BAR;
            PG8_LDA(At, 0, 1); PG8_STAGE(PG8_SA(0, 0), a2, voffA);
            PG8_BAR; PG8_WAIT_L(0); PG8_MMA(1, 0, At, B0); PG8_BAR; PG8_SCHED;
            PG8_STAGE(PG8_SB(0, 1), b2 + hstep, voffB);
            PG8_WAIT_V(6); PG8_BAR; PG8_MMA(1, 1, At, B1); PG8_BAR;
            PG8_LDB(B0, 1, 0); PG8_SCHED; PG8_LDA(At, 1, 0); PG8_STAGE(PG8_SA(0, 1), a2 + hstep, voffA);
            PG8_WAIT_L(8); PG8_BAR; PG8_WAIT_L(0); PG8_MMA(0, 0, At, B0); PG8_BAR; PG8_SCHED;
            PG8_LDB(B1, 1, 1); PG8_STAGE(PG8_SB(1, 0), b3, voffB);
            PG8_BAR; PG8_WAIT_L(0); PG8_MMA(0, 1, At, B1); PG8_BAR;
            PG8_LDA(At, 1, 1); PG8_STAGE(PG8_SA(1, 0), a3, voffA);
            PG8_BAR; PG8_WAIT_L(0); PG8_MMA(1, 0, At, B0); PG8_BAR; PG8_SCHED;
            PG8_STAGE(PG8_SB(1, 1), b3 + hstep, voffB);
            PG8_WAIT_V(6); PG8_BAR; PG8_MMA(1, 1, At, B1); PG8_BAR;
        }
        PG8_STAMP();
        if constexpr (!Epi::AFTER_DRAIN) { E(acc, cur, wr, wc, fr, fq); S.done(cur); }
        PG8_STAMP();
        if (!has_next) break;
#pragma unroll
        for (int a = 0; a < 2; ++a)
#pragma unroll
            for (int b = 0; b < 2; ++b)
#pragma unroll
                for (int m = 0; m < 4; ++m)
#pragma unroll
                    for (int n = 0; n < 2; ++n) acc[a][b][m][n] = (f32x4){0.f, 0.f, 0.f, 0.f};
        cur = nxt; cA = nA; cB = nB; ++ui;
    }
    PG8_WAIT_V(0);
    if (wr == 0) PG8_BAR;
    PG8_BAR;
    if constexpr (Epi::AFTER_DRAIN) { E.fused(acc, cur, wr, wc, fr, fq, lds, wid, lane); S.done(cur); }
    PG8_STAMP();
#undef PG8_STAMP
#undef PG8_SA
#undef PG8_SB
#undef PG8_STAGE
#undef PG8_LDA
#undef PG8_LDB
#undef PG8_MMA
#undef PG8_WAIT_V
#undef PG8_WAIT_L
#undef PG8_BAR
#undef PG8_SCHED
}
}
#define XCD_TILE_LOOP(t, ntiles)                                                                      \
  for (int t0_ = 0; t0_ < (ntiles); t0_ += GSZ)                                                        \
    if (const int t = t0_ + ((BID >> 1) & 7) * (GSZ >> 3) + (((BID >> 4) << 1) | (BID & 1)); t < (ntiles))
__device__ __forceinline__ void conv_weight(const float* src, int K, int ld, int N, bf16_t* dst, int mode, float* sm) {
  const int ntn = N >> 7, ntk = K >> 6;
  const int tid = TID;
  for (int t = BID; t < ntn * ntk; t += GSZ) {
    const int tn = t % ntn, tk = t / ntn;
    const int n0 = tn * 128, k0 = tk * 64;
    __syncthreads();
    {
      const int j = tid & 127, i = tid >> 7;
      const int n = n0 + j;
      int col = n;
      if (mode == 2) {
        const int P = n >> 8, c = n & 255;
        col = (c < 128) ? (128 * P + c) : (DFF + 128 * P + c - 128);
      } else if (mode == 3) {
        if (n < 2048) {
          const int P = n >> 8, c = n & 255, sx = c >> 7, c1 = c & 127;
          col = P * 256 + (c1 >> 6) * 128 + ((c1 >> 5) & 1) * 64 + (c1 & 31) + 32 * sx;
        }
      }
      float v[32];
#pragma unroll
      for (int r = 0; r < 32; ++r) v[r] = src[(long)(k0 + i + 2 * r) * ld + col];
#pragma unroll
      for (int r = 0; r < 32; ++r) sm[(i + 2 * r) * 129 + j] = v[r];
    }
    __syncthreads();
    {
      const int q = tid & 7, jj = tid >> 3;
#pragma unroll
      for (int r = 0; r < 4; ++r) {
        const int nn = jj + 32 * r;
        float v[8];
#pragma unroll
        for (int e = 0; e < 8; ++e) v[e] = sm[(q * 8 + e) * 129 + nn];
        u32x4 o;
        o.x = pk2(v[0], v[1]);
        o.y = pk2(v[2], v[3]);
        o.z = pk2(v[4], v[5]);
        o.w = pk2(v[6], v[7]);
        *(u32x4*)(dst + (long)(n0 + nn) * K + k0 + q * 8) = o;
      }
    }
  }
}

__device__ __forceinline__ void ph_mods_partial(const Params& p, float* sm) {
  float* part = (float*)(p.ws + OFF_MODSPART);
  for (int it = BID; it < 576; it += GSZ) {
    const int ks = it / 18, cch = it % 18;
    __syncthreads();
    if (TID < 128) {
      const int k = ks * 64 + (TID & 63);
      const float v = (TID < 64) ? p.c[k] : p.c_ctx[k];
      sm[TID] = v / (1.f + expf(-v));
    }
    __syncthreads();
    const int n = cch * 1024 + TID * 4;
    f32x4 a0 = (f32x4){0.f, 0.f, 0.f, 0.f}, a1 = a0;
    const float* wp = p.w_ada + (long)(ks * 64) * NMOD + n;
#pragma unroll 8
    for (int k = 0; k < 64; ++k) {
      const f32x4 w = *(const f32x4*)(wp + (long)k * NMOD);
      a0 += w * sm[k];
      a1 += w * sm[64 + k];
    }
    if (ks == 0) {
      const f32x4 bb = *(const f32x4*)(p.b_ada + n);
      a0 += bb;
      a1 += bb;
    }
    float* mods = (float*)(p.ws + OFF_MODS);
#pragma unroll
    for (int r = 0; r < 4; ++r) {
      atomicAdd(mods + n + r, a0[r]);
      atomicAdd(mods + NMOD + n + r, a1[r]);
    }
  }
}
__device__ __forceinline__ void ph_mods_reduce(const Params& p) {
  const float* part = (const float*)(p.ws + OFF_MODSPART);
  float* mods = (float*)(p.ws + OFF_MODS);
  for (int i = BID * 256 + TID; i < 2 * NMOD; i += GSZ * 256) {
    const int v = i / NMOD, n = i % NMOD;
    float s = p.b_ada[n];
    for (int ks = 0; ks < 32; ++ks) s += part[(long)(ks * 2 + v) * NMOD + n];
    mods[i] = s;
  }
}
__device__ __forceinline__ void ph_misc0(const Params& p) {
  float* sumsq = (float*)(p.ws + OFF_SUMSQ);
  float2* rope = (float2*)(p.ws + OFF_ROPE);
  bf16_t* h3 = (bf16_t*)(p.ws + OFF_H3B);
  const int gt = BID * 256 + TID, gs = GSZ * 256;
  for (int i = gt; i < 2048; i += gs) sumsq[i] = 0.f;
  for (int i = gt; i < 256 * 32; i += gs) {
    const int pos = i >> 5, k = i & 31;
    const float inv = exp2f(-(float)k * (13.287712379549449f / 32.f));
    const float ang = (float)pos * inv;
    rope[i] = make_float2(cosf(ang), sinf(ang));
  }
  const int lane = TID & 63;
  const int gw = BID * 4 + (TID >> 6), nw = GSZ * 4;
  const float fq = p.freq[lane];
  for (int j = gw; j < 16384; j += nw) {
    const float wj = (6.2831855f * (float)j) / 16384.f;
    float feat = 0.f;
    if (lane == 0)
      feat = (float)j / 16383.f;
    else if (lane <= 16) {
      const float f = 1e-4f + (float)(lane - 1) * ((15.f - 1e-4f) / 15.f);
      feat = cosf(f * wj);
    } else if (lane <= 32) {
      const float f = 1e-4f + (float)(lane - 17) * ((15.f - 1e-4f) / 15.f);
      feat = -sinf(f * wj);
    }
    float a = p.b1[lane];
    for (int e = 0; e < 33; ++e) a += __shfl(feat, e) * p.w1[e * 64 + lane];
    float h = sinf(fq * a);
    a = p.b2[lane];
    for (int k = 0; k < 64; ++k) a += __shfl(h, k) * p.w2[k * 64 + lane];
    h = sinf(fq * a);
    a = p.b3[lane];
    for (int k = 0; k < 64; ++k) a += __shfl(h, k) * p.w3[k * 64 + lane];
    h = sinf(fq * a);
    h3[j * 64 + lane] = f2bf(h);
  }
}
__device__ __forceinline__ void ph_prenorm(const Params& p, const float* xl, const float* xc, int rows, const float* g, int slot) {
  const float* mods = (const float*)(p.ws + OFF_MODS);
  bf16_t* A = (bf16_t*)(p.ws + OFF_AR);
  const int lane = TID & 63;
  const int gw = BID * 4 + (TID >> 6), nw = GSZ * 4;
  for (int r = gw; r < rows; r += nw) {
    const float* src = (r < T) ? xl + (long)r * D : xc + (long)(r - T) * D;
    const float* md = mods + ((r < T) ? 0 : NMOD);
    f32x4 v[8];
    float ss = 0.f;
#pragma unroll
    for (int i = 0; i < 8; ++i) {
      v[i] = *(const f32x4*)(src + i * 256 + lane * 4);
      ss += v[i][0] * v[i][0] + v[i][1] * v[i][1] + v[i][2] * v[i][2] + v[i][3] * v[i][3];
    }
    ss = wave_sum(ss);
    const float rstd = rsqrtf(ss * (1.f / 2048.f) + 1e-6f);
#pragma unroll
    for (int i = 0; i < 8; ++i) {
      const int c = i * 256 + lane * 4;
      const f32x4 gg = *(const f32x4*)(g + c);
      const f32x4 sh = *(const f32x4*)(md + (3 * slot) * D + c);
      const f32x4 sc = *(const f32x4*)(md + (3 * slot + 1) * D + c);
      const f32x4 y = v[i] * rstd * gg;
      const f32x4 o = y * (1.f + sc) + sh;
      *(u32x2*)(A + (long)r * D + c) = pk4(o);
    }
  }
}
__device__ __forceinline__ void ph_final_norm(const Params& p) {
  const int lane = TID & 63;
  const int gw = BID * 4 + (TID >> 6), nw = GSZ * 4;
  for (int r = gw; r < T; r += nw) {
    float* src = p.out + (long)r * D;
    f32x4 v[8];
    float ss = 0.f;
#pragma unroll
    for (int i = 0; i < 8; ++i) {
      v[i] = *(const f32x4*)(src + i * 256 + lane * 4);
      ss += v[i][0] * v[i][0] + v[i][1] * v[i][1] + v[i][2] * v[i][2] + v[i][3] * v[i][3];
    }
    ss = wave_sum(ss);
    const float rstd = rsqrtf(ss * (1.f / 2048.f) + 1e-6f);
#pragma unroll
    for (int i = 0; i < 8; ++i) {
      const int c = i * 256 + lane * 4;
      const f32x4 gg = *(const f32x4*)(p.fin_g + c);
      *(f32x4*)(src + c) = v[i] * rstd * gg;
    }
  }
}

#define GEMM_IDS                                                                       \
  const int lane = TID & 63, wv = TID >> 6, wm = wv >> 1, wn = wv & 1; \
  const int l15 = lane & 15, l4 = lane >> 4;                                           \
  (void)l15; (void)l4; (void)wm; (void)wn;

__device__ __forceinline__ void ph_gemm_up(const Params& p, int rows, bf16_t* lds) {
  GEMM_IDS
  const bf16_t* A = (const bf16_t*)(p.ws + OFF_AR);
  const bf16_t* Bt = (const bf16_t*)(p.ws + OFF_WBIG);
  bf16_t* H = (bf16_t*)(p.ws + OFF_H);
  const int ntm = rows >> 7, ntn = 88;
  bool primed = false;
  XCD_TILE_LOOP(t, ntm * ntn) {
    int tm, tn;
    tile_map(t, ntm, ntn, tm, tn);
    f32x4 acc[4][4];
    acc_zero(acc);
    const bf16_t *nA = nullptr, *nB = nullptr;
    if (t + (int)GSZ < ntm * ntn) { int tm2, tn2; tile_map(t + GSZ, ntm, ntn, tm2, tn2); nA = A + (long)tm2 * 128 * D; nB = Bt + (long)tn2 * 128 * D; }
    gemm_acc<true>(acc, A + (long)tm * 128 * D, D, Bt + (long)tn * 128 * D, D, D, lds, nA, nB, primed);
    primed = nA != nullptr;
#pragma unroll
    for (int mi = 0; mi < 4; ++mi) {
      const int m = tm * 128 + 64 * wm + 16 * mi + l15;
#pragma unroll
      for (int ni = 0; ni < 2; ++ni) {
        const int hc = (tn * 2 + wn) * 32 + 16 * ni + 4 * l4;
        f32x4 o;
#pragma unroll
        for (int r = 0; r < 4; ++r) o[r] = silu_f(acc[mi][ni][r]) * acc[mi][ni + 2][r];
        *(u32x2*)(H + (long)m * DFF + hc) = pk4(o);
      }
    }
  }
}
__device__ __forceinline__ void ph_gemm_down(const Params& p, int rows, int slot, const float* resl, const float* resc, float* outl, float* outc,
                             bf16_t* lds) {
  GEMM_IDS
  const bf16_t* A = (const bf16_t*)(p.ws + OFF_H);
  const bf16_t* Bt = (const bf16_t*)(p.ws + OFF_WDOWN);
  const float* mods = (const float*)(p.ws + OFF_MODS);
  const int ntm = rows >> 7, ntn = 16;
  bool primed = false;
  XCD_TILE_LOOP(t, ntm * ntn) {
    int tm, tn;
    tile_map(t, ntm, ntn, tm, tn);
    f32x4 acc[4][4];
    acc_zero(acc);
    const bf16_t *nA = nullptr, *nB = nullptr;
    if (t + (int)GSZ < ntm * ntn) { int tm2, tn2; tile_map(t + GSZ, ntm, ntn, tm2, tn2); nA = A + (long)tm2 * 128 * DFF; nB = Bt + (long)tn2 * 128 * DFF; }
    gemm_acc<true>(acc, A + (long)tm * 128 * DFF, DFF, Bt + (long)tn * 128 * DFF, DFF, DFF, lds, nA, nB, primed);
    primed = nA != nullptr;
    const bool lat = tm < 128;
    const float* gate = mods + (lat ? 0 : NMOD) + (3 * slot + 2) * D;
#pragma unroll
    for (int mi = 0; mi < 4; ++mi) {
      const int m = tm * 128 + 64 * wm + 16 * mi + l15;
      const float* rp = lat ? resl + (long)m * D : resc + (long)(m - T) * D;
      float* op = lat ? outl + (long)m * D : outc + (long)(m - T) * D;
#pragma unroll
      for (int ni = 0; ni < 4; ++ni) {
        const int n = tn * 128 + 64 * wn + 16 * ni + 4 * l4;
        const f32x4 gt = *(const f32x4*)(gate + n);
        const f32x4 rs = *(const f32x4*)(rp + n);
        *(f32x4*)(op + n) = rs + 0.5f * gt * acc[mi][ni];
      }
    }
  }
}
__device__ __forceinline__ void ph_gemm_plain(const bf16_t* A, const bf16_t* Bt, bf16_t* C, int M, int N, int K, bf16_t* lds) {
  GEMM_IDS
  const int ntm = M >> 7, ntn = N >> 7;
  bool primed = false;
  XCD_TILE_LOOP(t, ntm * ntn) {
    int tm, tn;
    tile_map(t, ntm, ntn, tm, tn);
    f32x4 acc[4][4];
    acc_zero(acc);
    const bf16_t *nA = nullptr, *nB = nullptr;
    if (t + (int)GSZ < ntm * ntn) { int tm2, tn2; tile_map(t + GSZ, ntm, ntn, tm2, tn2); nA = A + (long)tm2 * 128 * K; nB = Bt + (long)tn2 * 128 * K; }
    gemm_acc<true>(acc, A + (long)tm * 128 * K, K, Bt + (long)tn * 128 * K, K, K, lds, nA, nB, primed);
    primed = nA != nullptr;
#pragma unroll
    for (int mi = 0; mi < 4; ++mi) {
      const int m = tm * 128 + 64 * wm + 16 * mi + l15;
#pragma unroll
      for (int ni = 0; ni < 4; ++ni) {
        const int n = tn * 128 + 64 * wn + 16 * ni + 4 * l4;
        *(u32x2*)(C + (long)m * N + n) = pk4(acc[mi][ni]);
      }
    }
  }
}
__device__ __forceinline__ void ph_gemm_win_a(const Params& p, bf16_t* lds) {
  GEMM_IDS
  const bf16_t* A = (const bf16_t*)(p.ws + OFF_AR);
  const bf16_t* Bt = (const bf16_t*)(p.ws + OFF_WBIG);
  bf16_t* q = (bf16_t*)(p.ws + OFF_Q);
  bf16_t* kk = (bf16_t*)(p.ws + OFF_K);
  bf16_t* kTf = (bf16_t*)(p.ws + OFF_KTF);
  bf16_t* kTb = (bf16_t*)(p.ws + OFF_KTB);
  bf16_t* vT = (bf16_t*)(p.ws + OFF_VT);
  bf16_t* sg = (bf16_t*)(p.ws + OFF_SG);
  const float2* rope = (const float2*)(p.ws + OFF_ROPE);
  const int n_lat = 128 * 48, n_ctx = 2 * 24;
  XCD_TILE_LOOP(t, n_lat + n_ctx) {
    int tm, tn;
    if (t < n_lat)
      tile_map(t, 128, 48, tm, tn);
    else {
      const int u = t - n_lat;
      tm = 128 + u / 24;
      tn = 8 + u % 24;
    }
    f32x4 acc[4][4];
    acc_zero(acc);
    const bf16_t* Ap = A + (long)tm * 128 * D;
    const bf16_t* Bp = Bt + (long)tn * 128 * D;
    if (tn >= 16 && tn < 32) {
      gemm_acc<false>(acc, Ap, D, Bp, D, D, lds);
#pragma unroll
      for (int mi = 0; mi < 4; ++mi) {
        const int m0 = tm * 128 + 64 * wm + 16 * mi + 4 * l4;
#pragma unroll
        for (int ni = 0; ni < 4; ++ni) {
          const int ch = (tn - 16) * 128 + 64 * wn + 16 * ni + l15;
          *(u32x2*)(vT + (long)ch * TT + m0) = pk4(acc[mi][ni]);
        }
      }
    } else {
      gemm_acc<true>(acc, Ap, D, Bp, D, D, lds);
      if (tn < 8) {
        const float scl = 0.08838834764831845f;
#pragma unroll
        for (int mi = 0; mi < 4; ++mi) {
          const int m = tm * 128 + 64 * wm + 16 * mi + l15;
          const int pos = (wn == 0) ? (m >> 6) : (m & 63);
#pragma unroll
          for (int ni = 0; ni < 2; ++ni) {
            const int i0 = 16 * ni + 4 * l4;
            f32x4 o1, o2;
#pragma unroll
            for (int r = 0; r < 4; ++r) {
              const float2 cs = rope[pos * 32 + i0 + r];
              const float x1 = acc[mi][ni][r] * scl, x2 = acc[mi][ni + 2][r] * scl;
              o1[r] = x1 * cs.x - x2 * cs.y;
              o2[r] = x1 * cs.y + x2 * cs.x;
            }
            bf16_t* dp = q + (long)m * 1024 + tn * 128 + 64 * wn + i0;
            *(u32x2*)(dp) = pk4(o1);
            *(u32x2*)(dp + 32) = pk4(o2);
          }
        }
      } else if (tn < 16) {
        const int head = tn - 8;
        const float lgf = p.lg[head], lgb = p.lg[8 + head];
#pragma unroll
        for (int mi = 0; mi < 4; ++mi) {
          const int m = tm * 128 + 64 * wm + 16 * mi + l15;
          const bool lat = m < T;
          const int pos = (wn == 0) ? ((m >> 6) & 255) : (m & 63);
          const int j = m & 127;
          const float zf = __expf(lgf * (float)(127 - j)), zb = __expf(lgb * (float)j);
#pragma unroll
          for (int ni = 0; ni < 2; ++ni) {
            const int i0 = 16 * ni + 4 * l4;
            f32x4 o1, o2;
#pragma unroll
            for (int r = 0; r < 4; ++r) {
              float2 cs = rope[pos * 32 + i0 + r];
              if (!lat) cs = make_float2(1.f, 0.f);
              const float x1 = acc[mi][ni][r], x2 = acc[mi][ni + 2][r];
              o1[r] = x1 * cs.x - x2 * cs.y;
              o2[r] = x1 * cs.y + x2 * cs.x;
            }
            const int cb = head * 128 + 64 * wn + i0;
            if (lat) {
              bf16_t* dp = kk + (long)m * 1024 + cb;
              *(u32x2*)(dp) = pk4(o1);
              *(u32x2*)(dp + 32) = pk4(o2);
            }
#pragma unroll
            for (int r = 0; r < 4; ++r) {
              kTf[(long)(cb + r) * TT + m] = f2bf(o1[r] * zf);
              kTb[(long)(cb + r) * TT + m] = f2bf(o1[r] * zb);
              kTf[(long)(cb + 32 + r) * TT + m] = f2bf(o2[r] * zf);
              kTb[(long)(cb + 32 + r) * TT + m] = f2bf(o2[r] * zb);
            }
          }
        }
      } else {
#pragma unroll
        for (int mi = 0; mi < 4; ++mi) {
          const int m = tm * 128 + 64 * wm + 16 * mi + l15;
#pragma unroll
          for (int ni = 0; ni < 4; ++ni) {
            const int n = (tn - 32) * 128 + 64 * wn + 16 * ni + 4 * l4;
            f32x4 o;
#pragma unroll
            for (int r = 0; r < 4; ++r) o[r] = silu_f(acc[mi][ni][r]);
            *(u32x2*)(sg + (long)m * D + n) = pk4(o);
          }
        }
      }
    }
  }
}
__device__ __forceinline__ void ph_gemm_win_b(const Params& p, bf16_t* lds) {
  GEMM_IDS
  const bf16_t* A = (const bf16_t*)(p.ws + OFF_AR);
  const bf16_t* Bt = (const bf16_t*)(p.ws + OFF_WBIG);
  bf16_t* phy = (bf16_t*)(p.ws + OFF_PHY);
  bf16_t* gates = (bf16_t*)(p.ws + OFF_GATES);
  bool primed = false;
  XCD_TILE_LOOP(t, 128 * 80) {
    int tm, tn;
    tile_map(t, 128, 80, tm, tn);
    tn += 48;
    f32x4 acc[4][4];
    acc_zero(acc);
    const bf16_t *nA = nullptr, *nB = nullptr;
    if (t + (int)GSZ < 128 * 80) { int tm2, tn2; tile_map(t + GSZ, 128, 80, tm2, tn2); tn2 += 48; nA = A + (long)tm2 * 128 * D; nB = Bt + (long)tn2 * 128 * D; }
    gemm_acc<true>(acc, A + (long)tm * 128 * D, D, Bt + (long)tn * 128 * D, D, D, lds, nA, nB, primed);
    primed = nA != nullptr;
#pragma unroll
    for (int mi = 0; mi < 4; ++mi) {
      const int m = tm * 128 + 64 * wm + 16 * mi + l15;
#pragma unroll
      for (int ni = 0; ni < 4; ++ni) {
        const int nl = 64 * wn + 16 * ni + 4 * l4;
        if (tn < 96) {
          *(u32x2*)(phy + (long)m * 6144 + (tn - 48) * 128 + nl) = pk4(acc[mi][ni]);
        } else {
          f32x4 o;
#pragma unroll
          for (int r = 0; r < 4; ++r) o[r] = sigm_f(acc[mi][ni][r]);
          *(u32x2*)(gates + (long)m * 4096 + (tn - 96) * 128 + nl) = pk4(o);
        }
      }
    }
  }
}
__device__ __forceinline__ void ph_ret_kv_p(const Params& p, bf16_t* lds) {
  GEMM_IDS
  const bf16_t* q = (const bf16_t*)(p.ws + OFF_Q);
  const bf16_t* kk = (const bf16_t*)(p.ws + OFF_K);
  const bf16_t* kTf = (const bf16_t*)(p.ws + OFF_KTF);
  const bf16_t* kTb = (const bf16_t*)(p.ws + OFF_KTB);
  const bf16_t* vT = (const bf16_t*)(p.ws + OFF_VT);
  bf16_t* kvT = (bf16_t*)(p.ws + OFF_KVT);
  bf16_t* P = (bf16_t*)(p.ws + OFF_P);
  const int n1 = 130 * 8 * 2 * 2, n2 = 128 * 8;
  bool primed = false;
  for (int t = BID; t < n1; t += GSZ) {
    f32x4 acc[4][4];
    acc_zero(acc);
    {
      const int half = t & 1, d = (t >> 1) & 1, h = (t >> 2) & 7, ci = t >> 5;
      const bf16_t* Ap = vT + (long)(h * 256 + half * 128) * TT + ci * 128;
      const bf16_t* Bp = (d ? kTb : kTf) + (long)(h * 128) * TT + ci * 128;
      const bf16_t *nAp = nullptr, *nBp = nullptr;
      if (t + GSZ < n1) {
        const int t2 = t + GSZ, half2 = t2 & 1, d2 = (t2 >> 1) & 1, h2 = (t2 >> 2) & 7, ci2 = t2 >> 5;
        nAp = vT + (long)(h2 * 256 + half2 * 128) * TT + ci2 * 128;
        nBp = (d2 ? kTb : kTf) + (long)(h2 * 128) * TT + ci2 * 128;
      }
      gemm_acc<true>(acc, Ap, TT, Bp, TT, 128, lds, nAp, nBp, primed);
      primed = nAp != nullptr;
      bf16_t* o = kvT + ((long)(d * 130 + ci) * 8 + h) * 32768 + (long)(half * 128) * 128;
#pragma unroll
      for (int mi = 0; mi < 4; ++mi) {
        const int m = 64 * wm + 16 * mi + l15;
#pragma unroll
        for (int ni = 0; ni < 4; ++ni) {
          const int n = 64 * wn + 16 * ni + 4 * l4;
          *(u32x2*)(o + m * 128 + n) = pk4(acc[mi][ni]);
        }
      }
    }
  }
  bool primed2 = false;
  for (int u = BID; u < n2; u += GSZ) {
    f32x4 acc[4][4];
    acc_zero(acc);
    {
      const int h = u & 7, ci = u >> 3;
      const bf16_t* Ap = q + (long)ci * 128 * 1024 + h * 128;
      const bf16_t* Bp = kk + (long)ci * 128 * 1024 + h * 128;
      const bf16_t *nAp = nullptr, *nBp = nullptr;
      if (u + GSZ < n2) {
        const int u2 = u + GSZ, h2 = u2 & 7, ci2 = u2 >> 3;
        nAp = q + (long)ci2 * 128 * 1024 + h2 * 128;
        nBp = kk + (long)ci2 * 128 * 1024 + h2 * 128;
      }
      gemm_acc<true>(acc, Ap, 1024, Bp, 1024, 128, lds, nAp, nBp, primed2);
      primed2 = nAp != nullptr;
      const float lgf = p.lg[h], nlgb = -p.lg[8 + h];
      bf16_t* o = P + (long)(ci * 8 + h) * 16384;
#pragma unroll
      for (int mi = 0; mi < 4; ++mi) {
        const int a = 64 * wm + 16 * mi + l15;
#pragma unroll
        for (int ni = 0; ni < 4; ++ni) {
          const int b0 = 64 * wn + 16 * ni + 4 * l4;
          f32x4 ov;
#pragma unroll
          for (int r = 0; r < 4; ++r) {
            const int b = b0 + r;
            const int dd = a - b;
            const float dcy = (dd == 0) ? 2.f : __expf((dd > 0 ? lgf : nlgb) * (float)dd);
            ov[r] = acc[mi][ni][r] * dcy;
          }
          *(u32x2*)(o + a * 128 + b0) = pk4(ov);
        }
      }
    }
  }
}
__device__ __forceinline__ void ph_ret_scan(const Params& p) {
  unsigned* kv = (unsigned*)(p.ws + OFF_KVT);
  for (int e2 = BID * 256 + TID; e2 < 131072; e2 += GSZ * 256) {
    const int h = e2 >> 14, off = e2 & 16383;
    const float decf = expf(p.lg[h] * 128.f), decb = expf(p.lg[8 + h] * 128.f);
    unsigned* bf = kv + ((long)h) * 16384 + off;
    unsigned* bb = kv + ((long)130 * 8 + h) * 16384 + off;
    float f0 = 0.f, f1 = 0.f, b0 = 0.f, b1 = 0.f;
    for (int sb = 0; sb < 130; sb += 10) {
      unsigned vf[10], vb[10];
#pragma unroll
      for (int k = 0; k < 10; ++k) {
        const int step = sb + k;
        const int cf = (step < 2) ? (128 + step) : (step - 2), cb = 129 - step;
        vf[k] = bf[(long)cf * 131072];
        vb[k] = bb[(long)cb * 131072];
      }
#pragma unroll
      for (int k = 0; k < 10; ++k) {
        const int step = sb + k;
        const int cf = (step < 2) ? (128 + step) : (step - 2), cb = 129 - step;
        bf[(long)cf * 131072] = pk2(f0, f1);
        bb[(long)cb * 131072] = pk2(b0, b1);
        f0 = f0 * decf + bf2f(vf[k] & 0xffffu);
        f1 = f1 * decf + bf2f(vf[k] >> 16);
        b0 = b0 * decb + bf2f(vb[k] & 0xffffu);
        b1 = b1 * decb + bf2f(vb[k] >> 16);
      }
    }
  }
}
__device__ __forceinline__ void ph_ret_out(const Params& p, char* lds_all) {
  GEMM_IDS
  const int half = fresh_tid() >> 8;
  bf16_t* lds = (bf16_t*)(lds_all + half * LDS_HALF);
  float2* part = (float2*)(lds_all + 65536);
  const bf16_t* q = (const bf16_t*)(p.ws + OFF_Q);
  const bf16_t* vT = (const bf16_t*)(p.ws + OFF_VT);
  const bf16_t* kvT = (const bf16_t*)(p.ws + OFF_KVT);
  const bf16_t* P = (const bf16_t*)(p.ws + OFF_P);
  const bf16_t* sg = (const bf16_t*)(p.ws + OFF_SG);
  bf16_t* Y = (bf16_t*)(p.ws + OFF_Y);
  bool primed = false;
  for (int it = (int)blockIdx.x; it < 1024; it += (int)gridDim.x) {
    const int h = it & 7, ci = it >> 3;
    const float lgf = p.lg[h], lgb = p.lg[8 + h];
    f32x4 acc[4][4];
    acc_zero(acc);
    const bf16_t* Aq = q + (long)ci * 128 * 1024 + h * 128;
    const bf16_t* Sb = kvT + ((long)(130 + ci) * 8 + h) * 32768 + (long)(half * 128) * 128;
    const bf16_t* Sf = kvT + ((long)(ci)*8 + h) * 32768 + (long)(half * 128) * 128;
    const bf16_t* Ap = P + (long)(ci * 8 + h) * 16384;
    const bf16_t* Vp = vT + (long)(h * 256 + half * 128) * TT + ci * 128;
    const bf16_t *nAq = nullptr, *nSb = nullptr;
    if (it + (int)gridDim.x < 1024) {
      const int it2 = it + (int)gridDim.x, h2 = it2 & 7, ci2 = it2 >> 3;
      nAq = q + (long)ci2 * 128 * 1024 + h2 * 128;
      nSb = kvT + ((long)(130 + ci2) * 8 + h2) * 32768 + (long)(half * 128) * 128;
    }
    gemm_acc<true>(acc, Aq, 1024, Sb, 128, 128, lds, Aq, Sf, primed);
#pragma unroll
    for (int mi = 0; mi < 4; ++mi) {
      const int a = 64 * wm + 16 * mi + l15;
      const float ratio = __expf(lgb * (float)(128 - a) - lgf * (float)(a + 1));
#pragma unroll
      for (int ni = 0; ni < 4; ++ni) acc[mi][ni] *= ratio;
    }
    gemm_acc<true>(acc, Aq, 1024, Sf, 128, 128, lds, Ap, Vp, true, 128, TT);
#pragma unroll
    for (int mi = 0; mi < 4; ++mi) {
      const int a = 64 * wm + 16 * mi + l15;
      const float xf = __expf(lgf * (float)(a + 1));
#pragma unroll
      for (int ni = 0; ni < 4; ++ni) acc[mi][ni] *= xf;
    }
    gemm_acc<true>(acc, Ap, 128, Vp, TT, 128, lds, nAq, nSb, true, 1024, 128);
    primed = nAq != nullptr;
#pragma unroll
    for (int mi = 0; mi < 4; ++mi) {
      float s1 = 0.f, s2 = 0.f;
#pragma unroll
      for (int ni = 0; ni < 4; ++ni)
#pragma unroll
        for (int r = 0; r < 4; ++r) {
          const float v = acc[mi][ni][r];
          s1 += v;
          s2 += v * v;
        }
      s1 += __shfl_xor(s1, 16);
      s2 += __shfl_xor(s2, 16);
      s1 += __shfl_xor(s1, 32);
      s2 += __shfl_xor(s2, 32);
      if (l4 == 0) part[(half * 2 + wn) * 128 + 64 * wm + 16 * mi + l15] = make_float2(s1, s2);
    }
    __syncthreads();
#pragma unroll
    for (int mi = 0; mi < 4; ++mi) {
      const int a = 64 * wm + 16 * mi + l15;
      const float2 p0 = part[a], p1 = part[128 + a], p2 = part[256 + a], p3 = part[384 + a];
      const float mean = ((p0.x + p1.x) + (p2.x + p3.x)) * (1.f / 256.f);
      const float ex2 = ((p0.y + p1.y) + (p2.y + p3.y)) * (1.f / 256.f);
      const float rs = rsqrtf(fmaxf(ex2 - mean * mean, 0.f) + 1e-6f);
      const long t = (long)ci * 128 + a;
#pragma unroll
      for (int ni = 0; ni < 4; ++ni) {
        const int c = h * 256 + half * 128 + 64 * wn + 16 * ni + 4 * l4;
        const u32x2 graw = *(const u32x2*)(sg + t * D + c);
        const f32x4 gg = *(const f32x4*)(p.gn_g + c), gb = *(const f32x4*)(p.gn_b + c);
        f32x4 o;
        o[0] = ((acc[mi][ni][0] - mean) * rs * gg[0] + gb[0]) * bf2f(graw.x & 0xffffu);
        o[1] = ((acc[mi][ni][1] - mean) * rs * gg[1] + gb[1]) * bf2f(graw.x >> 16);
        o[2] = ((acc[mi][ni][2] - mean) * rs * gg[2] + gb[2]) * bf2f(graw.y & 0xffffu);
        o[3] = ((acc[mi][ni][3] - mean) * rs * gg[3] + gb[3]) * bf2f(graw.y >> 16);
        *(u32x2*)(Y + t * D + c) = pk4(o);
      }
    }
  }
}
__device__ __forceinline__ void ph_ret_gn(const Params& p) {
  bf16_t* Y = (bf16_t*)(p.ws + OFF_Y);
  const bf16_t* sg = (const bf16_t*)(p.ws + OFF_SG);
  const int lane = TID & 63;
  const int gw = BID * 4 + (TID >> 6), nw = GSZ * 4;
  for (int t = gw; t < T; t += nw) {
    u32x2 raw[8], graw[8];
#pragma unroll
    for (int h = 0; h < 8; ++h) {
      raw[h] = *(const u32x2*)(Y + (long)t * D + h * 256 + lane * 4);
      graw[h] = *(const u32x2*)(sg + (long)t * D + h * 256 + lane * 4);
    }
#pragma unroll
    for (int h = 0; h < 8; ++h) {
      const int c = h * 256 + lane * 4;
      float v[4] = {bf2f(raw[h].x & 0xffffu), bf2f(raw[h].x >> 16), bf2f(raw[h].y & 0xffffu), bf2f(raw[h].y >> 16)};
      const float mean = wave_sum(v[0] + v[1] + v[2] + v[3]) * (1.f / 256.f);
      float q = 0.f;
#pragma unroll
      for (int r = 0; r < 4; ++r) {
        v[r] -= mean;
        q += v[r] * v[r];
      }
      const float rs = rsqrtf(wave_sum(q) * (1.f / 256.f) + 1e-6f);
      const float gv[4] = {bf2f(graw[h].x & 0xffffu), bf2f(graw[h].x >> 16), bf2f(graw[h].y & 0xffffu), bf2f(graw[h].y >> 16)};
      const f32x4 gg = *(const f32x4*)(p.gn_g + c), gb = *(const f32x4*)(p.gn_b + c);
      f32x4 o;
#pragma unroll
      for (int r = 0; r < 4; ++r) o[r] = (v[r] * rs * gg[r] + gb[r]) * gv[r];
      *(u32x2*)(Y + (long)t * D + c) = pk4(o);
    }
  }
}
__device__ __forceinline__ void hy_conv_row(const u32x4 (&rm)[3], const u32x4 (&r0)[3], const u32x4 (&rp)[3], const float (&wv)[3][3][8],
                                            const float (&bv)[3][8], bf16_t* x0p, bf16_t* zp) {
  float u[3][8];
#pragma unroll
  for (int s3 = 0; s3 < 3; ++s3) {
#pragma unroll
    for (int e = 0; e < 8; ++e) u[s3][e] = bv[s3][e];
#pragma unroll
    for (int dt = 0; dt < 3; ++dt) {
      const u32x4 raw = (dt == 0) ? rm[s3] : ((dt == 1) ? r0[s3] : rp[s3]);
      const unsigned rw[4] = {raw.x, raw.y, raw.z, raw.w};
#pragma unroll
      for (int e = 0; e < 4; ++e) {
        u[s3][2 * e] += bf2f(rw[e] & 0xffffu) * wv[s3][dt][2 * e];
        u[s3][2 * e + 1] += bf2f(rw[e] >> 16) * wv[s3][dt][2 * e + 1];
      }
    }
  }
  u32x4 o0, oz;
  o0.x = pk2(u[0][0], u[0][1]);
  o0.y = pk2(u[0][2], u[0][3]);
  o0.z = pk2(u[0][4], u[0][5]);
  o0.w = pk2(u[0][6], u[0][7]);
  oz.x = pk2(u[1][0] * u[2][0], u[1][1] * u[2][1]);
  oz.y = pk2(u[1][2] * u[2][2], u[1][3] * u[2][3]);
  oz.z = pk2(u[1][4] * u[2][4], u[1][5] * u[2][5]);
  oz.w = pk2(u[1][6] * u[2][6], u[1][7] * u[2][7]);
  *(u32x4*)x0p = o0;
  *(u32x4*)zp = oz;
}
__device__ __forceinline__ void ph_hy_conv(const Params& p) {
  const bf16_t* phy = (const bf16_t*)(p.ws + OFF_PHY);
  bf16_t* x0 = (bf16_t*)(p.ws + OFF_X0);
  bf16_t* z = (bf16_t*)(p.ws + OFF_Z);
  const int c0 = TID * 8;
  float wv[3][3][8], bv[3][8];
#pragma unroll
  for (int s3 = 0; s3 < 3; ++s3) {
#pragma unroll
    for (int e = 0; e < 8; ++e) bv[s3][e] = p.conv_b[s3 * 2048 + c0 + e];
#pragma unroll
    for (int dt = 0; dt < 3; ++dt)
#pragma unroll
      for (int e = 0; e < 8; ++e) wv[s3][dt][e] = p.conv_w[dt * 6144 + s3 * 2048 + c0 + e];
  }
  const int nrows = T / GSZ;
  const int t0 = BID * nrows;
  u32x4 w0[3], w1[3], w2[3], w3[3], n0[3], n1[3];
#define HYC_LD(dst, tt)                                                                                   \
  {                                                                                                       \
    const int tt_ = (tt);                                                                                 \
    _Pragma("unroll") for (int s3 = 0; s3 < 3; ++s3)                                                      \
      dst[s3] = (tt_ >= 0 && tt_ < T) ? *(const u32x4*)(phy + (long)tt_ * 6144 + s3 * 2048 + c0) : (u32x4){0u, 0u, 0u, 0u}; \
  }
  HYC_LD(w0, t0 - 1)
  HYC_LD(w1, t0)
  HYC_LD(w2, t0 + 1)
  HYC_LD(w3, t0 + 2)
  for (int k = 0; k < nrows; k += 2) {
    const int t = t0 + k;
    HYC_LD(n0, t + 3)
    HYC_LD(n1, t + 4)
    hy_conv_row(w0, w1, w2, wv, bv, x0 + (long)t * D + c0, z + (long)t * D + c0);
    hy_conv_row(w1, w2, w3, wv, bv, x0 + (long)(t + 1) * D + c0, z + (long)(t + 1) * D + c0);
#pragma unroll
    for (int s3 = 0; s3 < 3; ++s3) { w0[s3] = w2[s3]; w1[s3] = w3[s3]; w2[s3] = n0[s3]; w3[s3] = n1[s3]; }
  }
#undef HYC_LD
}

__device__ __forceinline__ float2 cmul(float2 a, float2 b) { return make_float2(a.x * b.x - a.y * b.y, a.x * b.y + a.y * b.x); }
__device__ __forceinline__ float2 cmulc(float2 a, float2 b) { return make_float2(a.x * b.x + a.y * b.y, a.y * b.x - a.x * b.y); }
__device__ __forceinline__ float2 cadd(float2 a, float2 b) { return make_float2(a.x + b.x, a.y + b.y); }
__device__ __forceinline__ float2 csub(float2 a, float2 b) { return make_float2(a.x - b.x, a.y - b.y); }
__device__ __forceinline__ constexpr float w16c(int m) {
  m &= 15;
  return m == 0 ? 1.f : m == 1 ? 0.92387953251f : m == 2 ? 0.70710678119f : m == 3 ? 0.38268343237f : m == 4 ? 0.f
       : m == 5 ? -0.38268343237f : m == 6 ? -0.70710678119f : m == 7 ? -0.92387953251f : m == 8 ? -1.f
       : m == 9 ? -0.92387953251f : m == 10 ? -0.70710678119f : m == 11 ? -0.38268343237f : m == 12 ? 0.f
       : m == 13 ? 0.38268343237f : m == 14 ? 0.70710678119f : 0.92387953251f;
}
__device__ __forceinline__ constexpr float w16s(int m) { return w16c(m - 4); }
template <int SGN>
__device__ __forceinline__ void dft4(float2& a0, float2& a1, float2& a2, float2& a3) {
  const float2 s02 = cadd(a0, a2), d02 = csub(a0, a2), s13 = cadd(a1, a3), d13 = csub(a1, a3);
  const float2 jd = make_float2(-(float)SGN * d13.y, (float)SGN * d13.x);
  a0 = cadd(s02, s13);
  a1 = cadd(d02, jd);
  a2 = csub(s02, s13);
  a3 = csub(d02, jd);
}
template <int SGN>
__device__ __forceinline__ void dft16(float2 (&v)[16]) {
#pragma unroll
  for (int b = 0; b < 4; ++b) dft4<SGN>(v[b], v[4 + b], v[8 + b], v[12 + b]);
#pragma unroll
  for (int c = 1; c < 4; ++c)
#pragma unroll
    for (int b = 1; b < 4; ++b) {
      const float wr = w16c(b * c), wi = (float)SGN * w16s(b * c);
      const float2 t = v[4 * c + b];
      v[4 * c + b] = make_float2(t.x * wr - t.y * wi, t.x * wi + t.y * wr);
    }
#pragma unroll
  for (int c = 0; c < 4; ++c) dft4<SGN>(v[4 * c], v[4 * c + 1], v[4 * c + 2], v[4 * c + 3]);
}
template <int SGN>
__device__ __forceinline__ void dft8(float2 (&v)[8]) {
  dft4<SGN>(v[0], v[2], v[4], v[6]);
  dft4<SGN>(v[1], v[3], v[5], v[7]);
#pragma unroll
  for (int c = 1; c < 4; ++c) {
    const float wr = w16c(2 * c), wi = (float)SGN * w16s(2 * c);
    const float2 t = v[2 * c + 1];
    v[2 * c + 1] = make_float2(t.x * wr - t.y * wi, t.x * wi + t.y * wr);
  }
#pragma unroll
  for (int c = 0; c < 4; ++c) {
    const float2 t = v[2 * c], u = v[2 * c + 1];
    v[2 * c] = cadd(t, u);
    v[2 * c + 1] = csub(t, u);
  }
}
__device__ __forceinline__ void fft_tw_init(float2* TW) {
  __syncthreads();
  {
    float s, c;
    sincospif((float)TID * (1.f / 128.f), &s, &c);
    TW[TID] = make_float2(c, -s);
  }
  __syncthreads();
}
__device__ __forceinline__ float2 big_tw(int f1, int t2) {
  const float rev = (float)(f1 * t2) * (1.f / 32768.f);
  return make_float2(__builtin_amdgcn_cosf(rev), -__builtin_amdgcn_sinf(rev));
}
__device__ __forceinline__ void ph_taps(const Params& p, int g, bf16_t* lds) {
  GEMM_IDS
  const bf16_t* A = (const bf16_t*)(p.ws + OFF_H3B);
  const bf16_t* W = (const bf16_t*)(p.ws + OFF_W4T);
  bf16_t* TP = (bf16_t*)(p.ws + (g ? OFF_TAPS1 : OFF_TAPS));
  bool primed = false;
  for (int t = BID; t < 128 * 16; t += GSZ) {
    const int tn = t & 15, tm = t >> 4;
    const int wrow = (tn < 8) ? (g * 1024 + tn * 128) : (2048 + g * 1024 + (tn - 8) * 128);
    f32x4 acc[4][4];
    acc_zero(acc);
    const bf16_t *nA = nullptr, *nB = nullptr;
    if (t + GSZ < 128 * 16) {
      const int t2 = t + GSZ, tn2 = t2 & 15, tm2 = t2 >> 4;
      const int wrow2 = (tn2 < 8) ? (g * 1024 + tn2 * 128) : (2048 + g * 1024 + (tn2 - 8) * 128);
      nA = A + (long)tm2 * 128 * 64;
      nB = W + (long)wrow2 * 64;
    }
    gemm_acc<true>(acc, A + (long)tm * 128 * 64, 64, W + (long)wrow * 64, 64, 64, lds, nA, nB, primed);
    primed = nA != nullptr;
#pragma unroll
    for (int mi = 0; mi < 4; ++mi) {
      const int m = tm * 128 + 64 * wm + 16 * mi + l15;
#pragma unroll
      for (int ni = 0; ni < 4; ++ni) {
        const int n = tn * 128 + 64 * wn + 16 * ni + 4 * l4;
        *(u32x2*)(TP + (long)m * 2048 + n) = pk4(acc[mi][ni]);
      }
    }
  }
}
constexpr float KSCALE = 2.0f;
__device__ __forceinline__ void ph_fft_a(const Params& p, int g, char* ldsc) {
  float2* X = (float2*)ldsc;
  float2* TW = (float2*)(ldsc + 65536);
  const bf16_t* z = (const bf16_t*)(p.ws + OFF_Z);
  const bf16_t* TP = (const bf16_t*)(p.ws + (g ? OFF_TAPS1 : OFF_TAPS));
  float* sumsq = (float*)(p.ws + OFF_SUMSQ);
  unsigned* S = (unsigned*)(p.ws + OFF_S);
  const int ch = TID & 31, rg = TID >> 5;
  fft_tw_init(TW);
  for (int it = BID; it < 4096; it += GSZ) {
    const int t2 = it & 127, cc = it >> 7;
    const int c = g * 1024 + cc * 32 + ch;
    __syncthreads();
    {
      const float dec = fabsf(p.decay[c]);
      float ssq = 0.f;
      unsigned short rz[16], rt[32];
#pragma unroll
      for (int i = 0; i < 16; ++i) rz[i] = z[(long)(128 * (rg + 8 * i) + t2) * D + c];
#pragma unroll
      for (int i = 0; i < 32; ++i) {
        const int half = i >> 4, t1 = half * 128 + rg + 8 * (i & 15), j = 128 * t1 + t2;
        int jj = half ? (32768 - j) : j;
        if (jj >= 16384) jj = 0;
        rt[i] = TP[(long)jj * 2048 + half * 1024 + cc * 32 + ch];
      }
#pragma unroll
      for (int i = 0; i < 32; ++i) {
        const int half = i >> 4, t1 = half * 128 + rg + 8 * (i & 15), j = 128 * t1 + t2;
        int jj = half ? (32768 - j) : j;
        const bool zero = (jj >= 16384);
        if (zero) jj = 0;
        float val = bf2f(rt[i]) * __expf(-((float)jj * (1.f / 16383.f)) * dec);
        if (zero) val = 0.f;
        ssq += val * val;
        const float zr = (i < 16) ? bf2f(rz[i & 15]) : 0.f;
        X[t1 * 32 + ch] = make_float2(zr, val * KSCALE);
      }
      ((float*)(ldsc + 65536 + 2048))[TID] = ssq;
    }
    __syncthreads();
    if (TID < 32) {
      const float* red = (const float*)(ldsc + 65536 + 2048);
      float tot = 0.f;
#pragma unroll
      for (int r8 = 0; r8 < 8; ++r8) tot += red[r8 * 32 + TID];
      atomicAdd(&sumsq[c], tot);
    }
#pragma unroll 1
    for (int u = 0; u < 2; ++u) {
      const int j = rg + 8 * u;
      float2 v[16];
#pragma unroll
      for (int k = 0; k < 16; ++k) v[k] = X[(16 * k + j) * 32 + ch];
      dft16<-1>(v);
#pragma unroll
      for (int i = 0; i < 16; ++i) {
        const int q = (i >> 2) + 4 * (i & 3);
        X[(16 * q + j) * 32 + ch] = cmul(v[i], TW[(j * q) & 255]);
      }
    }
    __syncthreads();
#pragma unroll 1
    for (int u = 0; u < 2; ++u) {
      const int q = rg + 8 * u;
      float2 v[16];
#pragma unroll
      for (int j = 0; j < 16; ++j) v[j] = X[(16 * q + j) * 32 + ch];
      dft16<-1>(v);
      float2 twv[16];
      {
        const float2 st = big_tw(16, t2);
        twv[0] = big_tw(q, t2);
#pragma unroll
        for (int pp = 1; pp < 16; ++pp) twv[pp] = cmul(twv[pp - 1], st);
      }
#pragma unroll
      for (int i = 0; i < 16; ++i) {
        const int pp = (i >> 2) + 4 * (i & 3);
        const int r = 16 * q + pp;
        const float2 o = cmul(v[i], twv[pp]);
        S[((long)cc * 32768 + r * 128 + t2) * 32 + ch] = pk2(o.x, o.y);
      }
    }
  }
}
__device__ __forceinline__ void ph_fft_mid(const Params& p, char* lds_all) {
  const int hv = fresh_tid() >> 8;
  char* my = lds_all + hv * LDS_HALF;
  float2* XS = (float2*)my;
  float2* TW = (float2*)(my + 65536);
  unsigned* S = (unsigned*)(p.ws + OFF_S);
  const int ch = TID & 31, rg = TID >> 5;
  fft_tw_init(TW);
  unsigned rs[16];
  {
    const int pi0 = (int)blockIdx.x;
    const int P0 = pi0 & 127, cc0 = pi0 >> 7;
    const int f10 = (P0 == 0) ? (hv ? 128 : 0) : (hv ? 256 - P0 : P0);
    const int r0 = 16 * (f10 & 15) + (f10 >> 4);
    const long gb0 = ((long)cc0 * 32768 + r0 * 128) * 32 + ch;
#pragma unroll
    for (int k = 0; k < 16; ++k) rs[k] = S[gb0 + (8 * k + rg) * 32];
  }
  for (int pi = (int)blockIdx.x; pi < 4096; pi += (int)gridDim.x) {
    const int P = pi & 127, cc = pi >> 7;
    const int f1 = (P == 0) ? (hv ? 128 : 0) : (hv ? 256 - P : P);
    const int r = 16 * (f1 & 15) + (f1 >> 4);
    const long gbase = ((long)cc * 32768 + r * 128) * 32 + ch;
    const float2* XP = (P == 0) ? (const float2*)XS : (const float2*)(lds_all + (hv ^ 1) * LDS_HALF);
    __syncthreads();
    {
      const int j = rg;
      float2 v[16];
#pragma unroll
      for (int k = 0; k < 16; ++k) { const unsigned w_ = rs[k]; v[k] = make_float2(bf2f(w_ & 0xffffu), bf2f(w_ >> 16)); }
      dft16<-1>(v);
#pragma unroll
      for (int i = 0; i < 16; ++i) {
        const int q = (i >> 2) + 4 * (i & 3);
        XS[(8 * q + j) * 32 + ch] = cmul(v[i], TW[(2 * j * q) & 255]);
      }
    }
    {
      const int pin = pi + (int)gridDim.x;
      if (pin < 4096) {
        const int Pn = pin & 127, ccn = pin >> 7;
        const int f1n = (Pn == 0) ? (hv ? 128 : 0) : (hv ? 256 - Pn : Pn);
        const int rn = 16 * (f1n & 15) + (f1n >> 4);
        const long gbn = ((long)ccn * 32768 + rn * 128) * 32 + ch;
#pragma unroll
        for (int k = 0; k < 16; ++k) rs[k] = S[gbn + (8 * k + rg) * 32];
      }
    }
    __syncthreads();
    float2 a[2][8];
#pragma unroll
    for (int u = 0; u < 2; ++u) {
      const int q = rg + 8 * u;
#pragma unroll
      for (int j = 0; j < 8; ++j) a[u][j] = XS[(8 * q + j) * 32 + ch];
      dft8<-1>(a[u]);
#pragma unroll
      for (int pp = 0; pp < 8; ++pp) XS[(8 * q + pp) * 32 + ch] = a[u][2 * (pp & 3) + (pp >> 2)];
    }
    __syncthreads();
    float2 m[2][8];
#pragma unroll
    for (int u = 0; u < 2; ++u) {
      const int q = rg + 8 * u;
      const int sbase = (f1 != 0) ? (127 - 8 * q) : ((q > 0) ? (135 - 8 * q) : 8);
      const float2* xpb = XP + sbase * 32 + ch;
      const float2 bw0 = (f1 == 0 && q == 0) ? XP[ch] : xpb[0];
#pragma unroll
      for (int pp = 0; pp < 8; ++pp) {
        const float2 bw = (pp == 0) ? bw0 : xpb[-32 * pp];
        const float2 aw = a[u][2 * (pp & 3) + (pp >> 2)];
        const float dr = (aw.x * aw.x - aw.y * aw.y) - (bw.x * bw.x - bw.y * bw.y);
        const float di = 2.f * aw.x * aw.y + 2.f * bw.x * bw.y;
        m[u][pp] = make_float2(0.25f * di, -0.25f * dr);
      }
      dft8<1>(m[u]);
    }
    __syncthreads();
#pragma unroll
    for (int u = 0; u < 2; ++u) {
      const int q = rg + 8 * u;
#pragma unroll
      for (int i = 0; i < 8; ++i) {
        const int j = (i >> 1) + 4 * (i & 1);
        XS[(8 * q + j) * 32 + ch] = cmulc(m[u][i], TW[(2 * q * j) & 255]);
      }
    }
    __syncthreads();
    {
      const int j = rg;
      float2 v[16];
#pragma unroll
      for (int q = 0; q < 16; ++q) v[q] = XS[(8 * q + j) * 32 + ch];
      dft16<1>(v);
      float2 twv[16];
      {
        const float2 st = big_tw(f1, 8);
        twv[0] = big_tw(f1, j);
#pragma unroll
        for (int k = 1; k < 16; ++k) twv[k] = cmul(twv[k - 1], st);
      }
#pragma unroll
      for (int i = 0; i < 16; ++i) {
        const int k = (i >> 2) + 4 * (i & 3);
        const int t2 = 8 * k + j;
        const float2 o = cmulc(v[i], twv[k]);
        S[gbase + t2 * 32] = pk2(o.x, o.y);
      }
    }
  }
}
__device__ __forceinline__ void ph_fft_c(const Params& p, int g, char* ldsc) {
  float2* X = (float2*)ldsc;
  float2* TW = (float2*)(ldsc + 65536);
  const unsigned* S = (const unsigned*)(p.ws + OFF_S);
  const bf16_t* z = (const bf16_t*)(p.ws + OFF_Z);
  bf16_t* x0 = (bf16_t*)(p.ws + OFF_X0);
  const float* sumsq = (const float*)(p.ws + OFF_SUMSQ);
  const int ch = TID & 31, rg = TID >> 5;
  fft_tw_init(TW);
  unsigned raw[2][16];
  {
    const int it0 = BID;
    const int t20 = it0 & 127, cc0 = it0 >> 7;
#pragma unroll
    for (int u = 0; u < 2; ++u)
#pragma unroll
      for (int pp = 0; pp < 16; ++pp) raw[u][pp] = S[((long)cc0 * 32768 + (16 * (rg + 8 * u) + pp) * 128 + t20) * 32 + ch];
  }
  for (int it = BID; it < 4096; it += GSZ) {
    const int t2 = it & 127, cc = it >> 7;
    const int c = g * 1024 + cc * 32 + ch;
    __syncthreads();
    unsigned short zz[2][8], xx[2][8];
#pragma unroll
    for (int u = 0; u < 2; ++u)
#pragma unroll
      for (int k = 0; k < 8; ++k) {
        const long gi = (long)(128 * (16 * k + rg + 8 * u) + t2) * D + c;
        zz[u][k] = z[gi];
        xx[u][k] = x0[gi];
      }
#pragma unroll
    for (int u = 0; u < 2; ++u) {
      const int q = rg + 8 * u;
      float2 v[16];
#pragma unroll
      for (int pp = 0; pp < 16; ++pp) { const unsigned w_ = raw[u][pp]; v[pp] = make_float2(bf2f(w_ & 0xffffu), bf2f(w_ >> 16)); }
      dft16<1>(v);
#pragma unroll
      for (int i = 0; i < 16; ++i) {
        const int j = (i >> 2) + 4 * (i & 3);
        X[(16 * q + j) * 32 + ch] = cmulc(v[i], TW[(q * j) & 255]);
      }
    }
    {
      const int itn = it + GSZ;
      if (itn < 4096) {
        const int t2n = itn & 127, ccn = itn >> 7;
#pragma unroll
        for (int u = 0; u < 2; ++u)
#pragma unroll
          for (int pp = 0; pp < 16; ++pp) raw[u][pp] = S[((long)ccn * 32768 + (16 * (rg + 8 * u) + pp) * 128 + t2n) * 32 + ch];
      }
    }
    __syncthreads();
    const float nrm = rsqrtf(sumsq[c] + 1e-6f) * (1.f / (32768.f * KSCALE));
    const float sk = p.skip[c];
#pragma unroll
    for (int u = 0; u < 2; ++u) {
      const int j = rg + 8 * u;
      float2 v[16];
#pragma unroll
      for (int q = 0; q < 16; ++q) v[q] = X[(16 * q + j) * 32 + ch];
      dft16<1>(v);
#pragma unroll
      for (int i = 0; i < 16; ++i) {
        const int k = (i >> 2) + 4 * (i & 3);
        if (k < 8) {
          const int t1 = 16 * k + j;
          const long gi = (long)(128 * t1 + t2) * D + c;
          const float y = v[i].x * nrm + sk * bf2f(zz[u][k]);
          x0[gi] = f2bf(bf2f(xx[u][k]) * y);
        }
      }
    }
  }
}
__device__ __forceinline__ void ph_gemm_hyo(const Params& p, bf16_t* lds) {
  GEMM_IDS
  const bf16_t* A = (const bf16_t*)(p.ws + OFF_X0);
  const bf16_t* Bt = (const bf16_t*)(p.ws + OFF_WHO);
  bf16_t* ro = (bf16_t*)(p.ws + OFF_RETOUT);
  const bf16_t* gates = (const bf16_t*)(p.ws + OFF_GATES);
  bool primed = false;
  XCD_TILE_LOOP(t, 128 * 16) {
    int tm, tn;
    tile_map(t, 128, 16, tm, tn);
    f32x4 acc[4][4];
    acc_zero(acc);
#if !SKIP_HY
    const bf16_t *nA = nullptr, *nB = nullptr;
    if (t + (int)GSZ < 128 * 16) { int tm2, tn2; tile_map(t + GSZ, 128, 16, tm2, tn2); nA = A + (long)tm2 * 128 * D; nB = Bt + (long)tn2 * 128 * D; }
    gemm_acc<true>(acc, A + (long)tm * 128 * D, D, Bt + (long)tn * 128 * D, D, D, lds, nA, nB, primed);
    primed = nA != nullptr;
#endif
#pragma unroll
    for (int mi = 0; mi < 4; ++mi) {
      const int m = tm * 128 + 64 * wm + 16 * mi + l15;
#pragma unroll
      for (int ni = 0; ni < 4; ++ni) {
        const int n = tn * 128 + 64 * wn + 16 * ni + 4 * l4;
        const u32x2 r0 = *(const u32x2*)(ro + (long)m * D + n);
        const u32x2 g0 = *(const u32x2*)(gates + (long)m * 4096 + n);
        const u32x2 g1 = *(const u32x2*)(gates + (long)m * 4096 + 2048 + n);
        f32x4 o;
        o[0] = bf2f(g0.x & 0xffffu) * bf2f(r0.x & 0xffffu) + bf2f(g1.x & 0xffffu) * acc[mi][ni][0];
        o[1] = bf2f(g0.x >> 16) * bf2f(r0.x >> 16) + bf2f(g1.x >> 16) * acc[mi][ni][1];
        o[2] = bf2f(g0.y & 0xffffu) * bf2f(r0.y & 0xffffu) + bf2f(g1.y & 0xffffu) * acc[mi][ni][2];
        o[3] = bf2f(g0.y >> 16) * bf2f(r0.y >> 16) + bf2f(g1.y >> 16) * acc[mi][ni][3];
        *(u32x2*)(ro + (long)m * D + n) = pk4(o);
      }
    }
  }
}
__device__ __forceinline__ void ph_gemm_wout(const Params& p, bf16_t* lds) {
  GEMM_IDS
  const bf16_t* A = (const bf16_t*)(p.ws + OFF_RETOUT);
  const bf16_t* Bt = (const bf16_t*)(p.ws + OFF_WOUT);
  const float* gate = (const float*)(p.ws + OFF_MODS) + 5 * D;
  bool primed = false;
  XCD_TILE_LOOP(t, 128 * 16) {
    int tm, tn;
    tile_map(t, 128, 16, tm, tn);
    f32x4 acc[4][4];
    acc_zero(acc);
    const bf16_t *nA = nullptr, *nB = nullptr;
    if (t + (int)GSZ < 128 * 16) { int tm2, tn2; tile_map(t + GSZ, 128, 16, tm2, tn2); nA = A + (long)tm2 * 128 * D; nB = Bt + (long)tn2 * 128 * D; }
    gemm_acc<true>(acc, A + (long)tm * 128 * D, D, Bt + (long)tn * 128 * D, D, D, lds, nA, nB, primed);
    primed = nA != nullptr;
#pragma unroll
    for (int mi = 0; mi < 4; ++mi) {
      const int m = tm * 128 + 64 * wm + 16 * mi + l15;
#pragma unroll
      for (int ni = 0; ni < 4; ++ni) {
        const int n = tn * 128 + 64 * wn + 16 * ni + 4 * l4;
        float* op = p.out + (long)m * D + n;
        const f32x4 gt = *(const f32x4*)(gate + n);
        const f32x4 rs = *(const f32x4*)(op);
        *(f32x4*)(op) = rs + gt * acc[mi][ni];
      }
    }
  }
}


#define EPI_HEAD static constexpr bool PERM = false, AFTER_DRAIN = false;
typedef const f32x4 (&acc8_t)[2][2][4][2];
struct EpiSwiglu {
  EPI_HEAD
  bf16_t* H;
  __device__ __forceinline__ void operator()(acc8_t acc, const pg8::Unit& u, int wr, int wc, int fr, int fq) const {
#pragma unroll
    for (int ai = 0; ai < 2; ++ai)
#pragma unroll
      for (int m = 0; m < 4; ++m) {
        const int row = u.pm * 256 + ai * 128 + wr * 64 + m * 16 + fr;
#pragma unroll
        for (int n = 0; n < 2; ++n) {
          f32x4 o;
#pragma unroll
          for (int j = 0; j < 4; ++j) o[j] = silu_f(acc[ai][0][m][n][j]) * acc[ai][1][m][n][j];
          *(u32x2*)(H + (long)row * DFF + u.pn * 128 + wc * 32 + n * 16 + fq * 4) = pk4(o);
        }
      }
  }
};
struct EpiDown {
  EPI_HEAD
  const float* res; float* out; const float* gate;
  __device__ __forceinline__ void operator()(acc8_t acc, const pg8::Unit& u, int wr, int wc, int fr, int fq) const {
#pragma unroll
    for (int ai = 0; ai < 2; ++ai)
#pragma unroll
      for (int m = 0; m < 4; ++m) {
        const long ro = (long)(u.pm * 256 + ai * 128 + wr * 64 + m * 16 + fr) * D;
#pragma unroll
        for (int bj = 0; bj < 2; ++bj)
#pragma unroll
          for (int n = 0; n < 2; ++n) {
            const int col = u.pn * 256 + bj * 128 + wc * 32 + n * 16 + fq * 4;
            const f32x4 gt = *(const f32x4*)(gate + col);
            const f32x4 rs = *(const f32x4*)(res + ro + col);
            *(f32x4*)(out + ro + col) = rs + 0.5f * gt * acc[ai][bj][m][n];
          }
      }
  }
};
struct EpiPlain {
  EPI_HEAD
  bf16_t* C; int ldc;
  __device__ __forceinline__ void operator()(acc8_t acc, const pg8::Unit& u, int wr, int wc, int fr, int fq) const {
#pragma unroll
    for (int ai = 0; ai < 2; ++ai)
#pragma unroll
      for (int m = 0; m < 4; ++m) {
        const long ro = (long)(u.pm * 256 + ai * 128 + wr * 64 + m * 16 + fr) * ldc;
#pragma unroll
        for (int bj = 0; bj < 2; ++bj)
#pragma unroll
          for (int n = 0; n < 2; ++n) {
            const int col = u.pn * 256 + bj * 128 + wc * 32 + n * 16 + fq * 4;
            *(u32x2*)(C + ro + col) = pk4(acc[ai][bj][m][n]);
          }
      }
  }
};
struct EpiHyo {
  EPI_HEAD
  bf16_t* ro; const bf16_t* gates;
  __device__ __forceinline__ void operator()(acc8_t acc, const pg8::Unit& u, int wr, int wc, int fr, int fq) const {
#pragma unroll
    for (int ai = 0; ai < 2; ++ai)
#pragma unroll
      for (int m = 0; m < 4; ++m) {
        const long row = u.pm * 256 + ai * 128 + wr * 64 + m * 16 + fr;
#pragma unroll
        for (int bj = 0; bj < 2; ++bj)
#pragma unroll
          for (int n = 0; n < 2; ++n) {
            const int col = u.pn * 256 + bj * 128 + wc * 32 + n * 16 + fq * 4;
            const u32x2 r0 = *(const u32x2*)(ro + row * D + col);
            const u32x2 g0 = *(const u32x2*)(gates + row * 4096 + col);
            const u32x2 g1 = *(const u32x2*)(gates + row * 4096 + 2048 + col);
            const f32x4 a = acc[ai][bj][m][n];
            f32x4 o;
            o[0] = bf2f(g0.x & 0xffffu) * bf2f(r0.x & 0xffffu) + bf2f(g1.x & 0xffffu) * a[0];
            o[1] = bf2f(g0.x >> 16) * bf2f(r0.x >> 16) + bf2f(g1.x >> 16) * a[1];
            o[2] = bf2f(g0.y & 0xffffu) * bf2f(r0.y & 0xffffu) + bf2f(g1.y & 0xffffu) * a[2];
            o[3] = bf2f(g0.y >> 16) * bf2f(r0.y >> 16) + bf2f(g1.y >> 16) * a[3];
            *(u32x2*)(ro + row * D + col) = pk4(o);
          }
      }
  }
};
struct EpiWout {
  EPI_HEAD
  float* out; const float* gate;
  __device__ __forceinline__ void operator()(acc8_t acc, const pg8::Unit& u, int wr, int wc, int fr, int fq) const {
#pragma unroll
    for (int ai = 0; ai < 2; ++ai)
#pragma unroll
      for (int m = 0; m < 4; ++m) {
        const long ro = (long)(u.pm * 256 + ai * 128 + wr * 64 + m * 16 + fr) * D;
#pragma unroll
        for (int bj = 0; bj < 2; ++bj)
#pragma unroll
          for (int n = 0; n < 2; ++n) {
            const int col = u.pn * 256 + bj * 128 + wc * 32 + n * 16 + fq * 4;
            const f32x4 gt = *(const f32x4*)(gate + col);
            const f32x4 rs = *(const f32x4*)(out + ro + col);
            *(f32x4*)(out + ro + col) = rs + gt * acc[ai][bj][m][n];
          }
      }
  }
};
struct EpiWinA {
  EPI_HEAD
  bf16_t *q, *kk, *kTf, *kTb, *vT, *sg; const float2* rope; const float* lg;
  __device__ __forceinline__ void operator()(acc8_t acc, const pg8::Unit& u, int wr, int wc, int fr, int fq) const {
    const int pn = u.pn;
    if (pn < 8) {
      const bool isq = pn < 4;
      const int hh = wc >> 1, hf = wc & 1;
      const int head = 2 * (isq ? pn : pn - 4) + hh;
      const float scl = isq ? 0.08838834764831845f : 1.f;
      const float lgf = lg[head], lgb = lg[8 + head];
#pragma unroll
      for (int ai = 0; ai < 2; ++ai)
#pragma unroll
        for (int m = 0; m < 4; ++m) {
          const int t = u.pm * 256 + ai * 128 + wr * 64 + m * 16 + fr;
          const int pos = hf ? (t & 63) : (t >> 6);
          const int jc = t & 127;
          const float zf = __expf(lgf * (float)(127 - jc)), zb = __expf(lgb * (float)jc);
#pragma unroll
          for (int n = 0; n < 2; ++n) {
            const int i0 = 16 * n + 4 * fq;
            f32x4 o1, o2;
#pragma unroll
            for (int j = 0; j < 4; ++j) {
              const float2 cs = rope[pos * 32 + i0 + j];
              const float x1 = acc[ai][0][m][n][j] * scl, x2 = acc[ai][1][m][n][j] * scl;
              o1[j] = x1 * cs.x - x2 * cs.y;
              o2[j] = x1 * cs.y + x2 * cs.x;
            }
            const int cb = head * 128 + hf * 64 + i0;
            bf16_t* dp = (isq ? q : kk) + (long)t * 1024 + cb;
            *(u32x2*)(dp) = pk4(o1);
            *(u32x2*)(dp + 32) = pk4(o2);
            if (!isq) {
#pragma unroll
              for (int j = 0; j < 4; ++j) {
                kTf[(long)(cb + j) * TT + t] = f2bf(o1[j] * zf);
                kTb[(long)(cb + j) * TT + t] = f2bf(o1[j] * zb);
                kTf[(long)(cb + 32 + j) * TT + t] = f2bf(o2[j] * zf);
                kTb[(long)(cb + 32 + j) * TT + t] = f2bf(o2[j] * zb);
              }
            }
          }
        }
    } else if (pn < 16) {
#pragma unroll
      for (int ai = 0; ai < 2; ++ai)
#pragma unroll
        for (int m = 0; m < 4; ++m) {
          const int t = u.pm * 256 + ai * 128 + wr * 64 + m * 16 + fr;
#pragma unroll
          for (int bj = 0; bj < 2; ++bj)
#pragma unroll
            for (int n = 0; n < 2; ++n) {
              const int ch = (pn - 8) * 256 + bj * 128 + wc * 32 + n * 16 + fq * 4;
#pragma unroll
              for (int j = 0; j < 4; ++j) vT[(long)(ch + j) * TT + t] = f2bf(acc[ai][bj][m][n][j]);
            }
        }
    } else {
#pragma unroll
      for (int ai = 0; ai < 2; ++ai)
#pragma unroll
        for (int m = 0; m < 4; ++m) {
          const long t = u.pm * 256 + ai * 128 + wr * 64 + m * 16 + fr;
#pragma unroll
          for (int bj = 0; bj < 2; ++bj)
#pragma unroll
            for (int n = 0; n < 2; ++n) {
              const int col = (pn - 16) * 256 + bj * 128 + wc * 32 + n * 16 + fq * 4;
              f32x4 o;
#pragma unroll
              for (int j = 0; j < 4; ++j) o[j] = silu_f(acc[ai][bj][m][n][j]);
              *(u32x2*)(sg + t * D + col) = pk4(o);
            }
        }
    }
  }
};
struct EpiWinB {
  EPI_HEAD
  bf16_t *phy, *gates;
  __device__ __forceinline__ void operator()(acc8_t acc, const pg8::Unit& u, int wr, int wc, int fr, int fq) const {
    const int pn = u.pn;
#pragma unroll
    for (int ai = 0; ai < 2; ++ai)
#pragma unroll
      for (int m = 0; m < 4; ++m) {
        const long t = u.pm * 256 + ai * 128 + wr * 64 + m * 16 + fr;
#pragma unroll
        for (int bj = 0; bj < 2; ++bj)
#pragma unroll
          for (int n = 0; n < 2; ++n) {
            const int cl = bj * 128 + wc * 32 + n * 16 + fq * 4;
            if (pn < 48) {
              *(u32x2*)(phy + t * 6144 + (pn - 24) * 256 + cl) = pk4(acc[ai][bj][m][n]);
            } else {
              f32x4 o;
#pragma unroll
              for (int j = 0; j < 4; ++j) o[j] = sigm_f(acc[ai][bj][m][n][j]);
              *(u32x2*)(gates + t * 4096 + (pn - 48) * 256 + cl) = pk4(o);
            }
          }
      }
  }
};
template <class Epi>
__device__ __forceinline__ void big_gemm(char* lds_all, const bf16_t* A, const bf16_t* Bt, int K, int nM, int nN, int pn0, const Epi& E) {
  pg8::Gemm g;
  g.A = A; g.Bt = Bt; g.M = nM * 256; g.N = 0; g.K = K;
  pg8::TileOrder S;
  S.init(nM, nN, pn0, (int)gridDim.x, (int)blockIdx.x);
  pg8::gemm_phase(( __attribute__((address_space(3))) unsigned char*)lds_all, g, S, E);
}

__device__ __forceinline__ void ph_ctx_up(const Params& p, char* lds_all) {
  GEMM_IDS
  const int hv = fresh_tid() >> 8;
  bf16_t* lds = (bf16_t*)(lds_all + hv * LDS_HALF);
  u32x2* xch = (u32x2*)lds_all;
  const bf16_t* A = (const bf16_t*)(p.ws + OFF_AR) + (long)T * D;
  const bf16_t* Bt = (const bf16_t*)(p.ws + OFF_WBIG);
  bf16_t* H = (bf16_t*)(p.ws + OFF_H);
  for (int it = (int)blockIdx.x; it < 88; it += (int)gridDim.x) {
    const int tmc = it / 44, P = it % 44;
    f32x4 acc[4][4];
    acc_zero(acc);
    gemm_acc<true>(acc, A + (long)tmc * 128 * D, D, Bt + (long)(256 * P + 128 * hv) * D, D, D, lds);
    if (hv == 0) {
#pragma unroll
      for (int mi = 0; mi < 4; ++mi)
#pragma unroll
        for (int ni = 0; ni < 4; ++ni) {
          f32x4 o;
#pragma unroll
          for (int r = 0; r < 4; ++r) o[r] = silu_f(acc[mi][ni][r]);
          xch[(mi * 4 + ni) * 256 + TID] = pk4(o);
        }
    }
    __syncthreads();
    if (hv == 1) {
#pragma unroll
      for (int mi = 0; mi < 4; ++mi) {
        const int m = T + tmc * 128 + 64 * wm + 16 * mi + l15;
#pragma unroll
        for (int ni = 0; ni < 4; ++ni) {
          const int n = 128 * P + 64 * wn + 16 * ni + 4 * l4;
          const u32x2 w = xch[(mi * 4 + ni) * 256 + TID];
          f32x4 o;
          o[0] = bf2f(w.x & 0xffffu) * acc[mi][ni][0];
          o[1] = bf2f(w.x >> 16) * acc[mi][ni][1];
          o[2] = bf2f(w.y & 0xffffu) * acc[mi][ni][2];
          o[3] = bf2f(w.y >> 16) * acc[mi][ni][3];
          *(u32x2*)(H + (long)m * DFF + n) = pk4(o);
        }
      }
    }
  }
}
__device__ __forceinline__ void ph_ctx_down(const Params& p, bf16_t* lds) {
  GEMM_IDS
  const bf16_t* A = (const bf16_t*)(p.ws + OFF_H) + (long)T * DFF;
  const bf16_t* Bt = (const bf16_t*)(p.ws + OFF_WDOWN);
  const float* gate = (const float*)(p.ws + OFF_MODS) + NMOD + 2 * D;
  float* outc = (float*)(p.ws + OFF_CTX1);
  for (int it = BID; it < 128; it += GSZ) {
    const int ks = it & 3, tn = (it >> 2) & 15, tmc = it >> 6;
    f32x4 acc[4][4];
    acc_zero(acc);
    gemm_acc<true>(acc, A + (long)tmc * 128 * DFF + ks * 1408, DFF, Bt + (long)tn * 128 * DFF + ks * 1408, DFF, 1408, lds);
#pragma unroll
    for (int mi = 0; mi < 4; ++mi) {
      const int m = tmc * 128 + 64 * wm + 16 * mi + l15;
#pragma unroll
      for (int ni = 0; ni < 4; ++ni) {
        const int n = tn * 128 + 64 * wn + 16 * ni + 4 * l4;
        const f32x4 gt = *(const f32x4*)(gate + n);
#pragma unroll
        for (int r = 0; r < 4; ++r) atomicAdd(outc + (long)m * D + n + r, 0.5f * gt[r] * acc[mi][ni][r]);
      }
    }
  }
}
__device__ __forceinline__ void ph_ctx1_init(const Params& p) {
  f32x4* o = (f32x4*)(p.ws + OFF_CTX1);
  const f32x4* src = (const f32x4*)p.ctx;
  for (int i = BID * 256 + TID; i < 256 * D / 4; i += GSZ * 256) o[i] = src[i];
}
__device__ __forceinline__ void ph_ctx_win(const Params& p, char* lds_all) {
  GEMM_IDS
  const int hv = fresh_tid() >> 8;
  bf16_t* lds = (bf16_t*)(lds_all + hv * LDS_HALF);
  float* xacc = (float*)(lds_all + LDS_HALF);
  const bf16_t* A = (const bf16_t*)(p.ws + OFF_AR) + (long)T * D + hv * 1024;
  const bf16_t* Bt = (const bf16_t*)(p.ws + OFF_WBIG) + hv * 1024;
  bf16_t* kTf = (bf16_t*)(p.ws + OFF_KTF);
  bf16_t* kTb = (bf16_t*)(p.ws + OFF_KTB);
  bf16_t* vT = (bf16_t*)(p.ws + OFF_VT);
  for (int it = (int)blockIdx.x; it < 48; it += (int)gridDim.x) {
    f32x4 acc[4][4];
    acc_zero(acc);
    const bool isk = it < 16;
    const int u2 = it - 16;
    const int tmc = isk ? (it >> 3) : (u2 >> 4);
    const int kt8 = it & 7, tv = u2 & 15;
    if (isk)
      gemm_acc<true>(acc, A + (long)tmc * 128 * D, D, Bt + (long)(1024 + kt8 * 128) * D, D, 1024, lds);
    else
      gemm_acc<false>(acc, A + (long)tmc * 128 * D, D, Bt + (long)(2048 + tv * 128) * D, D, 1024, lds);
    if (hv == 1) {
#pragma unroll
      for (int mi = 0; mi < 4; ++mi)
#pragma unroll
        for (int ni = 0; ni < 4; ++ni) *(f32x4*)(xacc + ((mi * 4 + ni) * 256 + TID) * 4) = acc[mi][ni];
    }
    __syncthreads();
    if (hv == 0) {
#pragma unroll
      for (int mi = 0; mi < 4; ++mi)
#pragma unroll
        for (int ni = 0; ni < 4; ++ni) acc[mi][ni] += *(const f32x4*)(xacc + ((mi * 4 + ni) * 256 + TID) * 4);
      if (isk) {
        const int P = kt8 >> 1, sx = kt8 & 1;
        const int head = 2 * P + wn;
        const float lgf = p.lg[head], lgb = p.lg[8 + head];
#pragma unroll
        for (int mi = 0; mi < 4; ++mi) {
          const int m = T + tmc * 128 + 64 * wm + 16 * mi + l15;
          const int jc = m & 127;
          const float zf = __expf(lgf * (float)(127 - jc)), zb = __expf(lgb * (float)jc);
#pragma unroll
          for (int ni = 0; ni < 4; ++ni) {
            const int hf = ni >> 1, i0 = 16 * (ni & 1) + 4 * l4;
            const int cb = head * 128 + hf * 64 + i0 + 32 * sx;
#pragma unroll
            for (int r = 0; r < 4; ++r) {
              kTf[(long)(cb + r) * TT + m] = f2bf(acc[mi][ni][r] * zf);
              kTb[(long)(cb + r) * TT + m] = f2bf(acc[mi][ni][r] * zb);
            }
          }
        }
      } else {
#pragma unroll
        for (int mi = 0; mi < 4; ++mi) {
          const int m0 = T + tmc * 128 + 64 * wm + 16 * mi + 4 * l4;
#pragma unroll
          for (int ni = 0; ni < 4; ++ni) {
            const int ch = tv * 128 + 64 * wn + 16 * ni + l15;
            *(u32x2*)(vT + (long)ch * TT + m0) = pk4(acc[mi][ni]);
          }
        }
      }
    }
  }
}

#define XB_TMO      128
#define XB_XCNT(j)  (256  + 64 * (j))
#define XB_XSUB(j)  (1280 + 64 * (j))
#define XB_XGEN(j)  (2304 + 64 * (j))
#define XB_TOP      3328
#define XB_TOPGEN   3392
#define XCD_BAR_WORDS 3456
#define XB_SPIN_CAP (1u << 18)
#define LAS __attribute__((address_space(3)))

__device__ __forceinline__ unsigned xb_ld(unsigned* p)              { return __hip_atomic_load(p, __ATOMIC_RELAXED, __HIP_MEMORY_SCOPE_AGENT); }
__device__ __forceinline__ unsigned xb_add(unsigned* p, unsigned v) { return __hip_atomic_fetch_add(p, v, __ATOMIC_RELAXED, __HIP_MEMORY_SCOPE_AGENT); }
__device__ __forceinline__ unsigned xb_xcc_id() { return (unsigned)__builtin_amdgcn_s_getreg((3 << 11) | 20) & 0xFu; }
#define XB_SPIN(cond, bar) do { unsigned _sp = 0; while (cond) { __builtin_amdgcn_s_sleep(1); \
    if ((++_sp & 255u) == 0u) { if (xb_ld(&(bar)[XB_TMO])) break; if (_sp > XB_SPIN_CAP) { atomicAdd(&(bar)[XB_TMO], 1u); break; } } } } while (0)

struct XcdBarrier {
    unsigned* bar; unsigned x;
    volatile LAS unsigned* st;
};

__device__ __forceinline__ XcdBarrier xcd_barrier_post(unsigned* bar, volatile LAS unsigned* st) {
    XcdBarrier b; b.bar = bar; b.x = xb_xcc_id(); b.st = st;
    if (threadIdx.x == 0) (void)xb_add(&bar[XB_XCNT(b.x)], 1u);
    return b;
}
__device__ __forceinline__ void xcd_barrier_complete(unsigned* bar, unsigned x, unsigned& nloc, unsigned& nx) {
    const unsigned G = gridDim.x * gridDim.y * gridDim.z;
    unsigned sum, cnt, mine, sp = 0u;
    for (;;) {
        sum = 0u; cnt = 0u; mine = 0u;
#pragma unroll
        for (unsigned j = 0; j < 16; ++j) { const unsigned c = xb_ld(&bar[XB_XCNT(j)]); sum += c; cnt += (c > 0u) ? 1u : 0u; mine = (j == x) ? c : mine; }
        if (sum == G) break;
        __builtin_amdgcn_s_sleep(1);
        if ((++sp & 255u) == 0u) { if (xb_ld(&bar[XB_TMO])) break; if (sp > XB_SPIN_CAP) { atomicAdd(&bar[XB_TMO], 1u); break; } }
    }
    nloc = mine > 0u ? mine : 1u; nx = cnt > 0u ? cnt : 1u;
}

__device__ __forceinline__ void xcd_barrier(const XcdBarrier& b) {
    asm volatile("s_waitcnt vmcnt(0)" ::: "memory");
    __syncthreads();
    if (threadIdx.x == 0) {
        unsigned* bar = b.bar;
        __builtin_amdgcn_s_waitcnt(0);
        unsigned nloc = b.st[0], nx = b.st[1];
        if (nloc == 0u) { xcd_barrier_complete(bar, b.x, nloc, nx); b.st[0] = nloc; b.st[1] = nx; }
        const unsigned old = xb_add(&bar[XB_XSUB(b.x)], 1u);
        const unsigned gen = old / nloc;
        if (old + 1u == (gen + 1u) * nloc) {
            __builtin_amdgcn_fence(__ATOMIC_RELEASE, "agent");
            asm volatile("s_waitcnt vmcnt(0)" ::: "memory");
            const unsigned og = xb_add(&bar[XB_TOP], 1u);
            const unsigned tg = og / nx;
            if (og + 1u == (tg + 1u) * nx) xb_add(&bar[XB_TOPGEN], 1u);
            else XB_SPIN(xb_ld(&bar[XB_TOPGEN]) == tg, bar);
            __builtin_amdgcn_fence(__ATOMIC_ACQUIRE, "agent");
            xb_add(&bar[XB_XGEN(b.x)], 1u);
            asm volatile("s_waitcnt vmcnt(0)" ::: "memory");
        } else {
            XB_SPIN(xb_ld(&bar[XB_XGEN(b.x)]) == gen, bar);
            __builtin_amdgcn_fence(__ATOMIC_ACQUIRE, "agent");
            asm volatile("s_waitcnt vmcnt(0)" ::: "memory");
        }
    }
    __syncthreads();
}


__device__ __forceinline__ void gbar(unsigned* ctr, unsigned target) {
  asm volatile("s_waitcnt vmcnt(0) lgkmcnt(0)" ::: "memory");
  __syncthreads();
  if (threadIdx.x == 0) {
    __builtin_amdgcn_fence(__ATOMIC_RELEASE, "agent");
    asm volatile("s_waitcnt vmcnt(0)" ::: "memory");
    __hip_atomic_fetch_add(ctr, 1u, __ATOMIC_RELAXED, __HIP_MEMORY_SCOPE_AGENT);
    unsigned spins = 0;
    while (__hip_atomic_load(ctr, __ATOMIC_RELAXED, __HIP_MEMORY_SCOPE_AGENT) < target) {
      __builtin_amdgcn_s_sleep(2);
      if (++spins > (1u << 20)) break;
    }
    __builtin_amdgcn_fence(__ATOMIC_ACQUIRE, "agent");
    asm volatile("s_waitcnt vmcnt(0)" ::: "memory");
  }
  __syncthreads();
}
#ifndef SKIP_HY
#define SKIP_HY 0
#endif
#ifndef ONLY_NORM
#define ONLY_NORM 0
#endif
#ifndef SKIP_MIXER
#define SKIP_MIXER 0
#endif

__global__ void __launch_bounds__(512, 2) mega(Params p, int lo, int hi) {
  __shared__ __attribute__((aligned(1024))) char ldsc_all[LDS_BYTES];
#define ldsc (ldsc_all + (fresh_tid() >> 8) * LDS_HALF)
  cg::grid_group grid = cg::this_grid();
#define lds ((bf16_t*)ldsc)
#define ldsf ((float*)ldsc)
  char* ws = p.ws;
  volatile LAS unsigned* xb_st = (volatile LAS unsigned*)(ldsc_all + LDS_BYTES - 16);
  if (threadIdx.x == 0) { xb_st[0] = 0u; xb_st[1] = 0u; }
  __syncthreads();
  const XcdBarrier xb = xcd_barrier_post((unsigned*)(ws + OFF_BAR), xb_st);
#define PH(k, body) if (lo <= (k) && (k) < hi) { body; if ((k) + 1 < hi) xcd_barrier(xb); }
  if (lo < 0) grid.sync();
  PH(0, ph_mods_partial(p, ldsf))
  PH(2, ph_prenorm(p, p.x, p.ctx, TT, p.norm_g, 0);
        conv_weight(p.ffn_up, 2048, 11264, 11264, (bf16_t*)(ws + OFF_WBIG), 2, ldsf);
        conv_weight(p.ffn_down, 5632, 2048, 2048, (bf16_t*)(ws + OFF_WDOWN), 0, ldsf);
        conv_weight(p.w4, 64, 4096, 4096, (bf16_t*)(ws + OFF_W4T), 0, ldsf);
        conv_weight(p.w_ret_o, 2048, 2048, 2048, (bf16_t*)(ws + OFF_WRO), 0, ldsf);
        conv_weight(p.w_hy_o, 2048, 2048, 2048, (bf16_t*)(ws + OFF_WHO), 0, ldsf);
        conv_weight(p.w_out, 2048, 2048, 2048, (bf16_t*)(ws + OFF_WOUT), 0, ldsf);
        ph_misc0(p))
  PH(3, big_gemm(ldsc_all, (const bf16_t*)(ws + OFF_AR), (const bf16_t*)(ws + OFF_WBIG), 2048, 64, 44, 0, EpiSwiglu{(bf16_t*)(ws + OFF_H)});
        ph_ctx_up(p, ldsc_all); ph_ctx1_init(p))
  PH(4, big_gemm(ldsc_all, (const bf16_t*)(ws + OFF_H), (const bf16_t*)(ws + OFF_WDOWN), 5632, 64, 8, 0, EpiDown{p.x, p.out, (const float*)(ws + OFF_MODS) + 2 * D});
        ph_ctx_down(p, lds))
  PH(5, ph_prenorm(p, p.out, (const float*)(ws + OFF_CTX1), TT, p.norm_g + D, 1);
        conv_weight(p.w_in, 2048, 16384, 16384, (bf16_t*)(ws + OFF_WBIG), 3, ldsf))
#if !SKIP_MIXER
  PH(6, big_gemm(ldsc_all, (const bf16_t*)(ws + OFF_AR), (const bf16_t*)(ws + OFF_WBIG), 2048, 64, 24, 0,
                 EpiWinA{(bf16_t*)(ws + OFF_Q), (bf16_t*)(ws + OFF_K), (bf16_t*)(ws + OFF_KTF), (bf16_t*)(ws + OFF_KTB), (bf16_t*)(ws + OFF_VT), (bf16_t*)(ws + OFF_SG), (const float2*)(ws + OFF_ROPE), p.lg});
        ph_ctx_win(p, ldsc_all))
  PH(7, ph_ret_kv_p(p, lds))
  PH(8, ph_ret_scan(p))
  PH(9, ph_ret_out(p, ldsc_all))
  PH(11, big_gemm(ldsc_all, (const bf16_t*)(ws + OFF_Y), (const bf16_t*)(ws + OFF_WRO), 2048, 64, 8, 0, EpiPlain{(bf16_t*)(ws + OFF_RETOUT), D}))
  PH(12, big_gemm(ldsc_all, (const bf16_t*)(ws + OFF_AR), (const bf16_t*)(ws + OFF_WBIG), 2048, 64, 40, 24, EpiWinB{(bf16_t*)(ws + OFF_PHY), (bf16_t*)(ws + OFF_GATES)}))
#if !SKIP_HY
  PH(13, ph_hy_conv(p); ph_taps(p, 0, lds); ph_taps(p, 1, lds))
#endif
#if !SKIP_HY
  PH(15, ph_fft_a(p, 0, ldsc))
  PH(16, ph_fft_mid(p, ldsc_all))
  PH(17, ph_fft_c(p, 0, ldsc))
  PH(19, ph_fft_a(p, 1, ldsc))
  PH(20, ph_fft_mid(p, ldsc_all))
  PH(21, ph_fft_c(p, 1, ldsc))
#endif
  PH(26, big_gemm(ldsc_all, (const bf16_t*)(ws + OFF_X0), (const bf16_t*)(ws + OFF_WHO), 2048, 64, 8, 0, EpiHyo{(bf16_t*)(ws + OFF_RETOUT), (const bf16_t*)(ws + OFF_GATES)}))
  PH(27, big_gemm(ldsc_all, (const bf16_t*)(ws + OFF_RETOUT), (const bf16_t*)(ws + OFF_WOUT), 2048, 64, 8, 0, EpiWout{p.out, (const float*)(ws + OFF_MODS) + 5 * D}))
#endif
  PH(28, ph_prenorm(p, p.out, p.out, T, p.norm_g + 2 * D, 2);
         conv_weight(p.ffn_up + (long)2048 * 11264, 2048, 11264, 11264, (bf16_t*)(ws + OFF_WBIG), 2, ldsf);
         conv_weight(p.ffn_down + (long)5632 * 2048, 5632, 2048, 2048, (bf16_t*)(ws + OFF_WDOWN), 0, ldsf))
  PH(29, big_gemm(ldsc_all, (const bf16_t*)(ws + OFF_AR), (const bf16_t*)(ws + OFF_WBIG), 2048, 64, 44, 0, EpiSwiglu{(bf16_t*)(ws + OFF_H)}))
  PH(30, big_gemm(ldsc_all, (const bf16_t*)(ws + OFF_H), (const bf16_t*)(ws + OFF_WDOWN), 5632, 64, 8, 0, EpiDown{p.out, p.out, (const float*)(ws + OFF_MODS) + 8 * D}))
  PH(31, ph_final_norm(p))
}

extern "C" void kernel_launch(void* const* d_in, const int* in_sizes, int n_in, void* d_out, int out_size, void* d_ws,
                              size_t ws_size, hipStream_t stream) {
  if (ws_size < (size_t)WS_NEED || n_in < 29) {
    fprintf(stderr, "workspace too small: %zu\n", ws_size);
    return;
  }
  static int grid_blocks = 0;
  if (!grid_blocks) {
    int dev = 0, cus = 0, per_cu = 0;
    hipGetDevice(&dev);
    hipDeviceGetAttribute(&cus, hipDeviceAttributeMultiprocessorCount, dev);
    hipOccupancyMaxActiveBlocksPerMultiprocessor(&per_cu, mega, 512, 0);
    if (per_cu > 1) per_cu = 1;
    if (per_cu < 1) per_cu = 1;
    grid_blocks = cus * per_cu;
  }
  Params p{};
  const float** pp = (const float**)&p;
  for (int i = 0; i < 29; ++i) pp[i] = (const float*)d_in[i];
  p.out = (float*)d_out;
  p.ws = (char*)d_ws;
  hipMemsetAsync((char*)d_ws + OFF_BAR, 0, XCD_BAR_WORDS * 4, stream);
  hipMemsetAsync((char*)d_ws + OFF_MODS, 0, 2 * NMOD * 4, stream);
  int lo = 0, hi = NPH;
  void* args[] = {&p, &lo, &hi};
  hipError_t e = hipLaunchCooperativeKernel((void*)mega, dim3(grid_blocks), dim3(512), args, 0, stream);
  if (e != hipSuccess) fprintf(stderr, "cooperative launch failed: %s (grid %d)\n", hipGetErrorString(e), grid_blocks);
}
```

```cpp
#include <hip/hip_runtime.h>
#include <hip/hip_cooperative_groups.h>
#include <cstdio>
namespace cg = cooperative_groups;

typedef unsigned short bf16_t;
typedef short bf16x8 __attribute__((ext_vector_type(8)));
typedef float f32x4 __attribute__((ext_vector_type(4)));
typedef unsigned u32x2 __attribute__((ext_vector_type(2)));
typedef unsigned u32x4 __attribute__((ext_vector_type(4)));

__device__ __forceinline__ int fresh_tid() { int t = (int)threadIdx.x; asm volatile("" : "+v"(t)); return t; }
#define TID (fresh_tid() & 255)
#define BID ((int)(blockIdx.x * 2u) + (fresh_tid() >> 8))
#define GSZ ((int)(gridDim.x * 2u))
constexpr int T = 16384, TT = 16640, D = 2048, DFF = 5632;
constexpr long MiB = 1l << 20;
constexpr int NMOD = 18432;
constexpr long OFF_MODSPART = 0;
constexpr long OFF_MODS = 5 * MiB;
constexpr long OFF_SUMSQ = 5 * MiB + 512 * 1024;
constexpr long OFF_ROPE = 6 * MiB;
constexpr long OFF_BAR = 5 * MiB + 768 * 1024;
constexpr long OFF_CTX1 = 7 * MiB;
constexpr long OFF_H3B = 13 * MiB, OFF_W4T = 15 * MiB;
constexpr long OFF_TAPS = 104 * MiB, OFF_TAPS1 = 40 * MiB;
constexpr long OFF_WRO = 16 * MiB, OFF_WHO = 24 * MiB, OFF_WOUT = 32 * MiB;
constexpr long OFF_WBIG = 40 * MiB, OFF_WDOWN = 84 * MiB;
constexpr long OFF_AR = 106 * MiB;
constexpr long OFF_H = 171 * MiB;
constexpr long OFF_Q = 171 * MiB, OFF_K = 203 * MiB, OFF_KTF = 235 * MiB, OFF_KTB = 268 * MiB, OFF_VT = 301 * MiB,
               OFF_SG = 366 * MiB, OFF_KVT = 430 * MiB, OFF_P = 560 * MiB, OFF_Y = 592 * MiB;
constexpr long OFF_RETOUT = 171 * MiB, OFF_GATES = 235 * MiB, OFF_X0 = 363 * MiB, OFF_Z = 427 * MiB, OFF_PHY = 491 * MiB;
constexpr long OFF_S = 491 * MiB, OFF_KC = 40 * MiB;
constexpr long WS_NEED = 683 * MiB;
constexpr int LDS_HALF = 69632;
constexpr int LDS_BYTES = 2 * LDS_HALF;
constexpr int NPH = 32;
#ifndef SKIP_HY
#define SKIP_HY 0
#endif

struct Params {
  const float *x, *c, *ctx, *c_ctx, *w_ada, *b_ada, *norm_g, *ffn_up, *ffn_down, *w_in, *lg, *gn_g, *gn_b, *w_ret_o,
      *conv_w, *conv_b, *w1, *b1, *w2, *b2, *w3, *b3, *w4, *freq, *decay, *skip, *w_hy_o, *w_out, *fin_g;
  float* out;
  char* ws;
};

__device__ __forceinline__ float bf2f(unsigned h) { return __uint_as_float(h << 16); }
typedef float f32x2_t __attribute__((ext_vector_type(2)));
typedef __bf16 bf16x2_t __attribute__((ext_vector_type(2)));
__device__ __forceinline__ unsigned pk2(float lo, float hi) {
  const f32x2_t v = {lo, hi};
  const bf16x2_t b = __builtin_convertvector(v, bf16x2_t);
  return __builtin_bit_cast(unsigned, b);
}
__device__ __forceinline__ bf16_t f2bf(float f) { return (bf16_t)(pk2(f, 0.f) & 0xffffu); }
__device__ __forceinline__ u32x2 pk4(f32x4 v) {
  u32x2 r;
  r.x = pk2(v[0], v[1]);
  r.y = pk2(v[2], v[3]);
  return r;
}
__device__ __forceinline__ float wave_sum(float v) {
#pragma unroll
  for (int o = 32; o > 0; o >>= 1) v += __shfl_xor(v, o);
  return v;
}
__device__ __forceinline__ float silu_f(float v) { return v * __builtin_amdgcn_rcpf(1.f + __expf(-v)); }
__device__ __forceinline__ float sigm_f(float v) { return __builtin_amdgcn_rcpf(1.f + __expf(-v)); }

typedef __attribute__((address_space(3))) unsigned lds_u32_t;
template <bool SWAP>
__device__ __forceinline__ void gemm_acc(f32x4 (&acc)[4][4], const bf16_t* A, long lda, const bf16_t* Bt, long ldb, int K,
                                         bf16_t* lds, const bf16_t* nA = nullptr, const bf16_t* nB = nullptr,
                                         bool primed = false, long nlda = -1, long nldb = -1) {
  const int tid = TID, lane = tid & 63, w = tid >> 6, wm = w >> 1, wn = w & 1;
  char* ldsb = (char*)lds;
  const int chunk = (tid & 7) ^ ((tid >> 4) & 7);
  const int oa = (tid >> 3) * (int)lda + chunk * 8, ob = (tid >> 3) * (int)ldb + chunk * 8;
  const int sa = 32 * (int)lda, sb = 32 * (int)ldb;
  const int nk = K >> 6;
  if (!primed) {
    __syncthreads();
#pragma unroll
    for (int i = 0; i < 4; ++i) {
      __builtin_amdgcn_global_load_lds((const unsigned*)(A + (oa + i * sa)), (lds_u32_t*)(ldsb + tid * 16 + i * 4096), 16, 0, 0);
      __builtin_amdgcn_global_load_lds((const unsigned*)(Bt + (ob + i * sb)), (lds_u32_t*)(ldsb + 16384 + tid * 16 + i * 4096), 16, 0, 0);
    }
  }
  asm volatile("s_waitcnt vmcnt(0)" ::: "memory");
  __syncthreads();
  const int l15 = lane & 15, l4 = lane >> 4;
  const int o0 = l15 * 128 + ((l4 ^ (l15 >> 1)) << 4);
  for (int kt = 0; kt < nk; ++kt) {
    const int cur = kt & 1;
    if (kt + 1 < nk) {
      char* d = ldsb + (cur ^ 1) * 32768 + tid * 16;
#pragma unroll
      for (int i = 0; i < 4; ++i) {
        __builtin_amdgcn_global_load_lds((const unsigned*)(A + (oa + i * sa + (kt + 1) * 64)), (lds_u32_t*)(d + i * 4096), 16, 0, 0);
        __builtin_amdgcn_global_load_lds((const unsigned*)(Bt + (ob + i * sb + (kt + 1) * 64)), (lds_u32_t*)(d + 16384 + i * 4096), 16, 0, 0);
      }
    }
    const char* la = ldsb + cur * 32768 + (64 * wm) * 128;
    const char* lb = ldsb + cur * 32768 + 16384 + (64 * wn) * 128;
#pragma unroll
    for (int ks = 0; ks < 2; ++ks) {
      bf16x8 af[4], bfr[4];
#pragma unroll
      for (int i = 0; i < 4; ++i) {
        af[i] = *(const bf16x8*)(la + i * 2048 + (o0 ^ (ks * 64)));
        bfr[i] = *(const bf16x8*)(lb + i * 2048 + (o0 ^ (ks * 64)));
      }
#pragma unroll
      for (int mi = 0; mi < 4; ++mi)
#pragma unroll
        for (int ni = 0; ni < 4; ++ni) {
          if (SWAP)
            acc[mi][ni] = __builtin_amdgcn_mfma_f32_16x16x32_bf16(bfr[ni], af[mi], acc[mi][ni], 0, 0, 0);
          else
            acc[mi][ni] = __builtin_amdgcn_mfma_f32_16x16x32_bf16(af[mi], bfr[ni], acc[mi][ni], 0, 0, 0);
        }
    }
    asm volatile("s_waitcnt vmcnt(0)" ::: "memory");
    __syncthreads();
  }
  if (nA != nullptr) {
    const int la2 = (nlda < 0) ? (int)lda : (int)nlda, lb2 = (nldb < 0) ? (int)ldb : (int)nldb;
    const int oa2 = (tid >> 3) * la2 + chunk * 8, ob2 = (tid >> 3) * lb2 + chunk * 8;
#pragma unroll
    for (int i = 0; i < 4; ++i) {
      __builtin_amdgcn_global_load_lds((const unsigned*)(nA + (oa2 + i * 32 * la2)), (lds_u32_t*)(ldsb + tid * 16 + i * 4096), 16, 0, 0);
      __builtin_amdgcn_global_load_lds((const unsigned*)(nB + (ob2 + i * 32 * lb2)), (lds_u32_t*)(ldsb + 16384 + tid * 16 + i * 4096), 16, 0, 0);
    }
  }
}
__device__ __forceinline__ void acc_zero(f32x4 (&acc)[4][4]) {
#pragma unroll
  for (int i = 0; i < 4; ++i)
#pragma unroll
    for (int j = 0; j < 4; ++j) acc[i][j] = (f32x4){0.f, 0.f, 0.f, 0.f};
}
__device__ __forceinline__ void tile_map(int t, int ntm, int ntn, int& tm, int& tn) {
  const int GM = 8;
  const int per = GM * ntn;
  const int g = t / per, fm = g * GM;
  const int gsz = (ntm - fm) < GM ? (ntm - fm) : GM;
  const int rem = t - g * per;
  tn = rem / gsz;
  tm = fm + rem % gsz;
}

namespace pg8 {
#define PG8_LAS __attribute__((address_space(3)))
constexpr int BM = 256, BK = 64, HALF = 128, HTB = HALF * BK * 2  , STAGE_BYTES = 8 * HTB, NXCD = 8, WGM = 8;

__host__ __device__ __forceinline__ int lds_byte(int r, int c) { const int st = (r >> 4) * 2 + (c >> 5), rr = r & 15, cc = c & 31, ob = rr * 64 + cc * 2; return st * 1024 + (ob ^ (((ob >> 9) & 1) << 5)); }
__host__ __device__ __forceinline__ void stage_rc(int b, int& R, int& C) { const int st = b / 1024, sb = b % 1024, swz = sb ^ (((sb >> 9) & 1) << 5); R = (st >> 1) * 16 + swz / 64; C = (st & 1) * 32 + (swz % 64) / 2; }
__host__ __device__ __forceinline__ int perm32(int rho) { const int n = rho >> 4, i = rho & 15; return 8 * (i >> 2) + 4 * n + (i & 3); }

struct Unit { int pm, pn; };
struct Gemm { const bf16_t* A; const bf16_t* Bt; int M, N, K; };

struct TileOrder {
  int nM, nN, nwg, G, c, pn0;
  __device__ __forceinline__ void init(int nM_, int nN_, int pn0_, int G_, int c_) { nM = nM_; nN = nN_; nwg = nM_ * nN_; G = G_; c = c_; pn0 = pn0_; }
  __device__ __forceinline__ bool next(int i, Unit& u) const {
    const long L = (long)i * G + c;
    if (L >= nwg) return false;
    int wgid = (int)L;
    { const int q = nwg / NXCD, r = nwg % NXCD, xcd = wgid % NXCD, off = wgid / NXCD; wgid = (xcd < r ? xcd * (q + 1) : r * (q + 1) + (xcd - r) * q) + off; }
    const int nig = WGM * nN, gid = wgid / nig, fm = gid * WGM, gsz = (nM - fm) < WGM ? (nM - fm) : WGM;
    u.pm = fm + ((wgid % nig) % gsz);
    u.pn = pn0 + (wgid % nig) / gsz;
    return true;
  }
  __device__ __forceinline__ void a_ready(const Unit&) const {}
  __device__ __forceinline__ void done(const Unit&) const {}
};

template <class Epi, class Sched>
__device__ __forceinline__ void gemm_phase(PG8_LAS unsigned char* lds, const Gemm g, const Sched& S, const Epi& E) {
    const int tid = threadIdx.x, wid = __builtin_amdgcn_readfirstlane(tid >> 6), lane = tid & 63, wr = wid >> 2, wc = wid & 3, fr = lane & 15, fq = lane >> 4;
    const int K = g.K, nt = K / BK;
#define PG8_STAMP() do { } while (0)
    PG8_STAMP();
    unsigned voffA[2], voffB[2];
#pragma unroll
    for (int i = 0; i < 2; ++i) { int R, C; stage_rc(tid * 16 + i * 8192, R, C); const int Rb = Epi::PERM ? ((R & ~31) + perm32(R & 31)) : R;
        voffA[i] = (unsigned)(R * K + C) * 2u; voffB[i] = (unsigned)(Rb * K + C) * 2u; }
    const size_t kstep = (size_t)(BK * 2);
    const size_t hstep = (size_t)HALF * K * 2;
    const size_t tstep = 2 * hstep;
    const unsigned ldsw = (unsigned)wid * 1024u;
    const int aoff = lds_byte(wr * 64 + fr, fq * 8), boff = lds_byte(wc * 32 + fr, fq * 8);
#define PG8_SA(b, h) (((b) * 2 + (h)) * HTB)
#define PG8_SB(b, h) ((4 + (b) * 2 + (h)) * HTB)
#define PG8_STAGE(bufoff, gbase, voff) do { _Pragma("unroll") for (int _i = 0; _i < 2; ++_i) \
        __builtin_amdgcn_global_load_lds((const unsigned*)((const char*)(gbase) + (voff)[_i]), (PG8_LAS unsigned*)(lds + (bufoff) + ldsw + _i * 8192), 16, 0, 0); } while (0)
#define PG8_LDA(dst, b, h) do { _Pragma("unroll") for (int m = 0; m < 4; ++m) _Pragma("unroll") for (int k = 0; k < 2; ++k) dst[m][k] = *(const PG8_LAS bf16x8*)(lds + PG8_SA(b, h) + aoff + m * 2048 + k * 1024); } while (0)
#define PG8_LDB(dst, b, h) do { _Pragma("unroll") for (int n = 0; n < 2; ++n) _Pragma("unroll") for (int k = 0; k < 2; ++k) dst[n][k] = *(const PG8_LAS bf16x8*)(lds + PG8_SB(b, h) + boff + n * 2048 + k * 1024); } while (0)
#define PG8_MMA(ai, bj, At, Bt) do { __builtin_amdgcn_s_setprio(1); _Pragma("unroll") for (int m = 0; m < 4; ++m) _Pragma("unroll") for (int n = 0; n < 2; ++n) _Pragma("unroll") for (int k = 0; k < 2; ++k) \
        acc[ai][bj][m][n] = __builtin_amdgcn_mfma_f32_16x16x32_bf16(Bt[n][k], At[m][k], acc[ai][bj][m][n], 0, 0, 0); __builtin_amdgcn_s_setprio(0); } while (0)
#define PG8_WAIT_V(n) asm volatile("s_waitcnt vmcnt(" #n ")" ::: "memory")
#define PG8_WAIT_L(n) asm volatile("s_waitcnt lgkmcnt(" #n ")" ::: "memory")
#define PG8_BAR __builtin_amdgcn_s_barrier()
#define PG8_SCHED __builtin_amdgcn_sched_barrier(0)
    Unit cur, nxt; int ui = 0;
    if (!S.next(0, cur)) return;
    f32x4 acc[2][2][4][2];
#pragma unroll
    for (int a = 0; a < 2; ++a)
#pragma unroll
        for (int b = 0; b < 2; ++b)
#pragma unroll
            for (int m = 0; m < 4; ++m)
#pragma unroll
                for (int n = 0; n < 2; ++n) acc[a][b][m][n] = (f32x4){0.f, 0.f, 0.f, 0.f};
    bf16x8 At[4][2], B0[2][2], B1[2][2];
    const char* cA = (const char*)g.A + (size_t)cur.pm * tstep; const char* cB = (const char*)g.Bt + (size_t)cur.pn * tstep;
    S.a_ready(cur);
    PG8_STAGE(PG8_SB(0, 0), cB, voffB); PG8_STAGE(PG8_SA(0, 0), cA, voffA); PG8_STAGE(PG8_SB(0, 1), cB + hstep, voffB); PG8_STAGE(PG8_SA(0, 1), cA + hstep, voffA);
    if (wr == 1) PG8_BAR;
    PG8_WAIT_V(4); PG8_BAR;
    PG8_STAGE(PG8_SB(1, 0), cB + kstep, voffB); PG8_STAGE(PG8_SA(1, 0), cA + kstep, voffA); PG8_STAGE(PG8_SB(1, 1), cB + hstep + kstep, voffB);
    PG8_WAIT_V(6); PG8_BAR;
    PG8_STAMP();
    for (;;) {
        const bool has_next = S.next(ui + 1, nxt);
        const char* nA = has_next ? (const char*)g.A + (size_t)nxt.pm * tstep : cA; const char* nB = has_next ? (const char*)g.Bt + (size_t)nxt.pn * tstep : cB;
        for (int t = 0; t < nt; t += 2) {
            const bool last = (t == nt - 2);
            const char* a1 = cA + (size_t)(t + 1) * kstep;
            const char* a2 = last ? nA : cA + (size_t)(t + 2) * kstep; const char* b2 = last ? nB : cB + (size_t)(t + 2) * kstep;
            const char* a3 = a2 + kstep; const char* b3 = b2 + kstep;
            if (last && has_next) S.a_ready(nxt);
            PG8_LDB(B0, 0, 0); PG8_SCHED; PG8_LDA(At, 0, 0); PG8_STAGE(PG8_SA(1, 1), a1 + hstep, voffA);
            PG8_WAIT_L(8); PG8_BAR; PG8_WAIT_L(0); PG8_MMA(0, 0, At, B0); PG8_BAR; PG8_SCHED;
            PG8_LDB(B1, 0, 1); PG8_STAGE(PG8_SB(0, 0), b2, voffB);
            PG8_BAR; PG8_WAIT_L(0); PG8_MMA(0, 1, At, B1); PG8_BAR;
            PG8_LDA(At, 0, 1); PG8_STAGE(PG8_SA(0, 0), a2, voffA);
            PG8_BAR; PG8_WAIT_L(0); PG8_MMA(1, 0, At, B0); PG8_BAR; PG8_SCHED;
            PG8_STAGE(PG8_SB(0, 1), b2 + hstep, voffB);
            PG8_WAIT_V(6); PG8_BAR; PG8_MMA(1, 1, At, B1); PG8_BAR;
            PG8_LDB(B0, 1, 0); PG8_SCHED; PG8_LDA(At, 1, 0); PG8_STAGE(PG8_SA(0, 1), a2 + hstep, voffA);
            PG8_WAIT_L(8); PG8_BAR; PG8_WAIT_L(0); PG8_MMA(0, 0, At, B0); PG8_BAR; PG8_SCHED;
            PG8_LDB(B1, 1, 1); PG8_STAGE(PG8_SB(1, 0), b3, voffB);
            PG8_BAR; PG8_WAIT_L(0); PG8_MMA(0, 1, At, B1); PG8_BAR;
            PG8_LDA(At, 1, 1); PG8_STAGE(PG8_SA(1, 0), a3, voffA);
            PG8_BAR; PG8_WAIT_L(0); PG8_MMA(1, 0, At, B0); PG8_BAR; PG8_SCHED;
            PG8_STAGE(PG8_SB(1, 1), b3 + hstep, voffB);
            PG8_WAIT_V(6); PG8_BAR; PG8_MMA(1, 1, At, B1); PG8_BAR;
        }
        PG8_STAMP();
        if constexpr (!Epi::AFTER_DRAIN) { E(acc, cur, wr, wc, fr, fq); S.done(cur); }
        PG8_STAMP();
        if (!has_next) break;
#pragma unroll
        for (int a = 0; a < 2; ++a)
#pragma unroll
            for (int b = 0; b < 2; ++b)
#pragma unroll
                for (int m = 0; m < 4; ++m)
#pragma unroll
                    for (int n = 0; n < 2; ++n) acc[a][b][m][n] = (f32x4){0.f, 0.f, 0.f, 0.f};
        cur = nxt; cA = nA; cB = nB; ++ui;
    }
    PG8_WAIT_V(0);
    if (wr == 0) PG8_BAR;
    PG8_BAR;
    if constexpr (Epi::AFTER_DRAIN) { E.fused(acc, cur, wr, wc, fr, fq, lds, wid, lane); S.done(cur); }
    PG8_STAMP();
#undef PG8_STAMP
#undef PG8_SA
#undef PG8_SB
#undef PG8_STAGE
#undef PG8_LDA
#undef PG8_LDB
#undef PG8_MMA
#undef PG8_WAIT_V
#undef PG8_WAIT_L
#undef PG8_BAR
#undef PG8_SCHED
}
}
#define XCD_TILE_LOOP(t, ntiles)                                                                      \
  for (int t0_ = 0; t0_ < (ntiles); t0_ += GSZ)                                                        \
    if (const int t = t0_ + ((BID >> 1) & 7) * (GSZ >> 3) + (((BID >> 4) << 1) | (BID & 1)); t < (ntiles))
__device__ __forceinline__ void conv_weight(const float* src, int K, int ld, int N, bf16_t* dst, int mode, float* sm) {
  const int ntn = N >> 7, ntk = K >> 6;
  const int tid = TID;
  for (int t = BID; t < ntn * ntk; t += GSZ) {
    const int tn = t % ntn, tk = t / ntn;
    const int n0 = tn * 128, k0 = tk * 64;
    __syncthreads();
    {
      const int j = tid & 127, i = tid >> 7;
      const int n = n0 + j;
      int col = n;
      if (mode == 2) {
        const int P = n >> 8, c = n & 255;
        col = (c < 128) ? (128 * P + c) : (DFF + 128 * P + c - 128);
      } else if (mode == 3) {
        if (n < 2048) {
          const int P = n >> 8, c = n & 255, sx = c >> 7, c1 = c & 127;
          col = P * 256 + (c1 >> 6) * 128 + ((c1 >> 5) & 1) * 64 + (c1 & 31) + 32 * sx;
        }
      }
      float v[32];
#pragma unroll
      for (int r = 0; r < 32; ++r) v[r] = src[(long)(k0 + i + 2 * r) * ld + col];
#pragma unroll
      for (int r = 0; r < 32; ++r) sm[(i + 2 * r) * 129 + j] = v[r];
    }
    __syncthreads();
    {
      const int q = tid & 7, jj = tid >> 3;
#pragma unroll
      for (int r = 0; r < 4; ++r) {
        const int nn = jj + 32 * r;
        float v[8];
#pragma unroll
        for (int e = 0; e < 8; ++e) v[e] = sm[(q * 8 + e) * 129 + nn];
        u32x4 o;
        o.x = pk2(v[0], v[1]);
        o.y = pk2(v[2], v[3]);
        o.z = pk2(v[4], v[5]);
        o.w = pk2(v[6], v[7]);
        *(u32x4*)(dst + (long)(n0 + nn) * K + k0 + q * 8) = o;
      }
    }
  }
}

__device__ __forceinline__ void ph_mods_partial(const Params& p, float* sm) {
  float* part = (float*)(p.ws + OFF_MODSPART);
  for (int it = BID; it < 576; it += GSZ) {
    const int ks = it / 18, cch = it % 18;
    __syncthreads();
    if (TID < 128) {
      const int k = ks * 64 + (TID & 63);
      const float v = (TID < 64) ? p.c[k] : p.c_ctx[k];
      sm[TID] = v / (1.f + expf(-v));
    }
    __syncthreads();
    const int n = cch * 1024 + TID * 4;
    f32x4 a0 = (f32x4){0.f, 0.f, 0.f, 0.f}, a1 = a0;
    const float* wp = p.w_ada + (long)(ks * 64) * NMOD + n;
#pragma unroll 8
    for (int k = 0; k < 64; ++k) {
      const f32x4 w = *(const f32x4*)(wp + (long)k * NMOD);
      a0 += w * sm[k];
      a1 += w * sm[64 + k];
    }
    if (ks == 0) {
      const f32x4 bb = *(const f32x4*)(p.b_ada + n);
      a0 += bb;
      a1 += bb;
    }
    float* mods = (float*)(p.ws + OFF_MODS);
#pragma unroll
    for (int r = 0; r < 4; ++r) {
      atomicAdd(mods + n + r, a0[r]);
      atomicAdd(mods + NMOD + n + r, a1[r]);
    }
  }
}
__device__ __forceinline__ void ph_mods_reduce(const Params& p) {
  const float* part = (const float*)(p.ws + OFF_MODSPART);
  float* mods = (float*)(p.ws + OFF_MODS);
  for (int i = BID * 256 + TID; i < 2 * NMOD; i += GSZ * 256) {
    const int v = i / NMOD, n = i % NMOD;
    float s = p.b_ada[n];
    for (int ks = 0; ks < 32; ++ks) s += part[(long)(ks * 2 + v) * NMOD + n];
    mods[i] = s;
  }
}
__device__ __forceinline__ void ph_misc0(const Params& p) {
  float* sumsq = (float*)(p.ws + OFF_SUMSQ);
  float2* rope = (float2*)(p.ws + OFF_ROPE);
  bf16_t* h3 = (bf16_t*)(p.ws + OFF_H3B);
  const int gt = BID * 256 + TID, gs = GSZ * 256;
  for (int i = gt; i < 2048; i += gs) sumsq[i] = 0.f;
  for (int i = gt; i < 256 * 32; i += gs) {
    const int pos = i >> 5, k = i & 31;
    const float inv = exp2f(-(float)k * (13.287712379549449f / 32.f));
    const float ang = (float)pos * inv;
    rope[i] = make_float2(cosf(ang), sinf(ang));
  }
  const int lane = TID & 63;
  const int gw = BID * 4 + (TID >> 6), nw = GSZ * 4;
  const float fq = p.freq[lane];
  for (int j = gw; j < 16384; j += nw) {
    const float wj = (6.2831855f * (float)j) / 16384.f;
    float feat = 0.f;
    if (lane == 0)
      feat = (float)j / 16383.f;
    else if (lane <= 16) {
      const float f = 1e-4f + (float)(lane - 1) * ((15.f - 1e-4f) / 15.f);
      feat = cosf(f * wj);
    } else if (lane <= 32) {
      const float f = 1e-4f + (float)(lane - 17) * ((15.f - 1e-4f) / 15.f);
      feat = -sinf(f * wj);
    }
    float a = p.b1[lane];
    for (int e = 0; e < 33; ++e) a += __shfl(feat, e) * p.w1[e * 64 + lane];
    float h = sinf(fq * a);
    a = p.b2[lane];
    for (int k = 0; k < 64; ++k) a += __shfl(h, k) * p.w2[k * 64 + lane];
    h = sinf(fq * a);
    a = p.b3[lane];
    for (int k = 0; k < 64; ++k) a += __shfl(h, k) * p.w3[k * 64 + lane];
    h = sinf(fq * a);
    h3[j * 64 + lane] = f2bf(h);
  }
}
__device__ __forceinline__ void ph_prenorm(const Params& p, const float* xl, const float* xc, int rows, const float* g, int slot) {
  const float* mods = (const float*)(p.ws + OFF_MODS);
  bf16_t* A = (bf16_t*)(p.ws + OFF_AR);
  const int lane = TID & 63;
  const int gw = BID * 4 + (TID >> 6), nw = GSZ * 4;
  for (int r = gw; r < rows; r += nw) {
    const float* src = (r < T) ? xl + (long)r * D : xc + (long)(r - T) * D;
    const float* md = mods + ((r < T) ? 0 : NMOD);
    f32x4 v[8];
    float ss = 0.f;
#pragma unroll
    for (int i = 0; i < 8; ++i) {
      v[i] = *(const f32x4*)(src + i * 256 + lane * 4);
      ss += v[i][0] * v[i][0] + v[i][1] * v[i][1] + v[i][2] * v[i][2] + v[i][3] * v[i][3];
    }
    ss = wave_sum(ss);
    const float rstd = rsqrtf(ss * (1.f / 2048.f) + 1e-6f);
#pragma unroll
    for (int i = 0; i < 8; ++i) {
      const int c = i * 256 + lane * 4;
      const f32x4 gg = *(const f32x4*)(g + c);
      const f32x4 sh = *(const f32x4*)(md + (3 * slot) * D + c);
      const f32x4 sc = *(const f32x4*)(md + (3 * slot + 1) * D + c);
      const f32x4 y = v[i] * rstd * gg;
      const f32x4 o = y * (1.f + sc) + sh;
      *(u32x2*)(A + (long)r * D + c) = pk4(o);
    }
  }
}
__device__ __forceinline__ void ph_final_norm(const Params& p) {
  const int lane = TID & 63;
  const int gw = BID * 4 + (TID >> 6), nw = GSZ * 4;
  for (int r = gw; r < T; r += nw) {
    float* src = p.out + (long)r * D;
    f32x4 v[8];
    float ss = 0.f;
#pragma unroll
    for (int i = 0; i < 8; ++i) {
      v[i] = *(const f32x4*)(src + i * 256 + lane * 4);
      ss += v[i][0] * v[i][0] + v[i][1] * v[i][1] + v[i][2] * v[i][2] + v[i][3] * v[i][3];
    }
    ss = wave_sum(ss);
    const float rstd = rsqrtf(ss * (1.f / 2048.f) + 1e-6f);
#pragma unroll
    for (int i = 0; i < 8; ++i) {
      const int c = i * 256 + lane * 4;
      const f32x4 gg = *(const f32x4*)(p.fin_g + c);
      *(f32x4*)(src + c) = v[i] * rstd * gg;
    }
  }
}

#define GEMM_IDS                                                                       \
  const int lane = TID & 63, wv = TID >> 6, wm = wv >> 1, wn = wv & 1; \
  const int l15 = lane & 15, l4 = lane >> 4;                                           \
  (void)l15; (void)l4; (void)wm; (void)wn;

__device__ __forceinline__ void ph_gemm_up(const Params& p, int rows, bf16_t* lds) {
  GEMM_IDS
  const bf16_t* A = (const bf16_t*)(p.ws + OFF_AR);
  const bf16_t* Bt = (const bf16_t*)(p.ws + OFF_WBIG);
  bf16_t* H = (bf16_t*)(p.ws + OFF_H);
  const int ntm = rows >> 7, ntn = 88;
  bool primed = false;
  XCD_TILE_LOOP(t, ntm * ntn) {
    int tm, tn;
    tile_map(t, ntm, ntn, tm, tn);
    f32x4 acc[4][4];
    acc_zero(acc);
    const bf16_t *nA = nullptr, *nB = nullptr;
    if (t + (int)GSZ < ntm * ntn) { int tm2, tn2; tile_map(t + GSZ, ntm, ntn, tm2, tn2); nA = A + (long)tm2 * 128 * D; nB = Bt + (long)tn2 * 128 * D; }
    gemm_acc<true>(acc, A + (long)tm * 128 * D, D, Bt + (long)tn * 128 * D, D, D, lds, nA, nB, primed);
    primed = nA != nullptr;
#pragma unroll
    for (int mi = 0; mi < 4; ++mi) {
      const int m = tm * 128 + 64 * wm + 16 * mi + l15;
#pragma unroll
      for (int ni = 0; ni < 2; ++ni) {
        const int hc = (tn * 2 + wn) * 32 + 16 * ni + 4 * l4;
        f32x4 o;
#pragma unroll
        for (int r = 0; r < 4; ++r) o[r] = silu_f(acc[mi][ni][r]) * acc[mi][ni + 2][r];
        *(u32x2*)(H + (long)m * DFF + hc) = pk4(o);
      }
    }
  }
}
__device__ __forceinline__ void ph_gemm_down(const Params& p, int rows, int slot, const float* resl, const float* resc, float* outl, float* outc,
                             bf16_t* lds) {
  GEMM_IDS
  const bf16_t* A = (const bf16_t*)(p.ws + OFF_H);
  const bf16_t* Bt = (const bf16_t*)(p.ws + OFF_WDOWN);
  const float* mods = (const float*)(p.ws + OFF_MODS);
  const int ntm = rows >> 7, ntn = 16;
  bool primed = false;
  XCD_TILE_LOOP(t, ntm * ntn) {
    int tm, tn;
    tile_map(t, ntm, ntn, tm, tn);
    f32x4 acc[4][4];
    acc_zero(acc);
    const bf16_t *nA = nullptr, *nB = nullptr;
    if (t + (int)GSZ < ntm * ntn) { int tm2, tn2; tile_map(t + GSZ, ntm, ntn, tm2, tn2); nA = A + (long)tm2 * 128 * DFF; nB = Bt + (long)tn2 * 128 * DFF; }
    gemm_acc<true>(acc, A + (long)tm * 128 * DFF, DFF, Bt + (long)tn * 128 * DFF, DFF, DFF, lds, nA, nB, primed);
    primed = nA != nullptr;
    const bool lat = tm < 128;
    const float* gate = mods + (lat ? 0 : NMOD) + (3 * slot + 2) * D;
#pragma unroll
    for (int mi = 0; mi < 4; ++mi) {
      const int m = tm * 128 + 64 * wm + 16 * mi + l15;
      const float* rp = lat ? resl + (long)m * D : resc + (long)(m - T) * D;
      float* op = lat ? outl + (long)m * D : outc + (long)(m - T) * D;
#pragma unroll
      for (int ni = 0; ni < 4; ++ni) {
        const int n = tn * 128 + 64 * wn + 16 * ni + 4 * l4;
        const f32x4 gt = *(const f32x4*)(gate + n);
        const f32x4 rs = *(const f32x4*)(rp + n);
        *(f32x4*)(op + n) = rs + 0.5f * gt * acc[mi][ni];
      }
    }
  }
}
__device__ __forceinline__ void ph_gemm_plain(const bf16_t* A, const bf16_t* Bt, bf16_t* C, int M, int N, int K, bf16_t* lds) {
  GEMM_IDS
  const int ntm = M >> 7, ntn = N >> 7;
  bool primed = false;
  XCD_TILE_LOOP(t, ntm * ntn) {
    int tm, tn;
    tile_map(t, ntm, ntn, tm, tn);
    f32x4 acc[4][4];
    acc_zero(acc);
    const bf16_t *nA = nullptr, *nB = nullptr;
    if (t + (int)GSZ < ntm * ntn) { int tm2, tn2; tile_map(t + GSZ, ntm, ntn, tm2, tn2); nA = A + (long)tm2 * 128 * K; nB = Bt + (long)tn2 * 128 * K; }
    gemm_acc<true>(acc, A + (long)tm * 128 * K, K, Bt + (long)tn * 128 * K, K, K, lds, nA, nB, primed);
    primed = nA != nullptr;
#pragma unroll
    for (int mi = 0; mi < 4; ++mi) {
      const int m = tm * 128 + 64 * wm + 16 * mi + l15;
#pragma unroll
      for (int ni = 0; ni < 4; ++ni) {
        const int n = tn * 128 + 64 * wn + 16 * ni + 4 * l4;
        *(u32x2*)(C + (long)m * N + n) = pk4(acc[mi][ni]);
      }
    }
  }
}
__device__ __forceinline__ void ph_gemm_win_a(const Params& p, bf16_t* lds) {
  GEMM_IDS
  const bf16_t* A = (const bf16_t*)(p.ws + OFF_AR);
  const bf16_t* Bt = (const bf16_t*)(p.ws + OFF_WBIG);
  bf16_t* q = (bf16_t*)(p.ws + OFF_Q);
  bf16_t* kk = (bf16_t*)(p.ws + OFF_K);
  bf16_t* kTf = (bf16_t*)(p.ws + OFF_KTF);
  bf16_t* kTb = (bf16_t*)(p.ws + OFF_KTB);
  bf16_t* vT = (bf16_t*)(p.ws + OFF_VT);
  bf16_t* sg = (bf16_t*)(p.ws + OFF_SG);
  const float2* rope = (const float2*)(p.ws + OFF_ROPE);
  const int n_lat = 128 * 48, n_ctx = 2 * 24;
  XCD_TILE_LOOP(t, n_lat + n_ctx) {
    int tm, tn;
    if (t < n_lat)
      tile_map(t, 128, 48, tm, tn);
    else {
      const int u = t - n_lat;
      tm = 128 + u / 24;
      tn = 8 + u % 24;
    }
    f32x4 acc[4][4];
    acc_zero(acc);
    const bf16_t* Ap = A + (long)tm * 128 * D;
    const bf16_t* Bp = Bt + (long)tn * 128 * D;
    if (tn >= 16 && tn < 32) {
      gemm_acc<false>(acc, Ap, D, Bp, D, D, lds);
#pragma unroll
      for (int mi = 0; mi < 4; ++mi) {
        const int m0 = tm * 128 + 64 * wm + 16 * mi + 4 * l4;
#pragma unroll
        for (int ni = 0; ni < 4; ++ni) {
          const int ch = (tn - 16) * 128 + 64 * wn + 16 * ni + l15;
          *(u32x2*)(vT + (long)ch * TT + m0) = pk4(acc[mi][ni]);
        }
      }
    } else {
      gemm_acc<true>(acc, Ap, D, Bp, D, D, lds);
      if (tn < 8) {
        const float scl = 0.08838834764831845f;
#pragma unroll
        for (int mi = 0; mi < 4; ++mi) {
          const int m = tm * 128 + 64 * wm + 16 * mi + l15;
          const int pos = (wn == 0) ? (m >> 6) : (m & 63);
#pragma unroll
          for (int ni = 0; ni < 2; ++ni) {
            const int i0 = 16 * ni + 4 * l4;
            f32x4 o1, o2;
#pragma unroll
            for (int r = 0; r < 4; ++r) {
              const float2 cs = rope[pos * 32 + i0 + r];
              const float x1 = acc[mi][ni][r] * scl, x2 = acc[mi][ni + 2][r] * scl;
              o1[r] = x1 * cs.x - x2 * cs.y;
              o2[r] = x1 * cs.y + x2 * cs.x;
            }
            bf16_t* dp = q + (long)m * 1024 + tn * 128 + 64 * wn + i0;
            *(u32x2*)(dp) = pk4(o1);
            *(u32x2*)(dp + 32) = pk4(o2);
          }
        }
      } else if (tn < 16) {
        const int head = tn - 8;
        const float lgf = p.lg[head], lgb = p.lg[8 + head];
#pragma unroll
        for (int mi = 0; mi < 4; ++mi) {
          const int m = tm * 128 + 64 * wm + 16 * mi + l15;
          const bool lat = m < T;
          const int pos = (wn == 0) ? ((m >> 6) & 255) : (m & 63);
          const int j = m & 127;
          const float zf = __expf(lgf * (float)(127 - j)), zb = __expf(lgb * (float)j);
#pragma unroll
          for (int ni = 0; ni < 2; ++ni) {
            const int i0 = 16 * ni + 4 * l4;
            f32x4 o1, o2;
#pragma unroll
            for (int r = 0; r < 4; ++r) {
              float2 cs = rope[pos * 32 + i0 + r];
              if (!lat) cs = make_float2(1.f, 0.f);
              const float x1 = acc[mi][ni][r], x2 = acc[mi][ni + 2][r];
              o1[r] = x1 * cs.x - x2 * cs.y;
              o2[r] = x1 * cs.y + x2 * cs.x;
            }
            const int cb = head * 128 + 64 * wn + i0;
            if (lat) {
              bf16_t* dp = kk + (long)m * 1024 + cb;
              *(u32x2*)(dp) = pk4(o1);
              *(u32x2*)(dp + 32) = pk4(o2);
            }
#pragma unroll
            for (int r = 0; r < 4; ++r) {
              kTf[(long)(cb + r) * TT + m] = f2bf(o1[r] * zf);
              kTb[(long)(cb + r) * TT + m] = f2bf(o1[r] * zb);
              kTf[(long)(cb + 32 + r) * TT + m] = f2bf(o2[r] * zf);
              kTb[(long)(cb + 32 + r) * TT + m] = f2bf(o2[r] * zb);
            }
          }
        }
      } else {
#pragma unroll
        for (int mi = 0; mi < 4; ++mi) {
          const int m = tm * 128 + 64 * wm + 16 * mi + l15;
#pragma unroll
          for (int ni = 0; ni < 4; ++ni) {
            const int n = (tn - 32) * 128 + 64 * wn + 16 * ni + 4 * l4;
            f32x4 o;
#pragma unroll
            for (int r = 0; r < 4; ++r) o[r] = silu_f(acc[mi][ni][r]);
            *(u32x2*)(sg + (long)m * D + n) = pk4(o);
          }
        }
      }
    }
  }
}
__device__ __forceinline__ void ph_gemm_win_b(const Params& p, bf16_t* lds) {
  GEMM_IDS
  const bf16_t* A = (const bf16_t*)(p.ws + OFF_AR);
  const bf16_t* Bt = (const bf16_t*)(p.ws + OFF_WBIG);
  bf16_t* phy = (bf16_t*)(p.ws + OFF_PHY);
  bf16_t* gates = (bf16_t*)(p.ws + OFF_GATES);
  bool primed = false;
  XCD_TILE_LOOP(t, 128 * 80) {
    int tm, tn;
    tile_map(t, 128, 80, tm, tn);
    tn += 48;
    f32x4 acc[4][4];
    acc_zero(acc);
    const bf16_t *nA = nullptr, *nB = nullptr;
    if (t + (int)GSZ < 128 * 80) { int tm2, tn2; tile_map(t + GSZ, 128, 80, tm2, tn2); tn2 += 48; nA = A + (long)tm2 * 128 * D; nB = Bt + (long)tn2 * 128 * D; }
    gemm_acc<true>(acc, A + (long)tm * 128 * D, D, Bt + (long)tn * 128 * D, D, D, lds, nA, nB, primed);
    primed = nA != nullptr;
#pragma unroll
    for (int mi = 0; mi < 4; ++mi) {
      const int m = tm * 128 + 64 * wm + 16 * mi + l15;
#pragma unroll
      for (int ni = 0; ni < 4; ++ni) {
        const int nl = 64 * wn + 16 * ni + 4 * l4;
        if (tn < 96) {
          *(u32x2*)(phy + (long)m * 6144 + (tn - 48) * 128 + nl) = pk4(acc[mi][ni]);
        } else {
          f32x4 o;
#pragma unroll
          for (int r = 0; r < 4; ++r) o[r] = sigm_f(acc[mi][ni][r]);
          *(u32x2*)(gates + (long)m * 4096 + (tn - 96) * 128 + nl) = pk4(o);
        }
      }
    }
  }
}
__device__ __forceinline__ void ph_ret_kv_p(const Params& p, bf16_t* lds) {
  GEMM_IDS
  const bf16_t* q = (const bf16_t*)(p.ws + OFF_Q);
  const bf16_t* kk = (const bf16_t*)(p.ws + OFF_K);
  const bf16_t* kTf = (const bf16_t*)(p.ws + OFF_KTF);
  const bf16_t* kTb = (const bf16_t*)(p.ws + OFF_KTB);
  const bf16_t* vT = (const bf16_t*)(p.ws + OFF_VT);
  bf16_t* kvT = (bf16_t*)(p.ws + OFF_KVT);
  bf16_t* P = (bf16_t*)(p.ws + OFF_P);
  const int n1 = 130 * 8 * 2 * 2, n2 = 128 * 8;
  bool primed = false;
  for (int t = BID; t < n1; t += GSZ) {
    f32x4 acc[4][4];
    acc_zero(acc);
    {
      const int half = t & 1, d = (t >> 1) & 1, h = (t >> 2) & 7, ci = t >> 5;
      const bf16_t* Ap = vT + (long)(h * 256 + half * 128) * TT + ci * 128;
      const bf16_t* Bp = (d ? kTb : kTf) + (long)(h * 128) * TT + ci * 128;
      const bf16_t *nAp = nullptr, *nBp = nullptr;
      if (t + GSZ < n1) {
        const int t2 = t + GSZ, half2 = t2 & 1, d2 = (t2 >> 1) & 1, h2 = (t2 >> 2) & 7, ci2 = t2 >> 5;
        nAp = vT + (long)(h2 * 256 + half2 * 128) * TT + ci2 * 128;
        nBp = (d2 ? kTb : kTf) + (long)(h2 * 128) * TT + ci2 * 128;
      }
      gemm_acc<true>(acc, Ap, TT, Bp, TT, 128, lds, nAp, nBp, primed);
      primed = nAp != nullptr;
      bf16_t* o = kvT + ((long)(d * 130 + ci) * 8 + h) * 32768 + (long)(half * 128) * 128;
#pragma unroll
      for (int mi = 0; mi < 4; ++mi) {
        const int m = 64 * wm + 16 * mi + l15;
#pragma unroll
        for (int ni = 0; ni < 4; ++ni) {
          const int n = 64 * wn + 16 * ni + 4 * l4;
          *(u32x2*)(o + m * 128 + n) = pk4(acc[mi][ni]);
        }
      }
    }
  }
  bool primed2 = false;
  for (int u = BID; u < n2; u += GSZ) {
    f32x4 acc[4][4];
    acc_zero(acc);
    {
      const int h = u & 7, ci = u >> 3;
      const bf16_t* Ap = q + (long)ci * 128 * 1024 + h * 128;
      const bf16_t* Bp = kk + (long)ci * 128 * 1024 + h * 128;
      const bf16_t *nAp = nullptr, *nBp = nullptr;
      if (u + GSZ < n2) {
        const int u2 = u + GSZ, h2 = u2 & 7, ci2 = u2 >> 3;
        nAp = q + (long)ci2 * 128 * 1024 + h2 * 128;
        nBp = kk + (long)ci2 * 128 * 1024 + h2 * 128;
      }
      gemm_acc<true>(acc, Ap, 1024, Bp, 1024, 128, lds, nAp, nBp, primed2);
      primed2 = nAp != nullptr;
      const float lgf = p.lg[h], nlgb = -p.lg[8 + h];
      bf16_t* o = P + (long)(ci * 8 + h) * 16384;
#pragma unroll
      for (int mi = 0; mi < 4; ++mi) {
        const int a = 64 * wm + 16 * mi + l15;
#pragma unroll
        for (int ni = 0; ni < 4; ++ni) {
          const int b0 = 64 * wn + 16 * ni + 4 * l4;
          f32x4 ov;
#pragma unroll
          for (int r = 0; r < 4; ++r) {
            const int b = b0 + r;
            const int dd = a - b;
            const float dcy = (dd == 0) ? 2.f : __expf((dd > 0 ? lgf : nlgb) * (float)dd);
            ov[r] = acc[mi][ni][r] * dcy;
          }
          *(u32x2*)(o + a * 128 + b0) = pk4(ov);
        }
      }
    }
  }
}
__device__ __forceinline__ void ph_ret_scan(const Params& p) {
  unsigned* kv = (unsigned*)(p.ws + OFF_KVT);
  for (int it = BID * 256 + TID; it < 262144; it += GSZ * 256) {
    const int d = it >> 17, e2 = it & 131071, h = e2 >> 14, off = e2 & 16383;
    const float dec = expf(p.lg[d * 8 + h] * 128.f);
    unsigned* base = kv + ((long)d * 130 * 8 + h) * 16384 + off;
    float s0 = 0.f, s1 = 0.f;
    for (int sb = 0; sb < 130; sb += 10) {
      unsigned vv[10];
#pragma unroll
      for (int k = 0; k < 10; ++k) {
        const int step = sb + k;
        const int ci = (d == 0) ? ((step < 2) ? (128 + step) : (step - 2)) : (129 - step);
        vv[k] = base[(long)ci * 131072];
      }
#pragma unroll
      for (int k = 0; k < 10; ++k) {
        const int step = sb + k;
        const int ci = (d == 0) ? ((step < 2) ? (128 + step) : (step - 2)) : (129 - step);
        base[(long)ci * 131072] = pk2(s0, s1);
        s0 = s0 * dec + bf2f(vv[k] & 0xffffu);
        s1 = s1 * dec + bf2f(vv[k] >> 16);
      }
    }
  }
}
__device__ __forceinline__ void ph_ret_out(const Params& p, char* lds_all) {
  GEMM_IDS
  const int half = fresh_tid() >> 8;
  bf16_t* lds = (bf16_t*)(lds_all + half * LDS_HALF);
  float2* part = (float2*)(lds_all + 65536);
  const bf16_t* q = (const bf16_t*)(p.ws + OFF_Q);
  const bf16_t* vT = (const bf16_t*)(p.ws + OFF_VT);
  const bf16_t* kvT = (const bf16_t*)(p.ws + OFF_KVT);
  const bf16_t* P = (const bf16_t*)(p.ws + OFF_P);
  const bf16_t* sg = (const bf16_t*)(p.ws + OFF_SG);
  bf16_t* Y = (bf16_t*)(p.ws + OFF_Y);
  bool primed = false;
  for (int it = (int)blockIdx.x; it < 1024; it += (int)gridDim.x) {
    const int h = it & 7, ci = it >> 3;
    const float lgf = p.lg[h], lgb = p.lg[8 + h];
    f32x4 acc[4][4];
    acc_zero(acc);
    const bf16_t* Aq = q + (long)ci * 128 * 1024 + h * 128;
    const bf16_t* Sb = kvT + ((long)(130 + ci) * 8 + h) * 32768 + (long)(half * 128) * 128;
    const bf16_t* Sf = kvT + ((long)(ci)*8 + h) * 32768 + (long)(half * 128) * 128;
    const bf16_t* Ap = P + (long)(ci * 8 + h) * 16384;
    const bf16_t* Vp = vT + (long)(h * 256 + half * 128) * TT + ci * 128;
    const bf16_t *nAq = nullptr, *nSb = nullptr;
    if (it + (int)gridDim.x < 1024) {
      const int it2 = it + (int)gridDim.x, h2 = it2 & 7, ci2 = it2 >> 3;
      nAq = q + (long)ci2 * 128 * 1024 + h2 * 128;
      nSb = kvT + ((long)(130 + ci2) * 8 + h2) * 32768 + (long)(half * 128) * 128;
    }
    gemm_acc<true>(acc, Aq, 1024, Sb, 128, 128, lds, Aq, Sf, primed);
#pragma unroll
    for (int mi = 0; mi < 4; ++mi) {
      const int a = 64 * wm + 16 * mi + l15;
      const float ratio = __expf(lgb * (float)(128 - a) - lgf * (float)(a + 1));
#pragma unroll
      for (int ni = 0; ni < 4; ++ni) acc[mi][ni] *= ratio;
    }
    gemm_acc<true>(acc, Aq, 1024, Sf, 128, 128, lds, Ap, Vp, true, 128, TT);
#pragma unroll
    for (int mi = 0; mi < 4; ++mi) {
      const int a = 64 * wm + 16 * mi + l15;
      const float xf = __expf(lgf * (float)(a + 1));
#pragma unroll
      for (int ni = 0; ni < 4; ++ni) acc[mi][ni] *= xf;
    }
    gemm_acc<true>(acc, Ap, 128, Vp, TT, 128, lds, nAq, nSb, true, 1024, 128);
    primed = nAq != nullptr;
#pragma unroll
    for (int mi = 0; mi < 4; ++mi) {
      float s1 = 0.f, s2 = 0.f;
#pragma unroll
      for (int ni = 0; ni < 4; ++ni)
#pragma unroll
        for (int r = 0; r < 4; ++r) {
          const float v = acc[mi][ni][r];
          s1 += v;
          s2 += v * v;
        }
      s1 += __shfl_xor(s1, 16);
      s2 += __shfl_xor(s2, 16);
      s1 += __shfl_xor(s1, 32);
      s2 += __shfl_xor(s2, 32);
      if (l4 == 0) part[(half * 2 + wn) * 128 + 64 * wm + 16 * mi + l15] = make_float2(s1, s2);
    }
    __syncthreads();
#pragma unroll
    for (int mi = 0; mi < 4; ++mi) {
      const int a = 64 * wm + 16 * mi + l15;
      const float2 p0 = part[a], p1 = part[128 + a], p2 = part[256 + a], p3 = part[384 + a];
      const float mean = ((p0.x + p1.x) + (p2.x + p3.x)) * (1.f / 256.f);
      const float ex2 = ((p0.y + p1.y) + (p2.y + p3.y)) * (1.f / 256.f);
      const float rs = rsqrtf(fmaxf(ex2 - mean * mean, 0.f) + 1e-6f);
      const long t = (long)ci * 128 + a;
#pragma unroll
      for (int ni = 0; ni < 4; ++ni) {
        const int c = h * 256 + half * 128 + 64 * wn + 16 * ni + 4 * l4;
        const u32x2 graw = *(const u32x2*)(sg + t * D + c);
        const f32x4 gg = *(const f32x4*)(p.gn_g + c), gb = *(const f32x4*)(p.gn_b + c);
        f32x4 o;
        o[0] = ((acc[mi][ni][0] - mean) * rs * gg[0] + gb[0]) * bf2f(graw.x & 0xffffu);
        o[1] = ((acc[mi][ni][1] - mean) * rs * gg[1] + gb[1]) * bf2f(graw.x >> 16);
        o[2] = ((acc[mi][ni][2] - mean) * rs * gg[2] + gb[2]) * bf2f(graw.y & 0xffffu);
        o[3] = ((acc[mi][ni][3] - mean) * rs * gg[3] + gb[3]) * bf2f(graw.y >> 16);
        *(u32x2*)(Y + t * D + c) = pk4(o);
      }
    }
  }
}
__device__ __forceinline__ void ph_ret_gn(const Params& p) {
  bf16_t* Y = (bf16_t*)(p.ws + OFF_Y);
  const bf16_t* sg = (const bf16_t*)(p.ws + OFF_SG);
  const int lane = TID & 63;
  const int gw = BID * 4 + (TID >> 6), nw = GSZ * 4;
  for (int t = gw; t < T; t += nw) {
    u32x2 raw[8], graw[8];
#pragma unroll
    for (int h = 0; h < 8; ++h) {
      raw[h] = *(const u32x2*)(Y + (long)t * D + h * 256 + lane * 4);
      graw[h] = *(const u32x2*)(sg + (long)t * D + h * 256 + lane * 4);
    }
#pragma unroll
    for (int h = 0; h < 8; ++h) {
      const int c = h * 256 + lane * 4;
      float v[4] = {bf2f(raw[h].x & 0xffffu), bf2f(raw[h].x >> 16), bf2f(raw[h].y & 0xffffu), bf2f(raw[h].y >> 16)};
      const float mean = wave_sum(v[0] + v[1] + v[2] + v[3]) * (1.f / 256.f);
      float q = 0.f;
#pragma unroll
      for (int r = 0; r < 4; ++r) {
        v[r] -= mean;
        q += v[r] * v[r];
      }
      const float rs = rsqrtf(wave_sum(q) * (1.f / 256.f) + 1e-6f);
      const float gv[4] = {bf2f(graw[h].x & 0xffffu), bf2f(graw[h].x >> 16), bf2f(graw[h].y & 0xffffu), bf2f(graw[h].y >> 16)};
      const f32x4 gg = *(const f32x4*)(p.gn_g + c), gb = *(const f32x4*)(p.gn_b + c);
      f32x4 o;
#pragma unroll
      for (int r = 0; r < 4; ++r) o[r] = (v[r] * rs * gg[r] + gb[r]) * gv[r];
      *(u32x2*)(Y + (long)t * D + c) = pk4(o);
    }
  }
}
__device__ __forceinline__ void hy_conv_row(const u32x4 (&rm)[3], const u32x4 (&r0)[3], const u32x4 (&rp)[3], const float (&wv)[3][3][8],
                                            const float (&bv)[3][8], bf16_t* x0p, bf16_t* zp) {
  float u[3][8];
#pragma unroll
  for (int s3 = 0; s3 < 3; ++s3) {
#pragma unroll
    for (int e = 0; e < 8; ++e) u[s3][e] = bv[s3][e];
#pragma unroll
    for (int dt = 0; dt < 3; ++dt) {
      const u32x4 raw = (dt == 0) ? rm[s3] : ((dt == 1) ? r0[s3] : rp[s3]);
      const unsigned rw[4] = {raw.x, raw.y, raw.z, raw.w};
#pragma unroll
      for (int e = 0; e < 4; ++e) {
        u[s3][2 * e] += bf2f(rw[e] & 0xffffu) * wv[s3][dt][2 * e];
        u[s3][2 * e + 1] += bf2f(rw[e] >> 16) * wv[s3][dt][2 * e + 1];
      }
    }
  }
  u32x4 o0, oz;
  o0.x = pk2(u[0][0], u[0][1]);
  o0.y = pk2(u[0][2], u[0][3]);
  o0.z = pk2(u[0][4], u[0][5]);
  o0.w = pk2(u[0][6], u[0][7]);
  oz.x = pk2(u[1][0] * u[2][0], u[1][1] * u[2][1]);
  oz.y = pk2(u[1][2] * u[2][2], u[1][3] * u[2][3]);
  oz.z = pk2(u[1][4] * u[2][4], u[1][5] * u[2][5]);
  oz.w = pk2(u[1][6] * u[2][6], u[1][7] * u[2][7]);
  *(u32x4*)x0p = o0;
  *(u32x4*)zp = oz;
}
__device__ __forceinline__ void ph_hy_conv(const Params& p) {
  const bf16_t* phy = (const bf16_t*)(p.ws + OFF_PHY);
  bf16_t* x0 = (bf16_t*)(p.ws + OFF_X0);
  bf16_t* z = (bf16_t*)(p.ws + OFF_Z);
  const int c0 = TID * 8;
  float wv[3][3][8], bv[3][8];
#pragma unroll
  for (int s3 = 0; s3 < 3; ++s3) {
#pragma unroll
    for (int e = 0; e < 8; ++e) bv[s3][e] = p.conv_b[s3 * 2048 + c0 + e];
#pragma unroll
    for (int dt = 0; dt < 3; ++dt)
#pragma unroll
      for (int e = 0; e < 8; ++e) wv[s3][dt][e] = p.conv_w[dt * 6144 + s3 * 2048 + c0 + e];
  }
  const int nrows = T / GSZ;
  const int t0 = BID * nrows;
  u32x4 w0[3], w1[3], w2[3], w3[3], n0[3], n1[3];
#define HYC_LD(dst, tt)                                                                                   \
  {                                                                                                       \
    const int tt_ = (tt);                                                                                 \
    _Pragma("unroll") for (int s3 = 0; s3 < 3; ++s3)                                                      \
      dst[s3] = (tt_ >= 0 && tt_ < T) ? *(const u32x4*)(phy + (long)tt_ * 6144 + s3 * 2048 + c0) : (u32x4){0u, 0u, 0u, 0u}; \
  }
  HYC_LD(w0, t0 - 1)
  HYC_LD(w1, t0)
  HYC_LD(w2, t0 + 1)
  HYC_LD(w3, t0 + 2)
  for (int k = 0; k < nrows; k += 2) {
    const int t = t0 + k;
    HYC_LD(n0, t + 3)
    HYC_LD(n1, t + 4)
    hy_conv_row(w0, w1, w2, wv, bv, x0 + (long)t * D + c0, z + (long)t * D + c0);
    hy_conv_row(w1, w2, w3, wv, bv, x0 + (long)(t + 1) * D + c0, z + (long)(t + 1) * D + c0);
#pragma unroll
    for (int s3 = 0; s3 < 3; ++s3) { w0[s3] = w2[s3]; w1[s3] = w3[s3]; w2[s3] = n0[s3]; w3[s3] = n1[s3]; }
  }
#undef HYC_LD
}

typedef float c2f __attribute__((ext_vector_type(2)));
__device__ __forceinline__ c2f mk2(float a, float b) { return (c2f){a, b}; }
__device__ __forceinline__ c2f cmul(c2f a, c2f b) { return a.xx * b + a.yy * (c2f){-b.y, b.x}; }
__device__ __forceinline__ c2f cmulc(c2f a, c2f b) { return a.xx * (c2f){b.x, -b.y} + a.yy * (c2f){b.y, b.x}; }
__device__ __forceinline__ c2f cadd(c2f a, c2f b) { return a + b; }
__device__ __forceinline__ c2f csub(c2f a, c2f b) { return a - b; }
__device__ __forceinline__ constexpr float w16c(int m) {
  m &= 15;
  return m == 0 ? 1.f : m == 1 ? 0.92387953251f : m == 2 ? 0.70710678119f : m == 3 ? 0.38268343237f : m == 4 ? 0.f
       : m == 5 ? -0.38268343237f : m == 6 ? -0.70710678119f : m == 7 ? -0.92387953251f : m == 8 ? -1.f
       : m == 9 ? -0.92387953251f : m == 10 ? -0.70710678119f : m == 11 ? -0.38268343237f : m == 12 ? 0.f
       : m == 13 ? 0.38268343237f : m == 14 ? 0.70710678119f : 0.92387953251f;
}
__device__ __forceinline__ constexpr float w16s(int m) { return w16c(m - 4); }
template <int SGN>
__device__ __forceinline__ void dft4(c2f& a0, c2f& a1, c2f& a2, c2f& a3) {
  const c2f s02 = cadd(a0, a2), d02 = csub(a0, a2), s13 = cadd(a1, a3), d13 = csub(a1, a3);
  const c2f jd = mk2(-(float)SGN * d13.y, (float)SGN * d13.x);
  a0 = cadd(s02, s13);
  a1 = cadd(d02, jd);
  a2 = csub(s02, s13);
  a3 = csub(d02, jd);
}
template <int SGN>
__device__ __forceinline__ void dft16(c2f (&v)[16]) {
#pragma unroll
  for (int b = 0; b < 4; ++b) dft4<SGN>(v[b], v[4 + b], v[8 + b], v[12 + b]);
#pragma unroll
  for (int c = 1; c < 4; ++c)
#pragma unroll
    for (int b = 1; b < 4; ++b) {
      const float wr = w16c(b * c), wi = (float)SGN * w16s(b * c);
      const c2f t = v[4 * c + b];
      v[4 * c + b] = mk2(t.x * wr - t.y * wi, t.x * wi + t.y * wr);
    }
#pragma unroll
  for (int c = 0; c < 4; ++c) dft4<SGN>(v[4 * c], v[4 * c + 1], v[4 * c + 2], v[4 * c + 3]);
}
template <int SGN>
__device__ __forceinline__ void dft8(c2f (&v)[8]) {
  dft4<SGN>(v[0], v[2], v[4], v[6]);
  dft4<SGN>(v[1], v[3], v[5], v[7]);
#pragma unroll
  for (int c = 1; c < 4; ++c) {
    const float wr = w16c(2 * c), wi = (float)SGN * w16s(2 * c);
    const c2f t = v[2 * c + 1];
    v[2 * c + 1] = mk2(t.x * wr - t.y * wi, t.x * wi + t.y * wr);
  }
#pragma unroll
  for (int c = 0; c < 4; ++c) {
    const c2f t = v[2 * c], u = v[2 * c + 1];
    v[2 * c] = cadd(t, u);
    v[2 * c + 1] = csub(t, u);
  }
}
__device__ __forceinline__ void fft_tw_init(c2f* TW) {
  __syncthreads();
  {
    float s, c;
    sincospif((float)TID * (1.f / 128.f), &s, &c);
    TW[TID] = mk2(c, -s);
  }
  __syncthreads();
}
__device__ __forceinline__ c2f big_tw(int f1, int t2) {
  const float rev = (float)(f1 * t2) * (1.f / 32768.f);
  return mk2(__builtin_amdgcn_cosf(rev), -__builtin_amdgcn_sinf(rev));
}
__device__ __forceinline__ void ph_taps(const Params& p, int g, bf16_t* lds) {
  GEMM_IDS
  const bf16_t* A = (const bf16_t*)(p.ws + OFF_H3B);
  const bf16_t* W = (const bf16_t*)(p.ws + OFF_W4T);
  bf16_t* TP = (bf16_t*)(p.ws + (g ? OFF_TAPS1 : OFF_TAPS));
  bool primed = false;
  for (int t = BID; t < 128 * 16; t += GSZ) {
    const int tn = t & 15, tm = t >> 4;
    const int wrow = (tn < 8) ? (g * 1024 + tn * 128) : (2048 + g * 1024 + (tn - 8) * 128);
    f32x4 acc[4][4];
    acc_zero(acc);
    const bf16_t *nA = nullptr, *nB = nullptr;
    if (t + GSZ < 128 * 16) {
      const int t2 = t + GSZ, tn2 = t2 & 15, tm2 = t2 >> 4;
      const int wrow2 = (tn2 < 8) ? (g * 1024 + tn2 * 128) : (2048 + g * 1024 + (tn2 - 8) * 128);
      nA = A + (long)tm2 * 128 * 64;
      nB = W + (long)wrow2 * 64;
    }
    gemm_acc<true>(acc, A + (long)tm * 128 * 64, 64, W + (long)wrow * 64, 64, 64, lds, nA, nB, primed);
    primed = nA != nullptr;
#pragma unroll
    for (int mi = 0; mi < 4; ++mi) {
      const int m = tm * 128 + 64 * wm + 16 * mi + l15;
#pragma unroll
      for (int ni = 0; ni < 4; ++ni) {
        const int n = tn * 128 + 64 * wn + 16 * ni + 4 * l4;
        *(u32x2*)(TP + (long)m * 2048 + n) = pk4(acc[mi][ni]);
      }
    }
  }
}
constexpr float KSCALE = 2.0f;
__device__ __forceinline__ void ph_fft_a(const Params& p, int g, char* ldsc) {
  c2f* X = (c2f*)ldsc;
  c2f* TW = (c2f*)(ldsc + 65536);
  const bf16_t* z = (const bf16_t*)(p.ws + OFF_Z);
  const bf16_t* TP = (const bf16_t*)(p.ws + (g ? OFF_TAPS1 : OFF_TAPS));
  float* sumsq = (float*)(p.ws + OFF_SUMSQ);
  unsigned* S = (unsigned*)(p.ws + OFF_S);
  const int ch = TID & 31, rg = TID >> 5;
  fft_tw_init(TW);
  for (int it = BID; it < 4096; it += GSZ) {
    const int t2 = it & 127, cc = it >> 7;
    const int c = g * 1024 + cc * 32 + ch;
    __syncthreads();
    {
      const float dec = fabsf(p.decay[c]);
      float ssq = 0.f;
      unsigned short rz[16], rt[32];
#pragma unroll
      for (int i = 0; i < 16; ++i) rz[i] = z[(long)(128 * (rg + 8 * i) + t2) * D + c];
#pragma unroll
      for (int i = 0; i < 32; ++i) {
        const int half = i >> 4, t1 = half * 128 + rg + 8 * (i & 15), j = 128 * t1 + t2;
        int jj = half ? (32768 - j) : j;
        if (jj >= 16384) jj = 0;
        rt[i] = TP[(long)jj * 2048 + half * 1024 + cc * 32 + ch];
      }
#pragma unroll
      for (int i = 0; i < 32; ++i) {
        const int half = i >> 4, t1 = half * 128 + rg + 8 * (i & 15), j = 128 * t1 + t2;
        int jj = half ? (32768 - j) : j;
        const bool zero = (jj >= 16384);
        if (zero) jj = 0;
        float val = bf2f(rt[i]) * __expf(-((float)jj * (1.f / 16383.f)) * dec);
        if (zero) val = 0.f;
        ssq += val * val;
        const float zr = (i < 16) ? bf2f(rz[i & 15]) : 0.f;
        X[t1 * 32 + ch] = mk2(zr, val * KSCALE);
      }
      ((float*)(ldsc + 65536 + 2048))[TID] = ssq;
    }
    __syncthreads();
    if (TID < 32) {
      const float* red = (const float*)(ldsc + 65536 + 2048);
      float tot = 0.f;
#pragma unroll
      for (int r8 = 0; r8 < 8; ++r8) tot += red[r8 * 32 + TID];
      atomicAdd(&sumsq[c], tot);
    }
#pragma unroll 1
    for (int u = 0; u < 2; ++u) {
      const int j = rg + 8 * u;
      c2f v[16];
#pragma unroll
      for (int k = 0; k < 16; ++k) v[k] = X[(16 * k + j) * 32 + ch];
      dft16<-1>(v);
#pragma unroll
      for (int i = 0; i < 16; ++i) {
        const int q = (i >> 2) + 4 * (i & 3);
        X[(16 * q + j) * 32 + ch] = cmul(v[i], TW[(j * q) & 255]);
      }
    }
    __syncthreads();
#pragma unroll 1
    for (int u = 0; u < 2; ++u) {
      const int q = rg + 8 * u;
      c2f v[16];
#pragma unroll
      for (int j = 0; j < 16; ++j) v[j] = X[(16 * q + j) * 32 + ch];
      dft16<-1>(v);
      c2f twv[16];
      {
        const c2f st = big_tw(16, t2);
        twv[0] = big_tw(q, t2);
#pragma unroll
        for (int pp = 1; pp < 16; ++pp) twv[pp] = cmul(twv[pp - 1], st);
      }
#pragma unroll
      for (int i = 0; i < 16; ++i) {
        const int pp = (i >> 2) + 4 * (i & 3);
        const int r = 16 * q + pp;
        const c2f o = cmul(v[i], twv[pp]);
        S[((long)cc * 32768 + r * 128 + t2) * 32 + ch] = pk2(o.x, o.y);
      }
    }
  }
}
__device__ __forceinline__ void ph_fft_mid(const Params& p, char* lds_all) {
  const int hv = fresh_tid() >> 8;
  char* my = lds_all + hv * LDS_HALF;
  c2f* XS = (c2f*)my;
  c2f* TW = (c2f*)(my + 65536);
  unsigned* S = (unsigned*)(p.ws + OFF_S);
  const int ch = TID & 31, rg = TID >> 5;
  fft_tw_init(TW);
  unsigned rs[16];
  {
    const int pi0 = (int)blockIdx.x;
    const int P0 = pi0 & 127, cc0 = pi0 >> 7;
    const int f10 = (P0 == 0) ? (hv ? 128 : 0) : (hv ? 256 - P0 : P0);
    const int r0 = 16 * (f10 & 15) + (f10 >> 4);
    const long gb0 = ((long)cc0 * 32768 + r0 * 128) * 32 + ch;
#pragma unroll
    for (int k = 0; k < 16; ++k) rs[k] = S[gb0 + (8 * k + rg) * 32];
  }
  for (int pi = (int)blockIdx.x; pi < 4096; pi += (int)gridDim.x) {
    const int P = pi & 127, cc = pi >> 7;
    const int f1 = (P == 0) ? (hv ? 128 : 0) : (hv ? 256 - P : P);
    const int r = 16 * (f1 & 15) + (f1 >> 4);
    const long gbase = ((long)cc * 32768 + r * 128) * 32 + ch;
    const c2f* XP = (P == 0) ? (const c2f*)XS : (const c2f*)(lds_all + (hv ^ 1) * LDS_HALF);
    __syncthreads();
    {
      const int j = rg;
      c2f v[16];
#pragma unroll
      for (int k = 0; k < 16; ++k) { const unsigned w_ = rs[k]; v[k] = mk2(bf2f(w_ & 0xffffu), bf2f(w_ >> 16)); }
      dft16<-1>(v);
#pragma unroll
      for (int i = 0; i < 16; ++i) {
        const int q = (i >> 2) + 4 * (i & 3);
        XS[(8 * q + j) * 32 + ch] = cmul(v[i], TW[(2 * j * q) & 255]);
      }
    }
    {
      const int pin = pi + (int)gridDim.x;
      if (pin < 4096) {
        const int Pn = pin & 127, ccn = pin >> 7;
        const int f1n = (Pn == 0) ? (hv ? 128 : 0) : (hv ? 256 - Pn : Pn);
        const int rn = 16 * (f1n & 15) + (f1n >> 4);
        const long gbn = ((long)ccn * 32768 + rn * 128) * 32 + ch;
#pragma unroll
        for (int k = 0; k < 16; ++k) rs[k] = S[gbn + (8 * k + rg) * 32];
      }
    }
    __syncthreads();
    c2f a[2][8];
#pragma unroll
    for (int u = 0; u < 2; ++u) {
      const int q = rg + 8 * u;
#pragma unroll
      for (int j = 0; j < 8; ++j) a[u][j] = XS[(8 * q + j) * 32 + ch];
      dft8<-1>(a[u]);
#pragma unroll
      for (int pp = 0; pp < 8; ++pp) XS[(8 * q + pp) * 32 + ch] = a[u][2 * (pp & 3) + (pp >> 2)];
    }
    __syncthreads();
    c2f m[2][8];
#pragma unroll
    for (int u = 0; u < 2; ++u) {
      const int q = rg + 8 * u;
      const int sbase = (f1 != 0) ? (127 - 8 * q) : ((q > 0) ? (135 - 8 * q) : 8);
      const c2f* xpb = XP + sbase * 32 + ch;
      const c2f bw0 = (f1 == 0 && q == 0) ? XP[ch] : xpb[0];
#pragma unroll
      for (int pp = 0; pp < 8; ++pp) {
        const c2f bw = (pp == 0) ? bw0 : xpb[-32 * pp];
        const c2f aw = a[u][2 * (pp & 3) + (pp >> 2)];
        const float dr = (aw.x * aw.x - aw.y * aw.y) - (bw.x * bw.x - bw.y * bw.y);
        const float di = 2.f * aw.x * aw.y + 2.f * bw.x * bw.y;
        m[u][pp] = mk2(0.25f * di, -0.25f * dr);
      }
      dft8<1>(m[u]);
    }
    __syncthreads();
#pragma unroll
    for (int u = 0; u < 2; ++u) {
      const int q = rg + 8 * u;
#pragma unroll
      for (int i = 0; i < 8; ++i) {
        const int j = (i >> 1) + 4 * (i & 1);
        XS[(8 * q + j) * 32 + ch] = cmulc(m[u][i], TW[(2 * q * j) & 255]);
      }
    }
    __syncthreads();
    {
      const int j = rg;
      c2f v[16];
#pragma unroll
      for (int q = 0; q < 16; ++q) v[q] = XS[(8 * q + j) * 32 + ch];
      dft16<1>(v);
      c2f twv[16];
      {
        const c2f st = big_tw(f1, 8);
        twv[0] = big_tw(f1, j);
#pragma unroll
        for (int k = 1; k < 16; ++k) twv[k] = cmul(twv[k - 1], st);
      }
#pragma unroll
      for (int i = 0; i < 16; ++i) {
        const int k = (i >> 2) + 4 * (i & 3);
        const int t2 = 8 * k + j;
        const c2f o = cmulc(v[i], twv[k]);
        S[gbase + t2 * 32] = pk2(o.x, o.y);
      }
    }
  }
}
__device__ __forceinline__ void ph_fft_c(const Params& p, int g, char* ldsc) {
  c2f* X = (c2f*)ldsc;
  c2f* TW = (c2f*)(ldsc + 65536);
  const unsigned* S = (const unsigned*)(p.ws + OFF_S);
  const bf16_t* z = (const bf16_t*)(p.ws + OFF_Z);
  bf16_t* x0 = (bf16_t*)(p.ws + OFF_X0);
  const float* sumsq = (const float*)(p.ws + OFF_SUMSQ);
  const int ch = TID & 31, rg = TID >> 5;
  fft_tw_init(TW);
  unsigned raw[2][16];
  {
    const int it0 = BID;
    const int t20 = it0 & 127, cc0 = it0 >> 7;
#pragma unroll
    for (int u = 0; u < 2; ++u)
#pragma unroll
      for (int pp = 0; pp < 16; ++pp) raw[u][pp] = S[((long)cc0 * 32768 + (16 * (rg + 8 * u) + pp) * 128 + t20) * 32 + ch];
  }
  for (int it = BID; it < 4096; it += GSZ) {
    const int t2 = it & 127, cc = it >> 7;
    const int c = g * 1024 + cc * 32 + ch;
    __syncthreads();
    unsigned short zz[2][8], xx[2][8];
#pragma unroll
    for (int u = 0; u < 2; ++u)
#pragma unroll
      for (int k = 0; k < 8; ++k) {
        const long gi = (long)(128 * (16 * k + rg + 8 * u) + t2) * D + c;
        zz[u][k] = z[gi];
        xx[u][k] = x0[gi];
      }
#pragma unroll
    for (int u = 0; u < 2; ++u) {
      const int q = rg + 8 * u;
      c2f v[16];
#pragma unroll
      for (int pp = 0; pp < 16; ++pp) { const unsigned w_ = raw[u][pp]; v[pp] = mk2(bf2f(w_ & 0xffffu), bf2f(w_ >> 16)); }
      dft16<1>(v);
#pragma unroll
      for (int i = 0; i < 16; ++i) {
        const int j = (i >> 2) + 4 * (i & 3);
        X[(16 * q + j) * 32 + ch] = cmulc(v[i], TW[(q * j) & 255]);
      }
    }
    {
      const int itn = it + GSZ;
      if (itn < 4096) {
        const int t2n = itn & 127, ccn = itn >> 7;
#pragma unroll
        for (int u = 0; u < 2; ++u)
#pragma unroll
          for (int pp = 0; pp < 16; ++pp) raw[u][pp] = S[((long)ccn * 32768 + (16 * (rg + 8 * u) + pp) * 128 + t2n) * 32 + ch];
      }
    }
    __syncthreads();
    const float nrm = rsqrtf(sumsq[c] + 1e-6f) * (1.f / (32768.f * KSCALE));
    const float sk = p.skip[c];
#pragma unroll
    for (int u = 0; u < 2; ++u) {
      const int j = rg + 8 * u;
      c2f v[16];
#pragma unroll
      for (int q = 0; q < 16; ++q) v[q] = X[(16 * q + j) * 32 + ch];
      dft16<1>(v);
#pragma unroll
      for (int i = 0; i < 16; ++i) {
        const int k = (i >> 2) + 4 * (i & 3);
        if (k < 8) {
          const int t1 = 16 * k + j;
          const long gi = (long)(128 * t1 + t2) * D + c;
          const float y = v[i].x * nrm + sk * bf2f(zz[u][k]);
          x0[gi] = f2bf(bf2f(xx[u][k]) * y);
        }
      }
    }
  }
}
__device__ __forceinline__ void ph_gemm_hyo(const Params& p, bf16_t* lds) {
  GEMM_IDS
  const bf16_t* A = (const bf16_t*)(p.ws + OFF_X0);
  const bf16_t* Bt = (const bf16_t*)(p.ws + OFF_WHO);
  bf16_t* ro = (bf16_t*)(p.ws + OFF_RETOUT);
  const bf16_t* gates = (const bf16_t*)(p.ws + OFF_GATES);
  bool primed = false;
  XCD_TILE_LOOP(t, 128 * 16) {
    int tm, tn;
    tile_map(t, 128, 16, tm, tn);
    f32x4 acc[4][4];
    acc_zero(acc);
#if !SKIP_HY
    const bf16_t *nA = nullptr, *nB = nullptr;
    if (t + (int)GSZ < 128 * 16) { int tm2, tn2; tile_map(t + GSZ, 128, 16, tm2, tn2); nA = A + (long)tm2 * 128 * D; nB = Bt + (long)tn2 * 128 * D; }
    gemm_acc<true>(acc, A + (long)tm * 128 * D, D, Bt + (long)tn * 128 * D, D, D, lds, nA, nB, primed);
    primed = nA != nullptr;
#endif
#pragma unroll
    for (int mi = 0; mi < 4; ++mi) {
      const int m = tm * 128 + 64 * wm + 16 * mi + l15;
#pragma unroll
      for (int ni = 0; ni < 4; ++ni) {
        const int n = tn * 128 + 64 * wn + 16 * ni + 4 * l4;
        const u32x2 r0 = *(const u32x2*)(ro + (long)m * D + n);
        const u32x2 g0 = *(const u32x2*)(gates + (long)m * 4096 + n);
        const u32x2 g1 = *(const u32x2*)(gates + (long)m * 4096 + 2048 + n);
        f32x4 o;
        o[0] = bf2f(g0.x & 0xffffu) * bf2f(r0.x & 0xffffu) + bf2f(g1.x & 0xffffu) * acc[mi][ni][0];
        o[1] = bf2f(g0.x >> 16) * bf2f(r0.x >> 16) + bf2f(g1.x >> 16) * acc[mi][ni][1];
        o[2] = bf2f(g0.y & 0xffffu) * bf2f(r0.y & 0xffffu) + bf2f(g1.y & 0xffffu) * acc[mi][ni][2];
        o[3] = bf2f(g0.y >> 16) * bf2f(r0.y >> 16) + bf2f(g1.y >> 16) * acc[mi][ni][3];
        *(u32x2*)(ro + (long)m * D + n) = pk4(o);
      }
    }
  }
}
__device__ __forceinline__ void ph_gemm_wout(const Params& p, bf16_t* lds) {
  GEMM_IDS
  const bf16_t* A = (const bf16_t*)(p.ws + OFF_RETOUT);
  const bf16_t* Bt = (const bf16_t*)(p.ws + OFF_WOUT);
  const float* gate = (const float*)(p.ws + OFF_MODS) + 5 * D;
  bool primed = false;
  XCD_TILE_LOOP(t, 128 * 16) {
    int tm, tn;
    tile_map(t, 128, 16, tm, tn);
    f32x4 acc[4][4];
    acc_zero(acc);
    const bf16_t *nA = nullptr, *nB = nullptr;
    if (t + (int)GSZ < 128 * 16) { int tm2, tn2; tile_map(t + GSZ, 128, 16, tm2, tn2); nA = A + (long)tm2 * 128 * D; nB = Bt + (long)tn2 * 128 * D; }
    gemm_acc<true>(acc, A + (long)tm * 128 * D, D, Bt + (long)tn * 128 * D, D, D, lds, nA, nB, primed);
    primed = nA != nullptr;
#pragma unroll
    for (int mi = 0; mi < 4; ++mi) {
      const int m = tm * 128 + 64 * wm + 16 * mi + l15;
#pragma unroll
      for (int ni = 0; ni < 4; ++ni) {
        const int n = tn * 128 + 64 * wn + 16 * ni + 4 * l4;
        float* op = p.out + (long)m * D + n;
        const f32x4 gt = *(const f32x4*)(gate + n);
        const f32x4 rs = *(const f32x4*)(op);
        *(f32x4*)(op) = rs + gt * acc[mi][ni];
      }
    }
  }
}


#define EPI_HEAD static constexpr bool PERM = false, AFTER_DRAIN = false;
typedef const f32x4 (&acc8_t)[2][2][4][2];
struct EpiSwiglu {
  EPI_HEAD
  bf16_t* H;
  __device__ __forceinline__ void operator()(acc8_t acc, const pg8::Unit& u, int wr, int wc, int fr, int fq) const {
#pragma unroll
    for (int ai = 0; ai < 2; ++ai)
#pragma unroll
      for (int m = 0; m < 4; ++m) {
        const int row = u.pm * 256 + ai * 128 + wr * 64 + m * 16 + fr;
#pragma unroll
        for (int n = 0; n < 2; ++n) {
          f32x4 o;
#pragma unroll
          for (int j = 0; j < 4; ++j) o[j] = silu_f(acc[ai][0][m][n][j]) * acc[ai][1][m][n][j];
          *(u32x2*)(H + (long)row * DFF + u.pn * 128 + wc * 32 + n * 16 + fq * 4) = pk4(o);
        }
      }
  }
};
struct EpiDown {
  EPI_HEAD
  const float* res; float* out; const float* gate;
  __device__ __forceinline__ void operator()(acc8_t acc, const pg8::Unit& u, int wr, int wc, int fr, int fq) const {
#pragma unroll
    for (int ai = 0; ai < 2; ++ai)
#pragma unroll
      for (int m = 0; m < 4; ++m) {
        const long ro = (long)(u.pm * 256 + ai * 128 + wr * 64 + m * 16 + fr) * D;
#pragma unroll
        for (int bj = 0; bj < 2; ++bj)
#pragma unroll
          for (int n = 0; n < 2; ++n) {
            const int col = u.pn * 256 + bj * 128 + wc * 32 + n * 16 + fq * 4;
            const f32x4 gt = *(const f32x4*)(gate + col);
            const f32x4 rs = *(const f32x4*)(res + ro + col);
            *(f32x4*)(out + ro + col) = rs + 0.5f * gt * acc[ai][bj][m][n];
          }
      }
  }
};
struct EpiPlain {
  EPI_HEAD
  bf16_t* C; int ldc;
  __device__ __forceinline__ void operator()(acc8_t acc, const pg8::Unit& u, int wr, int wc, int fr, int fq) const {
#pragma unroll
    for (int ai = 0; ai < 2; ++ai)
#pragma unroll
      for (int m = 0; m < 4; ++m) {
        const long ro = (long)(u.pm * 256 + ai * 128 + wr * 64 + m * 16 + fr) * ldc;
#pragma unroll
        for (int bj = 0; bj < 2; ++bj)
#pragma unroll
          for (int n = 0; n < 2; ++n) {
            const int col = u.pn * 256 + bj * 128 + wc * 32 + n * 16 + fq * 4;
            *(u32x2*)(C + ro + col) = pk4(acc[ai][bj][m][n]);
          }
      }
  }
};
struct EpiHyo {
  EPI_HEAD
  bf16_t* ro; const bf16_t* gates;
  __device__ __forceinline__ void operator()(acc8_t acc, const pg8::Unit& u, int wr, int wc, int fr, int fq) const {
#pragma unroll
    for (int ai = 0; ai < 2; ++ai)
#pragma unroll
      for (int m = 0; m < 4; ++m) {
        const long row = u.pm * 256 + ai * 128 + wr * 64 + m * 16 + fr;
#pragma unroll
        for (int bj = 0; bj < 2; ++bj)
#pragma unroll
          for (int n = 0; n < 2; ++n) {
            const int col = u.pn * 256 + bj * 128 + wc * 32 + n * 16 + fq * 4;
            const u32x2 r0 = *(const u32x2*)(ro + row * D + col);
            const u32x2 g0 = *(const u32x2*)(gates + row * 4096 + col);
            const u32x2 g1 = *(const u32x2*)(gates + row * 4096 + 2048 + col);
            const f32x4 a = acc[ai][bj][m][n];
            f32x4 o;
            o[0] = bf2f(g0.x & 0xffffu) * bf2f(r0.x & 0xffffu) + bf2f(g1.x & 0xffffu) * a[0];
            o[1] = bf2f(g0.x >> 16) * bf2f(r0.x >> 16) + bf2f(g1.x >> 16) * a[1];
            o[2] = bf2f(g0.y & 0xffffu) * bf2f(r0.y & 0xffffu) + bf2f(g1.y & 0xffffu) * a[2];
            o[3] = bf2f(g0.y >> 16) * bf2f(r0.y >> 16) + bf2f(g1.y >> 16) * a[3];
            *(u32x2*)(ro + row * D + col) = pk4(o);
          }
      }
  }
};
struct EpiWout {
  EPI_HEAD
  float* out; const float* gate;
  __device__ __forceinline__ void operator()(acc8_t acc, const pg8::Unit& u, int wr, int wc, int fr, int fq) const {
#pragma unroll
    for (int ai = 0; ai < 2; ++ai)
#pragma unroll
      for (int m = 0; m < 4; ++m) {
        const long ro = (long)(u.pm * 256 + ai * 128 + wr * 64 + m * 16 + fr) * D;
#pragma unroll
        for (int bj = 0; bj < 2; ++bj)
#pragma unroll
          for (int n = 0; n < 2; ++n) {
            const int col = u.pn * 256 + bj * 128 + wc * 32 + n * 16 + fq * 4;
            const f32x4 gt = *(const f32x4*)(gate + col);
            const f32x4 rs = *(const f32x4*)(out + ro + col);
            *(f32x4*)(out + ro + col) = rs + gt * acc[ai][bj][m][n];
          }
      }
  }
};
struct EpiWinA {
  EPI_HEAD
  bf16_t *q, *kk, *kTf, *kTb, *vT, *sg; const float2* rope; const float* lg;
  __device__ __forceinline__ void operator()(acc8_t acc, const pg8::Unit& u, int wr, int wc, int fr, int fq) const {
    const int pn = u.pn;
    if (pn < 8) {
      const bool isq = pn < 4;
      const int hh = wc >> 1, hf = wc & 1;
      const int head = 2 * (isq ? pn : pn - 4) + hh;
      const float scl = isq ? 0.08838834764831845f : 1.f;
      const float lgf = lg[head], lgb = lg[8 + head];
#pragma unroll
      for (int ai = 0; ai < 2; ++ai)
#pragma unroll
        for (int m = 0; m < 4; ++m) {
          const int t = u.pm * 256 + ai * 128 + wr * 64 + m * 16 + fr;
          const int pos = hf ? (t & 63) : (t >> 6);
          const int jc = t & 127;
          const float zf = __expf(lgf * (float)(127 - jc)), zb = __expf(lgb * (float)jc);
#pragma unroll
          for (int n = 0; n < 2; ++n) {
            const int i0 = 16 * n + 4 * fq;
            f32x4 o1, o2;
#pragma unroll
            for (int j = 0; j < 4; ++j) {
              const float2 cs = rope[pos * 32 + i0 + j];
              const float x1 = acc[ai][0][m][n][j] * scl, x2 = acc[ai][1][m][n][j] * scl;
              o1[j] = x1 * cs.x - x2 * cs.y;
              o2[j] = x1 * cs.y + x2 * cs.x;
            }
            const int cb = head * 128 + hf * 64 + i0;
            bf16_t* dp = (isq ? q : kk) + (long)t * 1024 + cb;
            *(u32x2*)(dp) = pk4(o1);
            *(u32x2*)(dp + 32) = pk4(o2);
            if (!isq) {
#pragma unroll
              for (int j = 0; j < 4; ++j) {
                kTf[(long)(cb + j) * TT + t] = f2bf(o1[j] * zf);
                kTb[(long)(cb + j) * TT + t] = f2bf(o1[j] * zb);
                kTf[(long)(cb + 32 + j) * TT + t] = f2bf(o2[j] * zf);
                kTb[(long)(cb + 32 + j) * TT + t] = f2bf(o2[j] * zb);
              }
            }
          }
        }
    } else if (pn < 16) {
#pragma unroll
      for (int ai = 0; ai < 2; ++ai)
#pragma unroll
        for (int m = 0; m < 4; ++m) {
          const int t = u.pm * 256 + ai * 128 + wr * 64 + m * 16 + fr;
#pragma unroll
          for (int bj = 0; bj < 2; ++bj)
#pragma unroll
            for (int n = 0; n < 2; ++n) {
              const int ch = (pn - 8) * 256 + bj * 128 + wc * 32 + n * 16 + fq * 4;
#pragma unroll
              for (int j = 0; j < 4; ++j) vT[(long)(ch + j) * TT + t] = f2bf(acc[ai][bj][m][n][j]);
            }
        }
    } else {
#pragma unroll
      for (int ai = 0; ai < 2; ++ai)
#pragma unroll
        for (int m = 0; m < 4; ++m) {
          const long t = u.pm * 256 + ai * 128 + wr * 64 + m * 16 + fr;
#pragma unroll
          for (int bj = 0; bj < 2; ++bj)
#pragma unroll
            for (int n = 0; n < 2; ++n) {
              const int col = (pn - 16) * 256 + bj * 128 + wc * 32 + n * 16 + fq * 4;
              f32x4 o;
#pragma unroll
              for (int j = 0; j < 4; ++j) o[j] = silu_f(acc[ai][bj][m][n][j]);
              *(u32x2*)(sg + t * D + col) = pk4(o);
            }
        }
    }
  }
};
struct EpiWinB {
  EPI_HEAD
  bf16_t *phy, *gates;
  __device__ __forceinline__ void operator()(acc8_t acc, const pg8::Unit& u, int wr, int wc, int fr, int fq) const {
    const int pn = u.pn;
#pragma unroll
    for (int ai = 0; ai < 2; ++ai)
#pragma unroll
      for (int m = 0; m < 4; ++m) {
        const long t = u.pm * 256 + ai * 128 + wr * 64 + m * 16 + fr;
#pragma unroll
        for (int bj = 0; bj < 2; ++bj)
#pragma unroll
          for (int n = 0; n < 2; ++n) {
            const int cl = bj * 128 + wc * 32 + n * 16 + fq * 4;
            if (pn < 48) {
              *(u32x2*)(phy + t * 6144 + (pn - 24) * 256 + cl) = pk4(acc[ai][bj][m][n]);
            } else {
              f32x4 o;
#pragma unroll
              for (int j = 0; j < 4; ++j) o[j] = sigm_f(acc[ai][bj][m][n][j]);
              *(u32x2*)(gates + t * 4096 + (pn - 48) * 256 + cl) = pk4(o);
            }
          }
      }
  }
};
template <class Epi>
__device__ __forceinline__ void big_gemm(char* lds_all, const bf16_t* A, const bf16_t* Bt, int K, int nM, int nN, int pn0, const Epi& E) {
  pg8::Gemm g;
  g.A = A; g.Bt = Bt; g.M = nM * 256; g.N = 0; g.K = K;
  pg8::TileOrder S;
  S.init(nM, nN, pn0, (int)gridDim.x, (int)blockIdx.x);
  pg8::gemm_phase(( __attribute__((address_space(3))) unsigned char*)lds_all, g, S, E);
}

__device__ __forceinline__ void ph_ctx_up(const Params& p, char* lds_all) {
  GEMM_IDS
  const int hv = fresh_tid() >> 8;
  bf16_t* lds = (bf16_t*)(lds_all + hv * LDS_HALF);
  u32x2* xch = (u32x2*)lds_all;
  const bf16_t* A = (const bf16_t*)(p.ws + OFF_AR) + (long)T * D;
  const bf16_t* Bt = (const bf16_t*)(p.ws + OFF_WBIG);
  bf16_t* H = (bf16_t*)(p.ws + OFF_H);
  for (int it = (int)blockIdx.x; it < 88; it += (int)gridDim.x) {
    const int tmc = it / 44, P = it % 44;
    f32x4 acc[4][4];
    acc_zero(acc);
    gemm_acc<true>(acc, A + (long)tmc * 128 * D, D, Bt + (long)(256 * P + 128 * hv) * D, D, D, lds);
    if (hv == 0) {
#pragma unroll
      for (int mi = 0; mi < 4; ++mi)
#pragma unroll
        for (int ni = 0; ni < 4; ++ni) {
          f32x4 o;
#pragma unroll
          for (int r = 0; r < 4; ++r) o[r] = silu_f(acc[mi][ni][r]);
          xch[(mi * 4 + ni) * 256 + TID] = pk4(o);
        }
    }
    __syncthreads();
    if (hv == 1) {
#pragma unroll
      for (int mi = 0; mi < 4; ++mi) {
        const int m = T + tmc * 128 + 64 * wm + 16 * mi + l15;
#pragma unroll
        for (int ni = 0; ni < 4; ++ni) {
          const int n = 128 * P + 64 * wn + 16 * ni + 4 * l4;
          const u32x2 w = xch[(mi * 4 + ni) * 256 + TID];
          f32x4 o;
          o[0] = bf2f(w.x & 0xffffu) * acc[mi][ni][0];
          o[1] = bf2f(w.x >> 16) * acc[mi][ni][1];
          o[2] = bf2f(w.y & 0xffffu) * acc[mi][ni][2];
          o[3] = bf2f(w.y >> 16) * acc[mi][ni][3];
          *(u32x2*)(H + (long)m * DFF + n) = pk4(o);
        }
      }
    }
  }
}
__device__ __forceinline__ void ph_ctx_down(const Params& p, bf16_t* lds) {
  GEMM_IDS
  const bf16_t* A = (const bf16_t*)(p.ws + OFF_H) + (long)T * DFF;
  const bf16_t* Bt = (const bf16_t*)(p.ws + OFF_WDOWN);
  const float* gate = (const float*)(p.ws + OFF_MODS) + NMOD + 2 * D;
  float* outc = (float*)(p.ws + OFF_CTX1);
  for (int it = BID; it < 128; it += GSZ) {
    const int ks = it & 3, tn = (it >> 2) & 15, tmc = it >> 6;
    f32x4 acc[4][4];
    acc_zero(acc);
    gemm_acc<true>(acc, A + (long)tmc * 128 * DFF + ks * 1408, DFF, Bt + (long)tn * 128 * DFF + ks * 1408, DFF, 1408, lds);
#pragma unroll
    for (int mi = 0; mi < 4; ++mi) {
      const int m = tmc * 128 + 64 * wm + 16 * mi + l15;
#pragma unroll
      for (int ni = 0; ni < 4; ++ni) {
        const int n = tn * 128 + 64 * wn + 16 * ni + 4 * l4;
        const f32x4 gt = *(const f32x4*)(gate + n);
#pragma unroll
        for (int r = 0; r < 4; ++r) atomicAdd(outc + (long)m * D + n + r, 0.5f * gt[r] * acc[mi][ni][r]);
      }
    }
  }
}
__device__ __forceinline__ void ph_ctx1_init(const Params& p) {
  f32x4* o = (f32x4*)(p.ws + OFF_CTX1);
  const f32x4* src = (const f32x4*)p.ctx;
  for (int i = BID * 256 + TID; i < 256 * D / 4; i += GSZ * 256) o[i] = src[i];
}
__device__ __forceinline__ void ph_ctx_win(const Params& p, char* lds_all) {
  GEMM_IDS
  const int hv = fresh_tid() >> 8;
  bf16_t* lds = (bf16_t*)(lds_all + hv * LDS_HALF);
  float* xacc = (float*)(lds_all + LDS_HALF);
  const bf16_t* A = (const bf16_t*)(p.ws + OFF_AR) + (long)T * D + hv * 1024;
  const bf16_t* Bt = (const bf16_t*)(p.ws + OFF_WBIG) + hv * 1024;
  bf16_t* kTf = (bf16_t*)(p.ws + OFF_KTF);
  bf16_t* kTb = (bf16_t*)(p.ws + OFF_KTB);
  bf16_t* vT = (bf16_t*)(p.ws + OFF_VT);
  for (int it = (int)blockIdx.x; it < 48; it += (int)gridDim.x) {
    f32x4 acc[4][4];
    acc_zero(acc);
    const bool isk = it < 16;
    const int u2 = it - 16;
    const int tmc = isk ? (it >> 3) : (u2 >> 4);
    const int kt8 = it & 7, tv = u2 & 15;
    if (isk)
      gemm_acc<true>(acc, A + (long)tmc * 128 * D, D, Bt + (long)(1024 + kt8 * 128) * D, D, 1024, lds);
    else
      gemm_acc<false>(acc, A + (long)tmc * 128 * D, D, Bt + (long)(2048 + tv * 128) * D, D, 1024, lds);
    if (hv == 1) {
#pragma unroll
      for (int mi = 0; mi < 4; ++mi)
#pragma unroll
        for (int ni = 0; ni < 4; ++ni) *(f32x4*)(xacc + ((mi * 4 + ni) * 256 + TID) * 4) = acc[mi][ni];
    }
    __syncthreads();
    if (hv == 0) {
#pragma unroll
      for (int mi = 0; mi < 4; ++mi)
#pragma unroll
        for (int ni = 0; ni < 4; ++ni) acc[mi][ni] += *(const f32x4*)(xacc + ((mi * 4 + ni) * 256 + TID) * 4);
      if (isk) {
        const int P = kt8 >> 1, sx = kt8 & 1;
        const int head = 2 * P + wn;
        const float lgf = p.lg[head], lgb = p.lg[8 + head];
#pragma unroll
        for (int mi = 0; mi < 4; ++mi) {
          const int m = T + tmc * 128 + 64 * wm + 16 * mi + l15;
          const int jc = m & 127;
          const float zf = __expf(lgf * (float)(127 - jc)), zb = __expf(lgb * (float)jc);
#pragma unroll
          for (int ni = 0; ni < 4; ++ni) {
            const int hf = ni >> 1, i0 = 16 * (ni & 1) + 4 * l4;
            const int cb = head * 128 + hf * 64 + i0 + 32 * sx;
#pragma unroll
            for (int r = 0; r < 4; ++r) {
              kTf[(long)(cb + r) * TT + m] = f2bf(acc[mi][ni][r] * zf);
              kTb[(long)(cb + r) * TT + m] = f2bf(acc[mi][ni][r] * zb);
            }
          }
        }
      } else {
#pragma unroll
        for (int mi = 0; mi < 4; ++mi) {
          const int m0 = T + tmc * 128 + 64 * wm + 16 * mi + 4 * l4;
#pragma unroll
          for (int ni = 0; ni < 4; ++ni) {
            const int ch = tv * 128 + 64 * wn + 16 * ni + l15;
            *(u32x2*)(vT + (long)ch * TT + m0) = pk4(acc[mi][ni]);
          }
        }
      }
    }
  }
}

#define XB_TMO      128
#define XB_XCNT(j)  (256  + 64 * (j))
#define XB_XSUB(j)  (1280 + 64 * (j))
#define XB_XGEN(j)  (2304 + 64 * (j))
#define XB_TOP      3328
#define XB_TOPGEN   3392
#define XCD_BAR_WORDS 3456
#define XB_SPIN_CAP (1u << 18)
#define LAS __attribute__((address_space(3)))

__device__ __forceinline__ unsigned xb_ld(unsigned* p)              { return __hip_atomic_load(p, __ATOMIC_RELAXED, __HIP_MEMORY_SCOPE_AGENT); }
__device__ __forceinline__ unsigned xb_add(unsigned* p, unsigned v) { return __hip_atomic_fetch_add(p, v, __ATOMIC_RELAXED, __HIP_MEMORY_SCOPE_AGENT); }
__device__ __forceinline__ unsigned xb_xcc_id() { return (unsigned)__builtin_amdgcn_s_getreg((3 << 11) | 20) & 0xFu; }
#define XB_SPIN(cond, bar) do { unsigned _sp = 0; while (cond) { __builtin_amdgcn_s_sleep(1); \
    if ((++_sp & 255u) == 0u) { if (xb_ld(&(bar)[XB_TMO])) break; if (_sp > XB_SPIN_CAP) { atomicAdd(&(bar)[XB_TMO], 1u); break; } } } } while (0)

struct XcdBarrier {
    unsigned* bar; unsigned x;
    volatile LAS unsigned* st;
};

__device__ __forceinline__ XcdBarrier xcd_barrier_post(unsigned* bar, volatile LAS unsigned* st) {
    XcdBarrier b; b.bar = bar; b.x = xb_xcc_id(); b.st = st;
    if (threadIdx.x == 0) (void)xb_add(&bar[XB_XCNT(b.x)], 1u);
    return b;
}
__device__ __forceinline__ void xcd_barrier_complete(unsigned* bar, unsigned x, unsigned& nloc, unsigned& nx) {
    const unsigned G = gridDim.x * gridDim.y * gridDim.z;
    unsigned sum, cnt, mine, sp = 0u;
    for (;;) {
        sum = 0u; cnt = 0u; mine = 0u;
#pragma unroll
        for (unsigned j = 0; j < 16; ++j) { const unsigned c = xb_ld(&bar[XB_XCNT(j)]); sum += c; cnt += (c > 0u) ? 1u : 0u; mine = (j == x) ? c : mine; }
        if (sum == G) break;
        __builtin_amdgcn_s_sleep(1);
        if ((++sp & 255u) == 0u) { if (xb_ld(&bar[XB_TMO])) break; if (sp > XB_SPIN_CAP) { atomicAdd(&bar[XB_TMO], 1u); break; } }
    }
    nloc = mine > 0u ? mine : 1u; nx = cnt > 0u ? cnt : 1u;
}

__device__ __forceinline__ void xcd_barrier(const XcdBarrier& b) {
    asm volatile("s_waitcnt vmcnt(0)" ::: "memory");
    __syncthreads();
    if (threadIdx.x == 0) {
        unsigned* bar = b.bar;
        __builtin_amdgcn_s_waitcnt(0);
        unsigned nloc = b.st[0], nx = b.st[1];
        if (nloc == 0u) { xcd_barrier_complete(bar, b.x, nloc, nx); b.st[0] = nloc; b.st[1] = nx; }
        const unsigned old = xb_add(&bar[XB_XSUB(b.x)], 1u);
        const unsigned gen = old / nloc;
        if (old + 1u == (gen + 1u) * nloc) {
            __builtin_amdgcn_fence(__ATOMIC_RELEASE, "agent");
            asm volatile("s_waitcnt vmcnt(0)" ::: "memory");
            const unsigned og = xb_add(&bar[XB_TOP], 1u);
            const unsigned tg = og / nx;
            if (og + 1u == (tg + 1u) * nx) xb_add(&bar[XB_TOPGEN], 1u);
            else XB_SPIN(xb_ld(&bar[XB_TOPGEN]) == tg, bar);
            __builtin_amdgcn_fence(__ATOMIC_ACQUIRE, "agent");
            xb_add(&bar[XB_XGEN(b.x)], 1u);
            asm volatile("s_waitcnt vmcnt(0)" ::: "memory");
        } else {
            XB_SPIN(xb_ld(&bar[XB_XGEN(b.x)]) == gen, bar);
            __builtin_amdgcn_fence(__ATOMIC_ACQUIRE, "agent");
            asm volatile("s_waitcnt vmcnt(0)" ::: "memory");
        }
    }
    __syncthreads();
}


__device__ __forceinline__ void gbar(unsigned* ctr, unsigned target) {
  asm volatile("s_waitcnt vmcnt(0) lgkmcnt(0)" ::: "memory");
  __syncthreads();
  if (threadIdx.x == 0) {
    __builtin_amdgcn_fence(__ATOMIC_RELEASE, "agent");
    asm volatile("s_waitcnt vmcnt(0)" ::: "memory");
    __hip_atomic_fetch_add(ctr, 1u, __ATOMIC_RELAXED, __HIP_MEMORY_SCOPE_AGENT);
    unsigned spins = 0;
    while (__hip_atomic_load(ctr, __ATOMIC_RELAXED, __HIP_MEMORY_SCOPE_AGENT) < target) {
      __builtin_amdgcn_s_sleep(2);
      if (++spins > (1u << 20)) break;
    }
    __builtin_amdgcn_fence(__ATOMIC_ACQUIRE, "agent");
    asm volatile("s_waitcnt vmcnt(0)" ::: "memory");
  }
  __syncthreads();
}
#ifndef SKIP_HY
#define SKIP_HY 0
#endif
#ifndef ONLY_NORM
#define ONLY_NORM 0
#endif
#ifndef SKIP_MIXER
#define SKIP_MIXER 0
#endif

__global__ void __launch_bounds__(512, 2) mega(Params p, int lo, int hi) {
  __shared__ __attribute__((aligned(1024))) char ldsc_all[LDS_BYTES];
#define ldsc (ldsc_all + (fresh_tid() >> 8) * LDS_HALF)
  cg::grid_group grid = cg::this_grid();
#define lds ((bf16_t*)ldsc)
#define ldsf ((float*)ldsc)
  char* ws = p.ws;
  volatile LAS unsigned* xb_st = (volatile LAS unsigned*)(ldsc_all + LDS_BYTES - 16);
  if (threadIdx.x == 0) { xb_st[0] = 0u; xb_st[1] = 0u; }
  __syncthreads();
  const XcdBarrier xb = xcd_barrier_post((unsigned*)(ws + OFF_BAR), xb_st);
#define PH(k, body) if (lo <= (k) && (k) < hi) { body; if ((k) + 1 < hi) xcd_barrier(xb); }
  if (lo < 0) grid.sync();
  PH(0, ph_mods_partial(p, ldsf))
  PH(2, ph_prenorm(p, p.x, p.ctx, TT, p.norm_g, 0);
        conv_weight(p.ffn_up, 2048, 11264, 11264, (bf16_t*)(ws + OFF_WBIG), 2, ldsf);
        conv_weight(p.ffn_down, 5632, 2048, 2048, (bf16_t*)(ws + OFF_WDOWN), 0, ldsf);
        conv_weight(p.w4, 64, 4096, 4096, (bf16_t*)(ws + OFF_W4T), 0, ldsf);
        conv_weight(p.w_ret_o, 2048, 2048, 2048, (bf16_t*)(ws + OFF_WRO), 0, ldsf);
        conv_weight(p.w_hy_o, 2048, 2048, 2048, (bf16_t*)(ws + OFF_WHO), 0, ldsf);
        conv_weight(p.w_out, 2048, 2048, 2048, (bf16_t*)(ws + OFF_WOUT), 0, ldsf);
        ph_misc0(p))
  PH(3, big_gemm(ldsc_all, (const bf16_t*)(ws + OFF_AR), (const bf16_t*)(ws + OFF_WBIG), 2048, 64, 44, 0, EpiSwiglu{(bf16_t*)(ws + OFF_H)});
        ph_ctx_up(p, ldsc_all); ph_ctx1_init(p))
  PH(4, big_gemm(ldsc_all, (const bf16_t*)(ws + OFF_H), (const bf16_t*)(ws + OFF_WDOWN), 5632, 64, 8, 0, EpiDown{p.x, p.out, (const float*)(ws + OFF_MODS) + 2 * D});
        ph_ctx_down(p, lds))
  PH(5, ph_prenorm(p, p.out, (const float*)(ws + OFF_CTX1), TT, p.norm_g + D, 1);
        conv_weight(p.w_in, 2048, 16384, 16384, (bf16_t*)(ws + OFF_WBIG), 3, ldsf))
#if !SKIP_MIXER
  PH(6, big_gemm(ldsc_all, (const bf16_t*)(ws + OFF_AR), (const bf16_t*)(ws + OFF_WBIG), 2048, 64, 24, 0,
                 EpiWinA{(bf16_t*)(ws + OFF_Q), (bf16_t*)(ws + OFF_K), (bf16_t*)(ws + OFF_KTF), (bf16_t*)(ws + OFF_KTB), (bf16_t*)(ws + OFF_VT), (bf16_t*)(ws + OFF_SG), (const float2*)(ws + OFF_ROPE), p.lg});
        ph_ctx_win(p, ldsc_all))
  PH(7, ph_ret_kv_p(p, lds))
  PH(8, ph_ret_scan(p))
  PH(9, ph_ret_out(p, ldsc_all))
  PH(11, big_gemm(ldsc_all, (const bf16_t*)(ws + OFF_Y), (const bf16_t*)(ws + OFF_WRO), 2048, 64, 8, 0, EpiPlain{(bf16_t*)(ws + OFF_RETOUT), D}))
  PH(12, big_gemm(ldsc_all, (const bf16_t*)(ws + OFF_AR), (const bf16_t*)(ws + OFF_WBIG), 2048, 64, 40, 24, EpiWinB{(bf16_t*)(ws + OFF_PHY), (bf16_t*)(ws + OFF_GATES)}))
#if !SKIP_HY
  PH(13, ph_hy_conv(p); ph_taps(p, 0, lds); ph_taps(p, 1, lds))
#endif
#if !SKIP_HY
  PH(15, ph_fft_a(p, 0, ldsc))
  PH(16, ph_fft_mid(p, ldsc_all))
  PH(17, ph_fft_c(p, 0, ldsc))
  PH(19, ph_fft_a(p, 1, ldsc))
  PH(20, ph_fft_mid(p, ldsc_all))
  PH(21, ph_fft_c(p, 1, ldsc))
#endif
  PH(26, big_gemm(ldsc_all, (const bf16_t*)(ws + OFF_X0), (const bf16_t*)(ws + OFF_WHO), 2048, 64, 8, 0, EpiHyo{(bf16_t*)(ws + OFF_RETOUT), (const bf16_t*)(ws + OFF_GATES)}))
  PH(27, big_gemm(ldsc_all, (const bf16_t*)(ws + OFF_RETOUT), (const bf16_t*)(ws + OFF_WOUT), 2048, 64, 8, 0, EpiWout{p.out, (const float*)(ws + OFF_MODS) + 5 * D}))
#endif
  PH(28, ph_prenorm(p, p.out, p.out, T, p.norm_g + 2 * D, 2);
         conv_weight(p.ffn_up + (long)2048 * 11264, 2048, 11264, 11264, (bf16_t*)(ws + OFF_WBIG), 2, ldsf);
         conv_weight(p.ffn_down + (long)5632 * 2048, 5632, 2048, 2048, (bf16_t*)(ws + OFF_WDOWN), 0, ldsf))
  PH(29, big_gemm(ldsc_all, (const bf16_t*)(ws + OFF_AR), (const bf16_t*)(ws + OFF_WBIG), 2048, 64, 44, 0, EpiSwiglu{(bf16_t*)(ws + OFF_H)}))
  PH(30, big_gemm(ldsc_all, (const bf16_t*)(ws + OFF_H), (const bf16_t*)(ws + OFF_WDOWN), 5632, 64, 8, 0, EpiDown{p.out, p.out, (const float*)(ws + OFF_MODS) + 8 * D}))
  PH(31, ph_final_norm(p))
}

extern "C" void kernel_launch(void* const* d_in, const int* in_sizes, int n_in, void* d_out, int out_size, void* d_ws,
                              size_t ws_size, hipStream_t stream) {
  if (ws_size < (size_t)WS_NEED || n_in < 29) {
    fprintf(stderr, "workspace too small: %zu\n", ws_size);
    return;
  }
  static int grid_blocks = 0;
  if (!grid_blocks) {
    int dev = 0, cus = 0, per_cu = 0;
    hipGetDevice(&dev);
    hipDeviceGetAttribute(&cus, hipDeviceAttributeMultiprocessorCount, dev);
    hipOccupancyMaxActiveBlocksPerMultiprocessor(&per_cu, mega, 512, 0);
    if (per_cu > 1) per_cu = 1;
    if (per_cu < 1) per_cu = 1;
    grid_blocks = cus * per_cu;
  }
  Params p{};
  const float** pp = (const float**)&p;
  for (int i = 0; i < 29; ++i) pp[i] = (const float*)d_in[i];
  p.out = (float*)d_out;
  p.ws = (char*)d_ws;
  hipMemsetAsync((char*)d_ws + OFF_BAR, 0, XCD_BAR_WORDS * 4, stream);
  hipMemsetAsync((char*)d_ws + OFF_MODS, 0, 2 * NMOD * 4, stream);
  int lo = 0, hi = NPH;
  void* args[] = {&p, &lo, &hi};
  hipError_t e = hipLaunchCooperativeKernel((void*)mega, dim3(grid_blocks), dim3(512), args, 0, stream);
  if (e != hipSuccess) fprintf(stderr, "cooperative launch failed: %s (grid %d)\n", hipGetErrorString(e), grid_blocks);
}
```

```cpp
#include <hip/hip_runtime.h>
#include <hip/hip_cooperative_groups.h>
#include <cstdio>
namespace cg = cooperative_groups;

typedef unsigned short bf16_t;
typedef short bf16x8 __attribute__((ext_vector_type(8)));
typedef float f32x4 __attribute__((ext_vector_type(4)));
typedef unsigned u32x2 __attribute__((ext_vector_type(2)));
typedef unsigned u32x4 __attribute__((ext_vector_type(4)));

__device__ __forceinline__ int fresh_tid() { int t = (int)threadIdx.x; asm volatile("" : "+v"(t)); return t; }
#define TID (fresh_tid() & 255)
#define BID ((int)(blockIdx.x * 2u) + (fresh_tid() >> 8))
#define GSZ ((int)(gridDim.x * 2u))
constexpr int T = 16384, TT = 16640, D = 2048, DFF = 5632;
constexpr long MiB = 1l << 20;
constexpr int NMOD = 18432;
constexpr long OFF_MODSPART = 0;
constexpr long OFF_MODS = 5 * MiB;
constexpr long OFF_SUMSQ = 5 * MiB + 512 * 1024;
constexpr long OFF_ROPE = 6 * MiB;
constexpr long OFF_BAR = 5 * MiB + 768 * 1024;
constexpr long OFF_CTX1 = 7 * MiB;
constexpr long OFF_H3B = 13 * MiB, OFF_W4T = 15 * MiB;
constexpr long OFF_TAPS = 104 * MiB, OFF_TAPS1 = 40 * MiB;
constexpr long OFF_WRO = 16 * MiB, OFF_WHO = 24 * MiB, OFF_WOUT = 32 * MiB;
constexpr long OFF_WBIG = 40 * MiB, OFF_WDOWN = 84 * MiB;
constexpr long OFF_AR = 106 * MiB;
constexpr long OFF_H = 171 * MiB;
constexpr long OFF_Q = 171 * MiB, OFF_K = 203 * MiB, OFF_KTF = 235 * MiB, OFF_KTB = 268 * MiB, OFF_VT = 301 * MiB,
               OFF_SG = 366 * MiB, OFF_KVT = 430 * MiB, OFF_P = 560 * MiB, OFF_Y = 592 * MiB;
constexpr long OFF_RETOUT = 171 * MiB, OFF_GATES = 235 * MiB, OFF_X0 = 363 * MiB, OFF_Z = 427 * MiB, OFF_PHY = 491 * MiB;
constexpr long OFF_S = 491 * MiB, OFF_KC = 40 * MiB;
constexpr long WS_NEED = 683 * MiB;
constexpr int LDS_HALF = 69632;
constexpr int LDS_BYTES = 2 * LDS_HALF;
constexpr int NPH = 32;
#ifndef SKIP_HY
#define SKIP_HY 0
#endif

struct Params {
  const float *x, *c, *ctx, *c_ctx, *w_ada, *b_ada, *norm_g, *ffn_up, *ffn_down, *w_in, *lg, *gn_g, *gn_b, *w_ret_o,
      *conv_w, *conv_b, *w1, *b1, *w2, *b2, *w3, *b3, *w4, *freq, *decay, *skip, *w_hy_o, *w_out, *fin_g;
  float* out;
  char* ws;
};

__device__ __forceinline__ float bf2f(unsigned h) { return __uint_as_float(h << 16); }
typedef float f32x2_t __attribute__((ext_vector_type(2)));
typedef __bf16 bf16x2_t __attribute__((ext_vector_type(2)));
__device__ __forceinline__ unsigned pk2(float lo, float hi) {
  const f32x2_t v = {lo, hi};
  const bf16x2_t b = __builtin_convertvector(v, bf16x2_t);
  return __builtin_bit_cast(unsigned, b);
}
__device__ __forceinline__ bf16_t f2bf(float f) { return (bf16_t)(pk2(f, 0.f) & 0xffffu); }
__device__ __forceinline__ u32x2 pk4(f32x4 v) {
  u32x2 r;
  r.x = pk2(v[0], v[1]);
  r.y = pk2(v[2], v[3]);
  return r;
}
__device__ __forceinline__ float wave_sum(float v) {
#pragma unroll
  for (int o = 32; o > 0; o >>= 1) v += __shfl_xor(v, o);
  return v;
}
__device__ __forceinline__ float silu_f(float v) { return v * __builtin_amdgcn_rcpf(1.f + __expf(-v)); }
__device__ __forceinline__ float sigm_f(float v) { return __builtin_amdgcn_rcpf(1.f + __expf(-v)); }

typedef __attribute__((address_space(3))) unsigned lds_u32_t;
template <bool SWAP>
__device__ __forceinline__ void gemm_acc(f32x4 (&acc)[4][4], const bf16_t* A, long lda, const bf16_t* Bt, long ldb, int K,
                                         bf16_t* lds, const bf16_t* nA = nullptr, const bf16_t* nB = nullptr,
                                         bool primed = false, long nlda = -1, long nldb = -1) {
  const int tid = TID, lane = tid & 63, w = tid >> 6, wm = w >> 1, wn = w & 1;
  char* ldsb = (char*)lds;
  const int chunk = (tid & 7) ^ ((tid >> 4) & 7);
  const int oa = (tid >> 3) * (int)lda + chunk * 8, ob = (tid >> 3) * (int)ldb + chunk * 8;
  const int sa = 32 * (int)lda, sb = 32 * (int)ldb;
  const int nk = K >> 6;
  if (!primed) {
    __syncthreads();
#pragma unroll
    for (int i = 0; i < 4; ++i) {
      __builtin_amdgcn_global_load_lds((const unsigned*)(A + (oa + i * sa)), (lds_u32_t*)(ldsb + tid * 16 + i * 4096), 16, 0, 0);
      __builtin_amdgcn_global_load_lds((const unsigned*)(Bt + (ob + i * sb)), (lds_u32_t*)(ldsb + 16384 + tid * 16 + i * 4096), 16, 0, 0);
    }
  }
  asm volatile("s_waitcnt vmcnt(0)" ::: "memory");
  __syncthreads();
  const int l15 = lane & 15, l4 = lane >> 4;
  const int o0 = l15 * 128 + ((l4 ^ (l15 >> 1)) << 4);
  for (int kt = 0; kt < nk; ++kt) {
    const int cur = kt & 1;
    if (kt + 1 < nk) {
      char* d = ldsb + (cur ^ 1) * 32768 + tid * 16;
#pragma unroll
      for (int i = 0; i < 4; ++i) {
        __builtin_amdgcn_global_load_lds((const unsigned*)(A + (oa + i * sa + (kt + 1) * 64)), (lds_u32_t*)(d + i * 4096), 16, 0, 0);
        __builtin_amdgcn_global_load_lds((const unsigned*)(Bt + (ob + i * sb + (kt + 1) * 64)), (lds_u32_t*)(d + 16384 + i * 4096), 16, 0, 0);
      }
    }
    const char* la = ldsb + cur * 32768 + (64 * wm) * 128;
    const char* lb = ldsb + cur * 32768 + 16384 + (64 * wn) * 128;
#pragma unroll
    for (int ks = 0; ks < 2; ++ks) {
      bf16x8 af[4], bfr[4];
#pragma unroll
      for (int i = 0; i < 4; ++i) {
        af[i] = *(const bf16x8*)(la + i * 2048 + (o0 ^ (ks * 64)));
        bfr[i] = *(const bf16x8*)(lb + i * 2048 + (o0 ^ (ks * 64)));
      }
#pragma unroll
      for (int mi = 0; mi < 4; ++mi)
#pragma unroll
        for (int ni = 0; ni < 4; ++ni) {
          if (SWAP)
            acc[mi][ni] = __builtin_amdgcn_mfma_f32_16x16x32_bf16(bfr[ni], af[mi], acc[mi][ni], 0, 0, 0);
          else
            acc[mi][ni] = __builtin_amdgcn_mfma_f32_16x16x32_bf16(af[mi], bfr[ni], acc[mi][ni], 0, 0, 0);
        }
    }
    asm volatile("s_waitcnt vmcnt(0)" ::: "memory");
    __syncthreads();
  }
  if (nA != nullptr) {
    const int la2 = (nlda < 0) ? (int)lda : (int)nlda, lb2 = (nldb < 0) ? (int)ldb : (int)nldb;
    const int oa2 = (tid >> 3) * la2 + chunk * 8, ob2 = (tid >> 3) * lb2 + chunk * 8;
#pragma unroll
    for (int i = 0; i < 4; ++i) {
      __builtin_amdgcn_global_load_lds((const unsigned*)(nA + (oa2 + i * 32 * la2)), (lds_u32_t*)(ldsb + tid * 16 + i * 4096), 16, 0, 0);
      __builtin_amdgcn_global_load_lds((const unsigned*)(nB + (ob2 + i * 32 * lb2)), (lds_u32_t*)(ldsb + 16384 + tid * 16 + i * 4096), 16, 0, 0);
    }
  }
}
__device__ __forceinline__ void acc_zero(f32x4 (&acc)[4][4]) {
#pragma unroll
  for (int i = 0; i < 4; ++i)
#pragma unroll
    for (int j = 0; j < 4; ++j) acc[i][j] = (f32x4){0.f, 0.f, 0.f, 0.f};
}
__device__ __forceinline__ void tile_map(int t, int ntm, int ntn, int& tm, int& tn) {
  const int GM = 8;
  const int per = GM * ntn;
  const int g = t / per, fm = g * GM;
  const int gsz = (ntm - fm) < GM ? (ntm - fm) : GM;
  const int rem = t - g * per;
  tn = rem / gsz;
  tm = fm + rem % gsz;
}

namespace pg8 {
#define PG8_LAS __attribute__((address_space(3)))
constexpr int BM = 256, BK = 64, HALF = 128, HTB = HALF * BK * 2  , STAGE_BYTES = 8 * HTB, NXCD = 8, WGM = 8;

__host__ __device__ __forceinline__ int lds_byte(int r, int c) { const int st = (r >> 4) * 2 + (c >> 5), rr = r & 15, cc = c & 31, ob = rr * 64 + cc * 2; return st * 1024 + (ob ^ (((ob >> 9) & 1) << 5)); }
__host__ __device__ __forceinline__ void stage_rc(int b, int& R, int& C) { const int st = b / 1024, sb = b % 1024, swz = sb ^ (((sb >> 9) & 1) << 5); R = (st >> 1) * 16 + swz / 64; C = (st & 1) * 32 + (swz % 64) / 2; }
__host__ __device__ __forceinline__ int perm32(int rho) { const int n = rho >> 4, i = rho & 15; return 8 * (i >> 2) + 4 * n + (i & 3); }

struct Unit { int pm, pn; };
struct Gemm { const bf16_t* A; const bf16_t* Bt; int M, N, K; };

struct TileOrder {
  int nM, nN, nwg, G, c, pn0;
  __device__ __forceinline__ void init(int nM_, int nN_, int pn0_, int G_, int c_) { nM = nM_; nN = nN_; nwg = nM_ * nN_; G = G_; c = c_; pn0 = pn0_; }
  __device__ __forceinline__ bool next(int i, Unit& u) const {
    const long L = (long)i * G + c;
    if (L >= nwg) return false;
    int wgid = (int)L;
    { const int q = nwg / NXCD, r = nwg % NXCD, xcd = wgid % NXCD, off = wgid / NXCD; wgid = (xcd < r ? xcd * (q + 1) : r * (q + 1) + (xcd - r) * q) + off; }
    const int nig = WGM * nN, gid = wgid / nig, fm = gid * WGM, gsz = (nM - fm) < WGM ? (nM - fm) : WGM;
    u.pm = fm + ((wgid % nig) % gsz);
    u.pn = pn0 + (wgid % nig) / gsz;
    return true;
  }
  __device__ __forceinline__ void a_ready(const Unit&) const {}
  __device__ __forceinline__ void done(const Unit&) const {}
};

template <class Epi, class Sched>
__device__ __forceinline__ void gemm_phase(PG8_LAS unsigned char* lds, const Gemm g, const Sched& S, const Epi& E) {
    const int tid = threadIdx.x, wid = __builtin_amdgcn_readfirstlane(tid >> 6), lane = tid & 63, wr = wid >> 2, wc = wid & 3, fr = lane & 15, fq = lane >> 4;
    const int K = g.K, nt = K / BK;
#define PG8_STAMP() do { } while (0)
    PG8_STAMP();
    unsigned voffA[2], voffB[2];
#pragma unroll
    for (int i = 0; i < 2; ++i) { int R, C; stage_rc(tid * 16 + i * 8192, R, C); const int Rb = Epi::PERM ? ((R & ~31) + perm32(R & 31)) : R;
        voffA[i] = (unsigned)(R * K + C) * 2u; voffB[i] = (unsigned)(Rb * K + C) * 2u; }
    const size_t kstep = (size_t)(BK * 2);
    const size_t hstep = (size_t)HALF * K * 2;
    const size_t tstep = 2 * hstep;
    const unsigned ldsw = (unsigned)wid * 1024u;
    const int aoff = lds_byte(wr * 64 + fr, fq * 8), boff = lds_byte(wc * 32 + fr, fq * 8);
#define PG8_SA(b, h) (((b) * 2 + (h)) * HTB)
#define PG8_SB(b, h) ((4 + (b) * 2 + (h)) * HTB)
#define PG8_STAGE(bufoff, gbase, voff) do { _Pragma("unroll") for (int _i = 0; _i < 2; ++_i) \
        __builtin_amdgcn_global_load_lds((const unsigned*)((const char*)(gbase) + (voff)[_i]), (PG8_LAS unsigned*)(lds + (bufoff) + ldsw + _i * 8192), 16, 0, 0); } while (0)
#define PG8_LDA(dst, b, h) do { _Pragma("unroll") for (int m = 0; m < 4; ++m) _Pragma("unroll") for (int k = 0; k < 2; ++k) dst[m][k] = *(const PG8_LAS bf16x8*)(lds + PG8_SA(b, h) + aoff + m * 2048 + k * 1024); } while (0)
#define PG8_LDB(dst, b, h) do { _Pragma("unroll") for (int n = 0; n < 2; ++n) _Pragma("unroll") for (int k = 0; k < 2; ++k) dst[n][k] = *(const PG8_LAS bf16x8*)(lds + PG8_SB(b, h) + boff + n * 2048 + k * 1024); } while (0)
#define PG8_MMA(ai, bj, At, Bt) do { __builtin_amdgcn_s_setprio(1); _Pragma("unroll") for (int m = 0; m < 4; ++m) _Pragma("unroll") for (int n = 0; n < 2; ++n) _Pragma("unroll") for (int k = 0; k < 2; ++k) \
        acc[ai][bj][m][n] = __builtin_amdgcn_mfma_f32_16x16x32_bf16(Bt[n][k], At[m][k], acc[ai][bj][m][n], 0, 0, 0); __builtin_amdgcn_s_setprio(0); } while (0)
#define PG8_WAIT_V(n) asm volatile("s_waitcnt vmcnt(" #n ")" ::: "memory")
#define PG8_WAIT_L(n) asm volatile("s_waitcnt lgkmcnt(" #n ")" ::: "memory")
#define PG8_BAR __builtin_amdgcn_s_barrier()
#define PG8_SCHED __builtin_amdgcn_sched_barrier(0)
    Unit cur, nxt; int ui = 0;
    if (!S.next(0, cur)) return;
    f32x4 acc[2][2][4][2];
#pragma unroll
    for (int a = 0; a < 2; ++a)
#pragma unroll
        for (int b = 0; b < 2; ++b)
#pragma unroll
            for (int m = 0; m < 4; ++m)
#pragma unroll
                for (int n = 0; n < 2; ++n) acc[a][b][m][n] = (f32x4){0.f, 0.f, 0.f, 0.f};
    bf16x8 At[4][2], B0[2][2], B1[2][2];
    const char* cA = (const char*)g.A + (size_t)cur.pm * tstep; const char* cB = (const char*)g.Bt + (size_t)cur.pn * tstep;
    S.a_ready(cur);
    PG8_STAGE(PG8_SB(0, 0), cB, voffB); PG8_STAGE(PG8_SA(0, 0), cA, voffA); PG8_STAGE(PG8_SB(0, 1), cB + hstep, voffB); PG8_STAGE(PG8_SA(0, 1), cA + hstep, voffA);
    if (wr == 1) PG8_BAR;
    PG8_WAIT_V(4); PG8_BAR;
    PG8_STAGE(PG8_SB(1, 0), cB + kstep, voffB); PG8_STAGE(PG8_SA(1, 0), cA + kstep, voffA); PG8_STAGE(PG8_SB(1, 1), cB + hstep + kstep, voffB);
    PG8_WAIT_V(6); PG8_BAR;
    PG8_STAMP();
    for (;;) {
        const bool has_next = S.next(ui + 1, nxt);
        const char* nA = has_next ? (const char*)g.A + (size_t)nxt.pm * tstep : cA; const char* nB = has_next ? (const char*)g.Bt + (size_t)nxt.pn * tstep : cB;
        for (int t = 0; t < nt; t += 2) {
            const bool last = (t == nt - 2);
            const char* a1 = cA + (size_t)(t + 1) * kstep;
            const char* a2 = last ? nA : cA + (size_t)(t + 2) * kstep; const char* b2 = last ? nB : cB + (size_t)(t + 2) * kstep;
            const char* a3 = a2 + kstep; const char* b3 = b2 + kstep;
            if (last && has_next) S.a_ready(nxt);
            PG8_LDB(B0, 0, 0); PG8_SCHED; PG8_LDA(At, 0, 0); PG8_STAGE(PG8_SA(1, 1), a1 + hstep, voffA);
            PG8_WAIT_L(8); PG8_BAR; PG8_WAIT_L(0); PG8_MMA(0, 0, At, B0); PG8_BAR; PG8_SCHED;
            PG8_LDB(B1, 0, 1); PG8_STAGE(PG8_SB(0, 0), b2, voffB);
            PG8_BAR; PG8_WAIT_L(0); PG8_MMA(0, 1, At, B1); PG8_BAR;
            PG8_LDA(At, 0, 1); PG8_STAGE(PG8_SA(0, 0), a2, voffA);
            PG8_BAR; PG8_WAIT_L(0); PG8_MMA(1, 0, At, B0); PG8_BAR; PG8_SCHED;
            PG8_STAGE(PG8_SB(0, 1), b2 + hstep, voffB);
            PG8_WAIT_V(6); PG8_BAR; PG8_MMA(1, 1, At, B1); PG8_BAR;
            PG8_LDB(B0, 1, 0); PG8_SCHED; PG8_LDA(At, 1, 0); PG8_STAGE(PG8_SA(0, 1), a2 + hstep, voffA);
            PG8_WAIT_L(8); PG8_BAR; PG8_WAIT_L(0); PG8_MMA(0, 0, At, B0); PG8_BAR; PG8_SCHED;
            PG8_LDB(B1, 1, 1); PG8_STAGE(PG8_SB(1, 0), b3, voffB);
            PG8_BAR; PG8_WAIT_L(0); PG8_MMA(0, 1, At, B1); PG8_BAR;
            PG8_LDA(At, 1, 1); PG8_STAGE(PG8_SA(1, 0), a3, voffA);
            PG8_BAR; PG8_WAIT_L(0); PG8_MMA(1, 0, At, B0); PG8_BAR; PG8_SCHED;
            PG8_STAGE(PG8_SB(1, 1), b3 + hstep, voffB);
            PG8_WAIT_V(6); PG8_BAR; PG8_MMA(1, 1, At, B1); PG8_BAR;
        }
        PG8_STAMP();
        if constexpr (!Epi::AFTER_DRAIN) { E(acc, cur, wr, wc, fr, fq); S.done(cur); }
        PG8_STAMP();
        if (!has_next) break;
#pragma unroll
        for (int a = 0; a < 2; ++a)
#pragma unroll
            for (int b = 0; b < 2; ++b)
#pragma unroll
                for (int m = 0; m < 4; ++m)
#pragma unroll
                    for (int n = 0; n < 2; ++n) acc[a][b][m][n] = (f32x4){0.f, 0.f, 0.f, 0.f};
        cur = nxt; cA = nA; cB = nB; ++ui;
    }
    PG8_WAIT_V(0);
    if (wr == 0) PG8_BAR;
    PG8_BAR;
    if constexpr (Epi::AFTER_DRAIN) { E.fused(acc, cur, wr, wc, fr, fq, lds, wid, lane); S.done(cur); }
    PG8_STAMP();
#undef PG8_STAMP
#undef PG8_SA
#undef PG8_SB
#undef PG8_STAGE
#undef PG8_LDA
#undef PG8_LDB
#undef PG8_MMA
#undef PG8_WAIT_V
#undef PG8_WAIT_L
#undef PG8_BAR
#undef PG8_SCHED
}
}
#define XCD_TILE_LOOP(t, ntiles)                                                                      \
  for (int t0_ = 0; t0_ < (ntiles); t0_ += GSZ)                                                        \
    if (const int t = t0_ + ((BID >> 1) & 7) * (GSZ >> 3) + (((BID >> 4) << 1) | (BID & 1)); t < (ntiles))
__device__ __forceinline__ void conv_weight(const float* src, int K, int ld, int N, bf16_t* dst, int mode, float* sm) {
  const int ntn = N >> 7, ntk = K >> 6;
  const int tid = TID;
  for (int t = BID; t < ntn * ntk; t += GSZ) {
    const int tn = t % ntn, tk = t / ntn;
    const int n0 = tn * 128, k0 = tk * 64;
    __syncthreads();
    {
      const int j = tid & 127, i = tid >> 7;
      const int n = n0 + j;
      int col = n;
      if (mode == 2) {
        const int P = n >> 8, c = n & 255;
        col = (c < 128) ? (128 * P + c) : (DFF + 128 * P + c - 128);
      } else if (mode == 3) {
        if (n < 2048) {
          const int P = n >> 8, c = n & 255, sx = c >> 7, c1 = c & 127;
          col = P * 256 + (c1 >> 6) * 128 + ((c1 >> 5) & 1) * 64 + (c1 & 31) + 32 * sx;
        }
      }
      float v[32];
#pragma unroll
      for (int r = 0; r < 32; ++r) v[r] = src[(long)(k0 + i + 2 * r) * ld + col];
#pragma unroll
      for (int r = 0; r < 32; ++r) sm[(i + 2 * r) * 129 + j] = v[r];
    }
    __syncthreads();
    {
      const int q = tid & 7, jj = tid >> 3;
#pragma unroll
      for (int r = 0; r < 4; ++r) {
        const int nn = jj + 32 * r;
        float v[8];
#pragma unroll
        for (int e = 0; e < 8; ++e) v[e] = sm[(q * 8 + e) * 129 + nn];
        u32x4 o;
        o.x = pk2(v[0], v[1]);
        o.y = pk2(v[2], v[3]);
        o.z = pk2(v[4], v[5]);
        o.w = pk2(v[6], v[7]);
        *(u32x4*)(dst + (long)(n0 + nn) * K + k0 + q * 8) = o;
      }
    }
  }
}

__device__ __forceinline__ void ph_mods_partial(const Params& p, float* sm) {
  float* part = (float*)(p.ws + OFF_MODSPART);
  for (int it = BID; it < 576; it += GSZ) {
    const int ks = it / 18, cch = it % 18;
    __syncthreads();
    if (TID < 128) {
      const int k = ks * 64 + (TID & 63);
      const float v = (TID < 64) ? p.c[k] : p.c_ctx[k];
      sm[TID] = v / (1.f + expf(-v));
    }
    __syncthreads();
    const int n = cch * 1024 + TID * 4;
    f32x4 a0 = (f32x4){0.f, 0.f, 0.f, 0.f}, a1 = a0;
    const float* wp = p.w_ada + (long)(ks * 64) * NMOD + n;
#pragma unroll 8
    for (int k = 0; k < 64; ++k) {
      const f32x4 w = *(const f32x4*)(wp + (long)k * NMOD);
      a0 += w * sm[k];
      a1 += w * sm[64 + k];
    }
    if (ks == 0) {
      const f32x4 bb = *(const f32x4*)(p.b_ada + n);
      a0 += bb;
      a1 += bb;
    }
    float* mods = (float*)(p.ws + OFF_MODS);
#pragma unroll
    for (int r = 0; r < 4; ++r) {
      atomicAdd(mods + n + r, a0[r]);
      atomicAdd(mods + NMOD + n + r, a1[r]);
    }
  }
}
__device__ __forceinline__ void ph_mods_reduce(const Params& p) {
  const float* part = (const float*)(p.ws + OFF_MODSPART);
  float* mods = (float*)(p.ws + OFF_MODS);
  for (int i = BID * 256 + TID; i < 2 * NMOD; i += GSZ * 256) {
    const int v = i / NMOD, n = i % NMOD;
    float s = p.b_ada[n];
    for (int ks = 0; ks < 32; ++ks) s += part[(long)(ks * 2 + v) * NMOD + n];
    mods[i] = s;
  }
}
__device__ __forceinline__ void ph_misc0(const Params& p) {
  float* sumsq = (float*)(p.ws + OFF_SUMSQ);
  float2* rope = (float2*)(p.ws + OFF_ROPE);
  bf16_t* h3 = (bf16_t*)(p.ws + OFF_H3B);
  const int gt = BID * 256 + TID, gs = GSZ * 256;
  for (int i = gt; i < 2048; i += gs) sumsq[i] = 0.f;
  for (int i = gt; i < 256 * 32; i += gs) {
    const int pos = i >> 5, k = i & 31;
    const float inv = exp2f(-(float)k * (13.287712379549449f / 32.f));
    const float ang = (float)pos * inv;
    rope[i] = make_float2(cosf(ang), sinf(ang));
  }
  const int lane = TID & 63;
  const int gw = BID * 4 + (TID >> 6), nw = GSZ * 4;
  const float fq = p.freq[lane];
  for (int j = gw; j < 16384; j += nw) {
    const float wj = (6.2831855f * (float)j) / 16384.f;
    float feat = 0.f;
    if (lane == 0)
      feat = (float)j / 16383.f;
    else if (lane <= 16) {
      const float f = 1e-4f + (float)(lane - 1) * ((15.f - 1e-4f) / 15.f);
      feat = cosf(f * wj);
    } else if (lane <= 32) {
      const float f = 1e-4f + (float)(lane - 17) * ((15.f - 1e-4f) / 15.f);
      feat = -sinf(f * wj);
    }
    float a = p.b1[lane];
    for (int e = 0; e < 33; ++e) a += __shfl(feat, e) * p.w1[e * 64 + lane];
    float h = sinf(fq * a);
    a = p.b2[lane];
    for (int k = 0; k < 64; ++k) a += __shfl(h, k) * p.w2[k * 64 + lane];
    h = sinf(fq * a);
    a = p.b3[lane];
    for (int k = 0; k < 64; ++k) a += __shfl(h, k) * p.w3[k * 64 + lane];
    h = sinf(fq * a);
    h3[j * 64 + lane] = f2bf(h);
  }
}
__device__ __forceinline__ void ph_prenorm(const Params& p, const float* xl, const float* xc, int rows, const float* g, int slot) {
  const float* mods = (const float*)(p.ws + OFF_MODS);
  bf16_t* A = (bf16_t*)(p.ws + OFF_AR);
  const int lane = TID & 63;
  const int gw = BID * 4 + (TID >> 6), nw = GSZ * 4;
  for (int r = gw; r < rows; r += nw) {
    const float* src = (r < T) ? xl + (long)r * D : xc + (long)(r - T) * D;
    const float* md = mods + ((r < T) ? 0 : NMOD);
    f32x4 v[8];
    float ss = 0.f;
#pragma unroll
    for (int i = 0; i < 8; ++i) {
      v[i] = *(const f32x4*)(src + i * 256 + lane * 4);
      ss += v[i][0] * v[i][0] + v[i][1] * v[i][1] + v[i][2] * v[i][2] + v[i][3] * v[i][3];
    }
    ss = wave_sum(ss);
    const float rstd = rsqrtf(ss * (1.f / 2048.f) + 1e-6f);
#pragma unroll
    for (int i = 0; i < 8; ++i) {
      const int c = i * 256 + lane * 4;
      const f32x4 gg = *(const f32x4*)(g + c);
      const f32x4 sh = *(const f32x4*)(md + (3 * slot) * D + c);
      const f32x4 sc = *(const f32x4*)(md + (3 * slot + 1) * D + c);
      const f32x4 y = v[i] * rstd * gg;
      const f32x4 o = y * (1.f + sc) + sh;
      *(u32x2*)(A + (long)r * D + c) = pk4(o);
    }
  }
}
__device__ __forceinline__ void ph_final_norm(const Params& p) {
  const int lane = TID & 63;
  const int gw = BID * 4 + (TID >> 6), nw = GSZ * 4;
  for (int r = gw; r < T; r += nw) {
    float* src = p.out + (long)r * D;
    f32x4 v[8];
    float ss = 0.f;
#pragma unroll
    for (int i = 0; i < 8; ++i) {
      v[i] = *(const f32x4*)(src + i * 256 + lane * 4);
      ss += v[i][0] * v[i][0] + v[i][1] * v[i][1] + v[i][2] * v[i][2] + v[i][3] * v[i][3];
    }
    ss = wave_sum(ss);
    const float rstd = rsqrtf(ss * (1.f / 2048.f) + 1e-6f);
#pragma unroll
    for (int i = 0; i < 8; ++i) {
      const int c = i * 256 + lane * 4;
      const f32x4 gg = *(const f32x4*)(p.fin_g + c);
      *(f32x4*)(src + c) = v[i] * rstd * gg;
    }
  }
}

#define GEMM_IDS                                                                       \
  const int lane = TID & 63, wv = TID >> 6, wm = wv >> 1, wn = wv & 1; \
  const int l15 = lane & 15, l4 = lane >> 4;                                           \
  (void)l15; (void)l4; (void)wm; (void)wn;

__device__ __forceinline__ void ph_gemm_up(const Params& p, int rows, bf16_t* lds) {
  GEMM_IDS
  const bf16_t* A = (const bf16_t*)(p.ws + OFF_AR);
  const bf16_t* Bt = (const bf16_t*)(p.ws + OFF_WBIG);
  bf16_t* H = (bf16_t*)(p.ws + OFF_H);
  const int ntm = rows >> 7, ntn = 88;
  bool primed = false;
  XCD_TILE_LOOP(t, ntm * ntn) {
    int tm, tn;
    tile_map(t, ntm, ntn, tm, tn);
    f32x4 acc[4][4];
    acc_zero(acc);
    const bf16_t *nA = nullptr, *nB = nullptr;
    if (t + (int)GSZ < ntm * ntn) { int tm2, tn2; tile_map(t + GSZ, ntm, ntn, tm2, tn2); nA = A + (long)tm2 * 128 * D; nB = Bt + (long)tn2 * 128 * D; }
    gemm_acc<true>(acc, A + (long)tm * 128 * D, D, Bt + (long)tn * 128 * D, D, D, lds, nA, nB, primed);
    primed = nA != nullptr;
#pragma unroll
    for (int mi = 0; mi < 4; ++mi) {
      const int m = tm * 128 + 64 * wm + 16 * mi + l15;
#pragma unroll
      for (int ni = 0; ni < 2; ++ni) {
        const int hc = (tn * 2 + wn) * 32 + 16 * ni + 4 * l4;
        f32x4 o;
#pragma unroll
        for (int r = 0; r < 4; ++r) o[r] = silu_f(acc[mi][ni][r]) * acc[mi][ni + 2][r];
        *(u32x2*)(H + (long)m * DFF + hc) = pk4(o);
      }
    }
  }
}
__device__ __forceinline__ void ph_gemm_down(const Params& p, int rows, int slot, const float* resl, const float* resc, float* outl, float* outc,
                             bf16_t* lds) {
  GEMM_IDS
  const bf16_t* A = (const bf16_t*)(p.ws + OFF_H);
  const bf16_t* Bt = (const bf16_t*)(p.ws + OFF_WDOWN);
  const float* mods = (const float*)(p.ws + OFF_MODS);
  const int ntm = rows >> 7, ntn = 16;
  bool primed = false;
  XCD_TILE_LOOP(t, ntm * ntn) {
    int tm, tn;
    tile_map(t, ntm, ntn, tm, tn);
    f32x4 acc[4][4];
    acc_zero(acc);
    const bf16_t *nA = nullptr, *nB = nullptr;
    if (t + (int)GSZ < ntm * ntn) { int tm2, tn2; tile_map(t + GSZ, ntm, ntn, tm2, tn2); nA = A + (long)tm2 * 128 * DFF; nB = Bt + (long)tn2 * 128 * DFF; }
    gemm_acc<true>(acc, A + (long)tm * 128 * DFF, DFF, Bt + (long)tn * 128 * DFF, DFF, DFF, lds, nA, nB, primed);
    primed = nA != nullptr;
    const bool lat = tm < 128;
    const float* gate = mods + (lat ? 0 : NMOD) + (3 * slot + 2) * D;
#pragma unroll
    for (int mi = 0; mi < 4; ++mi) {
      const int m = tm * 128 + 64 * wm + 16 * mi + l15;
      const float* rp = lat ? resl + (long)m * D : resc + (long)(m - T) * D;
      float* op = lat ? outl + (long)m * D : outc + (long)(m - T) * D;
#pragma unroll
      for (int ni = 0; ni < 4; ++ni) {
        const int n = tn * 128 + 64 * wn + 16 * ni + 4 * l4;
        const f32x4 gt = *(const f32x4*)(gate + n);
        const f32x4 rs = *(const f32x4*)(rp + n);
        *(f32x4*)(op + n) = rs + 0.5f * gt * acc[mi][ni];
      }
    }
  }
}
__device__ __forceinline__ void ph_gemm_plain(const bf16_t* A, const bf16_t* Bt, bf16_t* C, int M, int N, int K, bf16_t* lds) {
  GEMM_IDS
  const int ntm = M >> 7, ntn = N >> 7;
  bool primed = false;
  XCD_TILE_LOOP(t, ntm * ntn) {
    int tm, tn;
    tile_map(t, ntm, ntn, tm, tn);
    f32x4 acc[4][4];
    acc_zero(acc);
    const bf16_t *nA = nullptr, *nB = nullptr;
    if (t + (int)GSZ < ntm * ntn) { int tm2, tn2; tile_map(t + GSZ, ntm, ntn, tm2, tn2); nA = A + (long)tm2 * 128 * K; nB = Bt + (long)tn2 * 128 * K; }
    gemm_acc<true>(acc, A + (long)tm * 128 * K, K, Bt + (long)tn * 128 * K, K, K, lds, nA, nB, primed);
    primed = nA != nullptr;
#pragma unroll
    for (int mi = 0; mi < 4; ++mi) {
      const int m = tm * 128 + 64 * wm + 16 * mi + l15;
#pragma unroll
      for (int ni = 0; ni < 4; ++ni) {
        const int n = tn * 128 + 64 * wn + 16 * ni + 4 * l4;
        *(u32x2*)(C + (long)m * N + n) = pk4(acc[mi][ni]);
      }
    }
  }
}
__device__ __forceinline__ void ph_gemm_win_a(const Params& p, bf16_t* lds) {
  GEMM_IDS
  const bf16_t* A = (const bf16_t*)(p.ws + OFF_AR);
  const bf16_t* Bt = (const bf16_t*)(p.ws + OFF_WBIG);
  bf16_t* q = (bf16_t*)(p.ws + OFF_Q);
  bf16_t* kk = (bf16_t*)(p.ws + OFF_K);
  bf16_t* kTf = (bf16_t*)(p.ws + OFF_KTF);
  bf16_t* kTb = (bf16_t*)(p.ws + OFF_KTB);
  bf16_t* vT = (bf16_t*)(p.ws + OFF_VT);
  bf16_t* sg = (bf16_t*)(p.ws + OFF_SG);
  const float2* rope = (const float2*)(p.ws + OFF_ROPE);
  const int n_lat = 128 * 48, n_ctx = 2 * 24;
  XCD_TILE_LOOP(t, n_lat + n_ctx) {
    int tm, tn;
    if (t < n_lat)
      tile_map(t, 128, 48, tm, tn);
    else {
      const int u = t - n_lat;
      tm = 128 + u / 24;
      tn = 8 + u % 24;
    }
    f32x4 acc[4][4];
    acc_zero(acc);
    const bf16_t* Ap = A + (long)tm * 128 * D;
    const bf16_t* Bp = Bt + (long)tn * 128 * D;
    if (tn >= 16 && tn < 32) {
      gemm_acc<false>(acc, Ap, D, Bp, D, D, lds);
#pragma unroll
      for (int mi = 0; mi < 4; ++mi) {
        const int m0 = tm * 128 + 64 * wm + 16 * mi + 4 * l4;
#pragma unroll
        for (int ni = 0; ni < 4; ++ni) {
          const int ch = (tn - 16) * 128 + 64 * wn + 16 * ni + l15;
          *(u32x2*)(vT + (long)ch * TT + m0) = pk4(acc[mi][ni]);
        }
      }
    } else {
      gemm_acc<true>(acc, Ap, D, Bp, D, D, lds);
      if (tn < 8) {
        const float scl = 0.08838834764831845f;
#pragma unroll
        for (int mi = 0; mi < 4; ++mi) {
          const int m = tm * 128 + 64 * wm + 16 * mi + l15;
          const int pos = (wn == 0) ? (m >> 6) : (m & 63);
#pragma unroll
          for (int ni = 0; ni < 2; ++ni) {
            const int i0 = 16 * ni + 4 * l4;
            f32x4 o1, o2;
#pragma unroll
            for (int r = 0; r < 4; ++r) {
              const float2 cs = rope[pos * 32 + i0 + r];
              const float x1 = acc[mi][ni][r] * scl, x2 = acc[mi][ni + 2][r] * scl;
              o1[r] = x1 * cs.x - x2 * cs.y;
              o2[r] = x1 * cs.y + x2 * cs.x;
            }
            bf16_t* dp = q + (long)m * 1024 + tn * 128 + 64 * wn + i0;
            *(u32x2*)(dp) = pk4(o1);
            *(u32x2*)(dp + 32) = pk4(o2);
          }
        }
      } else if (tn < 16) {
        const int head = tn - 8;
        const float lgf = p.lg[head], lgb = p.lg[8 + head];
#pragma unroll
        for (int mi = 0; mi < 4; ++mi) {
          const int m = tm * 128 + 64 * wm + 16 * mi + l15;
          const bool lat = m < T;
          const int pos = (wn == 0) ? ((m >> 6) & 255) : (m & 63);
          const int j = m & 127;
          const float zf = __expf(lgf * (float)(127 - j)), zb = __expf(lgb * (float)j);
#pragma unroll
          for (int ni = 0; ni < 2; ++ni) {
            const int i0 = 16 * ni + 4 * l4;
            f32x4 o1, o2;
#pragma unroll
            for (int r = 0; r < 4; ++r) {
              float2 cs = rope[pos * 32 + i0 + r];
              if (!lat) cs = make_float2(1.f, 0.f);
              const float x1 = acc[mi][ni][r], x2 = acc[mi][ni + 2][r];
              o1[r] = x1 * cs.x - x2 * cs.y;
              o2[r] = x1 * cs.y + x2 * cs.x;
            }
            const int cb = head * 128 + 64 * wn + i0;
            if (lat) {
              bf16_t* dp = kk + (long)m * 1024 + cb;
              *(u32x2*)(dp) = pk4(o1);
              *(u32x2*)(dp + 32) = pk4(o2);
            }
#pragma unroll
            for (int r = 0; r < 4; ++r) {
              kTf[(long)(cb + r) * TT + m] = f2bf(o1[r] * zf);
              kTb[(long)(cb + r) * TT + m] = f2bf(o1[r] * zb);
              kTf[(long)(cb + 32 + r) * TT + m] = f2bf(o2[r] * zf);
              kTb[(long)(cb + 32 + r) * TT + m] = f2bf(o2[r] * zb);
            }
          }
        }
      } else {
#pragma unroll
        for (int mi = 0; mi < 4; ++mi) {
          const int m = tm * 128 + 64 * wm + 16 * mi + l15;
#pragma unroll
          for (int ni = 0; ni < 4; ++ni) {
            const int n = (tn - 32) * 128 + 64 * wn + 16 * ni + 4 * l4;
            f32x4 o;
#pragma unroll
            for (int r = 0; r < 4; ++r) o[r] = silu_f(acc[mi][ni][r]);
            *(u32x2*)(sg + (long)m * D + n) = pk4(o);
          }
        }
      }
    }
  }
}
__device__ __forceinline__ void ph_gemm_win_b(const Params& p, bf16_t* lds) {
  GEMM_IDS
  const bf16_t* A = (const bf16_t*)(p.ws + OFF_AR);
  const bf16_t* Bt = (const bf16_t*)(p.ws + OFF_WBIG);
  bf16_t* phy = (bf16_t*)(p.ws + OFF_PHY);
  bf16_t* gates = (bf16_t*)(p.ws + OFF_GATES);
  bool primed = false;
  XCD_TILE_LOOP(t, 128 * 80) {
    int tm, tn;
    tile_map(t, 128, 80, tm, tn);
    tn += 48;
    f32x4 acc[4][4];
    acc_zero(acc);
    const bf16_t *nA = nullptr, *nB = nullptr;
    if (t + (int)GSZ < 128 * 80) { int tm2, tn2; tile_map(t + GSZ, 128, 80, tm2, tn2); tn2 += 48; nA = A + (long)tm2 * 128 * D; nB = Bt + (long)tn2 * 128 * D; }
    gemm_acc<true>(acc, A + (long)tm * 128 * D, D, Bt + (long)tn * 128 * D, D, D, lds, nA, nB, primed);
    primed = nA != nullptr;
#pragma unroll
    for (int mi = 0; mi < 4; ++mi) {
      const int m = tm * 128 + 64 * wm + 16 * mi + l15;
#pragma unroll
      for (int ni = 0; ni < 4; ++ni) {
        const int nl = 64 * wn + 16 * ni + 4 * l4;
        if (tn < 96) {
          *(u32x2*)(phy + (long)m * 6144 + (tn - 48) * 128 + nl) = pk4(acc[mi][ni]);
        } else {
          f32x4 o;
#pragma unroll
          for (int r = 0; r < 4; ++r) o[r] = sigm_f(acc[mi][ni][r]);
          *(u32x2*)(gates + (long)m * 4096 + (tn - 96) * 128 + nl) = pk4(o);
        }
      }
    }
  }
}
__device__ __forceinline__ void ph_ret_kv_p(const Params& p, bf16_t* lds) {
  GEMM_IDS
  const bf16_t* q = (const bf16_t*)(p.ws + OFF_Q);
  const bf16_t* kk = (const bf16_t*)(p.ws + OFF_K);
  const bf16_t* kTf = (const bf16_t*)(p.ws + OFF_KTF);
  const bf16_t* kTb = (const bf16_t*)(p.ws + OFF_KTB);
  const bf16_t* vT = (const bf16_t*)(p.ws + OFF_VT);
  bf16_t* kvT = (bf16_t*)(p.ws + OFF_KVT);
  bf16_t* P = (bf16_t*)(p.ws + OFF_P);
  const int n1 = 130 * 8 * 2 * 2, n2 = 128 * 8;
  bool primed = false;
  for (int t = BID; t < n1; t += GSZ) {
    f32x4 acc[4][4];
    acc_zero(acc);
    {
      const int half = t & 1, d = (t >> 1) & 1, h = (t >> 2) & 7, ci = t >> 5;
      const bf16_t* Ap = vT + (long)(h * 256 + half * 128) * TT + ci * 128;
      const bf16_t* Bp = (d ? kTb : kTf) + (long)(h * 128) * TT + ci * 128;
      const bf16_t *nAp = nullptr, *nBp = nullptr;
      if (t + GSZ < n1) {
        const int t2 = t + GSZ, half2 = t2 & 1, d2 = (t2 >> 1) & 1, h2 = (t2 >> 2) & 7, ci2 = t2 >> 5;
        nAp = vT + (long)(h2 * 256 + half2 * 128) * TT + ci2 * 128;
        nBp = (d2 ? kTb : kTf) + (long)(h2 * 128) * TT + ci2 * 128;
      }
      gemm_acc<true>(acc, Ap, TT, Bp, TT, 128, lds, nAp, nBp, primed);
      primed = nAp != nullptr;
      bf16_t* o = kvT + ((long)(d * 130 + ci) * 8 + h) * 32768 + (long)(half * 128) * 128;
#pragma unroll
      for (int mi = 0; mi < 4; ++mi) {
        const int m = 64 * wm + 16 * mi + l15;
#pragma unroll
        for (int ni = 0; ni < 4; ++ni) {
          const int n = 64 * wn + 16 * ni + 4 * l4;
          *(u32x2*)(o + m * 128 + n) = pk4(acc[mi][ni]);
        }
      }
    }
  }
  bool primed2 = false;
  for (int u = BID; u < n2; u += GSZ) {
    f32x4 acc[4][4];
    acc_zero(acc);
    {
      const int h = u & 7, ci = u >> 3;
      const bf16_t* Ap = q + (long)ci * 128 * 1024 + h * 128;
      const bf16_t* Bp = kk + (long)ci * 128 * 1024 + h * 128;
      const bf16_t *nAp = nullptr, *nBp = nullptr;
      if (u + GSZ < n2) {
        const int u2 = u + GSZ, h2 = u2 & 7, ci2 = u2 >> 3;
        nAp = q + (long)ci2 * 128 * 1024 + h2 * 128;
        nBp = kk + (long)ci2 * 128 * 1024 + h2 * 128;
      }
      gemm_acc<true>(acc, Ap, 1024, Bp, 1024, 128, lds, nAp, nBp, primed2);
      primed2 = nAp != nullptr;
      const float lgf = p.lg[h], nlgb = -p.lg[8 + h];
      bf16_t* o = P + (long)(ci * 8 + h) * 16384;
#pragma unroll
      for (int mi = 0; mi < 4; ++mi) {
        const int a = 64 * wm + 16 * mi + l15;
#pragma unroll
        for (int ni = 0; ni < 4; ++ni) {
          const int b0 = 64 * wn + 16 * ni + 4 * l4;
          f32x4 ov;
#pragma unroll
          for (int r = 0; r < 4; ++r) {
            const int b = b0 + r;
            const int dd = a - b;
            const float dcy = (dd == 0) ? 2.f : __expf((dd > 0 ? lgf : nlgb) * (float)dd);
            ov[r] = acc[mi][ni][r] * dcy;
          }
          *(u32x2*)(o + a * 128 + b0) = pk4(ov);
        }
      }
    }
  }
}
__device__ __forceinline__ void ph_ret_scan(const Params& p) {
  unsigned* kv = (unsigned*)(p.ws + OFF_KVT);
  for (int it = BID * 256 + TID; it < 262144; it += GSZ * 256) {
    const int d = it >> 17, e2 = it & 131071, h = e2 >> 14, off = e2 & 16383;
    const float dec = expf(p.lg[d * 8 + h] * 128.f);
    unsigned* base = kv + ((long)d * 130 * 8 + h) * 16384 + off;
    float s0 = 0.f, s1 = 0.f;
    for (int sb = 0; sb < 130; sb += 10) {
      unsigned vv[10];
#pragma unroll
      for (int k = 0; k < 10; ++k) {
        const int step = sb + k;
        const int ci = (d == 0) ? ((step < 2) ? (128 + step) : (step - 2)) : (129 - step);
        vv[k] = base[(long)ci * 131072];
      }
#pragma unroll
      for (int k = 0; k < 10; ++k) {
        const int step = sb + k;
        const int ci = (d == 0) ? ((step < 2) ? (128 + step) : (step - 2)) : (129 - step);
        base[(long)ci * 131072] = pk2(s0, s1);
        s0 = s0 * dec + bf2f(vv[k] & 0xffffu);
        s1 = s1 * dec + bf2f(vv[k] >> 16);
      }
    }
  }
}
__device__ __forceinline__ void ph_ret_out(const Params& p, char* lds_all) {
  GEMM_IDS
  const int half = fresh_tid() >> 8;
  bf16_t* lds = (bf16_t*)(lds_all + half * LDS_HALF);
  float2* part = (float2*)(lds_all + 65536);
  const bf16_t* q = (const bf16_t*)(p.ws + OFF_Q);
  const bf16_t* vT = (const bf16_t*)(p.ws + OFF_VT);
  const bf16_t* kvT = (const bf16_t*)(p.ws + OFF_KVT);
  const bf16_t* P = (const bf16_t*)(p.ws + OFF_P);
  const bf16_t* sg = (const bf16_t*)(p.ws + OFF_SG);
  bf16_t* Y = (bf16_t*)(p.ws + OFF_Y);
  bool primed = false;
  for (int it = (int)blockIdx.x; it < 1024; it += (int)gridDim.x) {
    const int h = it & 7, ci = it >> 3;
    const float lgf = p.lg[h], lgb = p.lg[8 + h];
    f32x4 acc[4][4];
    acc_zero(acc);
    const bf16_t* Aq = q + (long)ci * 128 * 1024 + h * 128;
    const bf16_t* Sb = kvT + ((long)(130 + ci) * 8 + h) * 32768 + (long)(half * 128) * 128;
    const bf16_t* Sf = kvT + ((long)(ci)*8 + h) * 32768 + (long)(half * 128) * 128;
    const bf16_t* Ap = P + (long)(ci * 8 + h) * 16384;
    const bf16_t* Vp = vT + (long)(h * 256 + half * 128) * TT + ci * 128;
    const bf16_t *nAq = nullptr, *nSb = nullptr;
    if (it + (int)gridDim.x < 1024) {
      const int it2 = it + (int)gridDim.x, h2 = it2 & 7, ci2 = it2 >> 3;
      nAq = q + (long)ci2 * 128 * 1024 + h2 * 128;
      nSb = kvT + ((long)(130 + ci2) * 8 + h2) * 32768 + (long)(half * 128) * 128;
    }
    gemm_acc<true>(acc, Aq, 1024, Sb, 128, 128, lds, Aq, Sf, primed);
#pragma unroll
    for (int mi = 0; mi < 4; ++mi) {
      const int a = 64 * wm + 16 * mi + l15;
      const float ratio = __expf(lgb * (float)(128 - a) - lgf * (float)(a + 1));
#pragma unroll
      for (int ni = 0; ni < 4; ++ni) acc[mi][ni] *= ratio;
    }
    gemm_acc<true>(acc, Aq, 1024, Sf, 128, 128, lds, Ap, Vp, true, 128, TT);
#pragma unroll
    for (int mi = 0; mi < 4; ++mi) {
      const int a = 64 * wm + 16 * mi + l15;
      const float xf = __expf(lgf * (float)(a + 1));
#pragma unroll
      for (int ni = 0; ni < 4; ++ni) acc[mi][ni] *= xf;
    }
    gemm_acc<true>(acc, Ap, 128, Vp, TT, 128, lds, nAq, nSb, true, 1024, 128);
    primed = nAq != nullptr;
#pragma unroll
    for (int mi = 0; mi < 4; ++mi) {
      float s1 = 0.f, s2 = 0.f;
#pragma unroll
      for (int ni = 0; ni < 4; ++ni)
#pragma unroll
        for (int r = 0; r < 4; ++r) {
          const float v = acc[mi][ni][r];
          s1 += v;
          s2 += v * v;
        }
      s1 += __shfl_xor(s1, 16);
      s2 += __shfl_xor(s2, 16);
      s1 += __shfl_xor(s1, 32);
      s2 += __shfl_xor(s2, 32);
      if (l4 == 0) part[(half * 2 + wn) * 128 + 64 * wm + 16 * mi + l15] = make_float2(s1, s2);
    }
    __syncthreads();
#pragma unroll
    for (int mi = 0; mi < 4; ++mi) {
      const int a = 64 * wm + 16 * mi + l15;
      const float2 p0 = part[a], p1 = part[128 + a], p2 = part[256 + a], p3 = part[384 + a];
      const float mean = ((p0.x + p1.x) + (p2.x + p3.x)) * (1.f / 256.f);
      const float ex2 = ((p0.y + p1.y) + (p2.y + p3.y)) * (1.f / 256.f);
      const float rs = rsqrtf(fmaxf(ex2 - mean * mean, 0.f) + 1e-6f);
      const long t = (long)ci * 128 + a;
#pragma unroll
      for (int ni = 0; ni < 4; ++ni) {
        const int c = h * 256 + half * 128 + 64 * wn + 16 * ni + 4 * l4;
        const u32x2 graw = *(const u32x2*)(sg + t * D + c);
        const f32x4 gg = *(const f32x4*)(p.gn_g + c), gb = *(const f32x4*)(p.gn_b + c);
        f32x4 o;
        o[0] = ((acc[mi][ni][0] - mean) * rs * gg[0] + gb[0]) * bf2f(graw.x & 0xffffu);
        o[1] = ((acc[mi][ni][1] - mean) * rs * gg[1] + gb[1]) * bf2f(graw.x >> 16);
        o[2] = ((acc[mi][ni][2] - mean) * rs * gg[2] + gb[2]) * bf2f(graw.y & 0xffffu);
        o[3] = ((acc[mi][ni][3] - mean) * rs * gg[3] + gb[3]) * bf2f(graw.y >> 16);
        *(u32x2*)(Y + t * D + c) = pk4(o);
      }
    }
  }
}
__device__ __forceinline__ void ph_ret_gn(const Params& p) {
  bf16_t* Y = (bf16_t*)(p.ws + OFF_Y);
  const bf16_t* sg = (const bf16_t*)(p.ws + OFF_SG);
  const int lane = TID & 63;
  const int gw = BID * 4 + (TID >> 6), nw = GSZ * 4;
  for (int t = gw; t < T; t += nw) {
    u32x2 raw[8], graw[8];
#pragma unroll
    for (int h = 0; h < 8; ++h) {
      raw[h] = *(const u32x2*)(Y + (long)t * D + h * 256 + lane * 4);
      graw[h] = *(const u32x2*)(sg + (long)t * D + h * 256 + lane * 4);
    }
#pragma unroll
    for (int h = 0; h < 8; ++h) {
      const int c = h * 256 + lane * 4;
      float v[4] = {bf2f(raw[h].x & 0xffffu), bf2f(raw[h].x >> 16), bf2f(raw[h].y & 0xffffu), bf2f(raw[h].y >> 16)};
      const float mean = wave_sum(v[0] + v[1] + v[2] + v[3]) * (1.f / 256.f);
      float q = 0.f;
#pragma unroll
      for (int r = 0; r < 4; ++r) {
        v[r] -= mean;
        q += v[r] * v[r];
      }
      const float rs = rsqrtf(wave_sum(q) * (1.f / 256.f) + 1e-6f);
      const float gv[4] = {bf2f(graw[h].x & 0xffffu), bf2f(graw[h].x >> 16), bf2f(graw[h].y & 0xffffu), bf2f(graw[h].y >> 16)};
      const f32x4 gg = *(const f32x4*)(p.gn_g + c), gb = *(const f32x4*)(p.gn_b + c);
      f32x4 o;
#pragma unroll
      for (int r = 0; r < 4; ++r) o[r] = (v[r] * rs * gg[r] + gb[r]) * gv[r];
      *(u32x2*)(Y + (long)t * D + c) = pk4(o);
    }
  }
}
__device__ __forceinline__ void hy_conv_row(const u32x4 (&rm)[3], const u32x4 (&r0)[3], const u32x4 (&rp)[3], const float (&wv)[3][3][8],
                                            const float (&bv)[3][8], bf16_t* x0p, bf16_t* zp) {
  float u[3][8];
#pragma unroll
  for (int s3 = 0; s3 < 3; ++s3) {
#pragma unroll
    for (int e = 0; e < 8; ++e) u[s3][e] = bv[s3][e];
#pragma unroll
    for (int dt = 0; dt < 3; ++dt) {
      const u32x4 raw = (dt == 0) ? rm[s3] : ((dt == 1) ? r0[s3] : rp[s3]);
      const unsigned rw[4] = {raw.x, raw.y, raw.z, raw.w};
#pragma unroll
      for (int e = 0; e < 4; ++e) {
        u[s3][2 * e] += bf2f(rw[e] & 0xffffu) * wv[s3][dt][2 * e];
        u[s3][2 * e + 1] += bf2f(rw[e] >> 16) * wv[s3][dt][2 * e + 1];
      }
    }
  }
  u32x4 o0, oz;
  o0.x = pk2(u[0][0], u[0][1]);
  o0.y = pk2(u[0][2], u[0][3]);
  o0.z = pk2(u[0][4], u[0][5]);
  o0.w = pk2(u[0][6], u[0][7]);
  oz.x = pk2(u[1][0] * u[2][0], u[1][1] * u[2][1]);
  oz.y = pk2(u[1][2] * u[2][2], u[1][3] * u[2][3]);
  oz.z = pk2(u[1][4] * u[2][4], u[1][5] * u[2][5]);
  oz.w = pk2(u[1][6] * u[2][6], u[1][7] * u[2][7]);
  *(u32x4*)x0p = o0;
  *(u32x4*)zp = oz;
}
__device__ __forceinline__ void ph_hy_conv(const Params& p) {
  const bf16_t* phy = (const bf16_t*)(p.ws + OFF_PHY);
  bf16_t* x0 = (bf16_t*)(p.ws + OFF_X0);
  bf16_t* z = (bf16_t*)(p.ws + OFF_Z);
  const int c0 = TID * 8;
  float wv[3][3][8], bv[3][8];
#pragma unroll
  for (int s3 = 0; s3 < 3; ++s3) {
#pragma unroll
    for (int e = 0; e < 8; ++e) bv[s3][e] = p.conv_b[s3 * 2048 + c0 + e];
#pragma unroll
    for (int dt = 0; dt < 3; ++dt)
#pragma unroll
      for (int e = 0; e < 8; ++e) wv[s3][dt][e] = p.conv_w[dt * 6144 + s3 * 2048 + c0 + e];
  }
  const int nrows = T / GSZ;
  const int t0 = BID * nrows;
  u32x4 w0[3], w1[3], w2[3], w3[3], n0[3], n1[3];
#define HYC_LD(dst, tt)                                                                                   \
  {                                                                                                       \
    const int tt_ = (tt);                                                                                 \
    _Pragma("unroll") for (int s3 = 0; s3 < 3; ++s3)                                                      \
      dst[s3] = (tt_ >= 0 && tt_ < T) ? *(const u32x4*)(phy + (long)tt_ * 6144 + s3 * 2048 + c0) : (u32x4){0u, 0u, 0u, 0u}; \
  }
  HYC_LD(w0, t0 - 1)
  HYC_LD(w1, t0)
  HYC_LD(w2, t0 + 1)
  HYC_LD(w3, t0 + 2)
  for (int k = 0; k < nrows; k += 2) {
    const int t = t0 + k;
    HYC_LD(n0, t + 3)
    HYC_LD(n1, t + 4)
    hy_conv_row(w0, w1, w2, wv, bv, x0 + (long)t * D + c0, z + (long)t * D + c0);
    hy_conv_row(w1, w2, w3, wv, bv, x0 + (long)(t + 1) * D + c0, z + (long)(t + 1) * D + c0);
#pragma unroll
    for (int s3 = 0; s3 < 3; ++s3) { w0[s3] = w2[s3]; w1[s3] = w3[s3]; w2[s3] = n0[s3]; w3[s3] = n1[s3]; }
  }
#undef HYC_LD
}

typedef float c2f __attribute__((ext_vector_type(2)));
__device__ __forceinline__ c2f mk2(float a, float b) { return (c2f){a, b}; }
__device__ __forceinline__ c2f cmul(c2f a, c2f b) { return a.xx * b + a.yy * (c2f){-b.y, b.x}; }
__device__ __forceinline__ c2f cmulc(c2f a, c2f b) { return a.xx * (c2f){b.x, -b.y} + a.yy * (c2f){b.y, b.x}; }
__device__ __forceinline__ c2f cadd(c2f a, c2f b) { return a + b; }
__device__ __forceinline__ c2f csub(c2f a, c2f b) { return a - b; }
__device__ __forceinline__ constexpr float w16c(int m) {
  m &= 15;
  return m == 0 ? 1.f : m == 1 ? 0.92387953251f : m == 2 ? 0.70710678119f : m == 3 ? 0.38268343237f : m == 4 ? 0.f
       : m == 5 ? -0.38268343237f : m == 6 ? -0.70710678119f : m == 7 ? -0.92387953251f : m == 8 ? -1.f
       : m == 9 ? -0.92387953251f : m == 10 ? -0.70710678119f : m == 11 ? -0.38268343237f : m == 12 ? 0.f
       : m == 13 ? 0.38268343237f : m == 14 ? 0.70710678119f : 0.92387953251f;
}
__device__ __forceinline__ constexpr float w16s(int m) { return w16c(m - 4); }
template <int SGN>
__device__ __forceinline__ void dft4(c2f& a0, c2f& a1, c2f& a2, c2f& a3) {
  const c2f s02 = cadd(a0, a2), d02 = csub(a0, a2), s13 = cadd(a1, a3), d13 = csub(a1, a3);
  const c2f jd = mk2(-(float)SGN * d13.y, (float)SGN * d13.x);
  a0 = cadd(s02, s13);
  a1 = cadd(d02, jd);
  a2 = csub(s02, s13);
  a3 = csub(d02, jd);
}
template <int SGN>
__device__ __forceinline__ void dft16(c2f (&v)[16]) {
#pragma unroll
  for (int b = 0; b < 4; ++b) dft4<SGN>(v[b], v[4 + b], v[8 + b], v[12 + b]);
#pragma unroll
  for (int c = 1; c < 4; ++c)
#pragma unroll
    for (int b = 1; b < 4; ++b) {
      const float wr = w16c(b * c), wi = (float)SGN * w16s(b * c);
      const c2f t = v[4 * c + b];
      v[4 * c + b] = t.xx * (c2f){wr, wi} + t.yy * (c2f){-wi, wr};
    }
#pragma unroll
  for (int c = 0; c < 4; ++c) dft4<SGN>(v[4 * c], v[4 * c + 1], v[4 * c + 2], v[4 * c + 3]);
}
template <int SGN>
__device__ __forceinline__ void dft8(c2f (&v)[8]) {
  dft4<SGN>(v[0], v[2], v[4], v[6]);
  dft4<SGN>(v[1], v[3], v[5], v[7]);
#pragma unroll
  for (int c = 1; c < 4; ++c) {
    const float wr = w16c(2 * c), wi = (float)SGN * w16s(2 * c);
    const c2f t = v[2 * c + 1];
    v[2 * c + 1] = t.xx * (c2f){wr, wi} + t.yy * (c2f){-wi, wr};
  }
#pragma unroll
  for (int c = 0; c < 4; ++c) {
    const c2f t = v[2 * c], u = v[2 * c + 1];
    v[2 * c] = cadd(t, u);
    v[2 * c + 1] = csub(t, u);
  }
}
__device__ __forceinline__ void fft_tw_init(c2f* TW) {
  __syncthreads();
  {
    float s, c;
    sincospif((float)TID * (1.f / 128.f), &s, &c);
    TW[TID] = mk2(c, -s);
  }
  __syncthreads();
}
__device__ __forceinline__ c2f big_tw(int f1, int t2) {
  const float rev = (float)(f1 * t2) * (1.f / 32768.f);
  return mk2(__builtin_amdgcn_cosf(rev), -__builtin_amdgcn_sinf(rev));
}
__device__ __forceinline__ void ph_taps(const Params& p, int g, bf16_t* lds) {
  GEMM_IDS
  const bf16_t* A = (const bf16_t*)(p.ws + OFF_H3B);
  const bf16_t* W = (const bf16_t*)(p.ws + OFF_W4T);
  bf16_t* TP = (bf16_t*)(p.ws + (g ? OFF_TAPS1 : OFF_TAPS));
  bool primed = false;
  for (int t = BID; t < 128 * 16; t += GSZ) {
    const int tn = t & 15, tm = t >> 4;
    const int wrow = (tn < 8) ? (g * 1024 + tn * 128) : (2048 + g * 1024 + (tn - 8) * 128);
    f32x4 acc[4][4];
    acc_zero(acc);
    const bf16_t *nA = nullptr, *nB = nullptr;
    if (t + GSZ < 128 * 16) {
      const int t2 = t + GSZ, tn2 = t2 & 15, tm2 = t2 >> 4;
      const int wrow2 = (tn2 < 8) ? (g * 1024 + tn2 * 128) : (2048 + g * 1024 + (tn2 - 8) * 128);
      nA = A + (long)tm2 * 128 * 64;
      nB = W + (long)wrow2 * 64;
    }
    gemm_acc<true>(acc, A + (long)tm * 128 * 64, 64, W + (long)wrow * 64, 64, 64, lds, nA, nB, primed);
    primed = nA != nullptr;
#pragma unroll
    for (int mi = 0; mi < 4; ++mi) {
      const int m = tm * 128 + 64 * wm + 16 * mi + l15;
#pragma unroll
      for (int ni = 0; ni < 4; ++ni) {
        const int n = tn * 128 + 64 * wn + 16 * ni + 4 * l4;
        *(u32x2*)(TP + (long)m * 2048 + n) = pk4(acc[mi][ni]);
      }
    }
  }
}
constexpr float KSCALE = 2.0f;
__device__ __forceinline__ void ph_fft_a(const Params& p, int g, char* ldsc) {
  c2f* X = (c2f*)ldsc;
  c2f* TW = (c2f*)(ldsc + 65536);
  const bf16_t* z = (const bf16_t*)(p.ws + OFF_Z);
  const bf16_t* TP = (const bf16_t*)(p.ws + (g ? OFF_TAPS1 : OFF_TAPS));
  float* sumsq = (float*)(p.ws + OFF_SUMSQ);
  unsigned* S = (unsigned*)(p.ws + OFF_S);
  const int ch = TID & 31, rg = TID >> 5;
  fft_tw_init(TW);
  for (int it = BID; it < 4096; it += GSZ) {
    const int t2 = it & 127, cc = it >> 7;
    const int c = g * 1024 + cc * 32 + ch;
    __syncthreads();
    {
      const float dec = fabsf(p.decay[c]);
      float ssq = 0.f;
      unsigned short rz[16], rt[32];
#pragma unroll
      for (int i = 0; i < 16; ++i) rz[i] = z[(long)(128 * (rg + 8 * i) + t2) * D + c];
#pragma unroll
      for (int i = 0; i < 32; ++i) {
        const int half = i >> 4, t1 = half * 128 + rg + 8 * (i & 15), j = 128 * t1 + t2;
        int jj = half ? (32768 - j) : j;
        if (jj >= 16384) jj = 0;
        rt[i] = TP[(long)jj * 2048 + half * 1024 + cc * 32 + ch];
      }
#pragma unroll
      for (int i = 0; i < 32; ++i) {
        const int half = i >> 4, t1 = half * 128 + rg + 8 * (i & 15), j = 128 * t1 + t2;
        int jj = half ? (32768 - j) : j;
        const bool zero = (jj >= 16384);
        if (zero) jj = 0;
        float val = bf2f(rt[i]) * __expf(-((float)jj * (1.f / 16383.f)) * dec);
        if (zero) val = 0.f;
        ssq += val * val;
        const float zr = (i < 16) ? bf2f(rz[i & 15]) : 0.f;
        X[t1 * 32 + ch] = mk2(zr, val * KSCALE);
      }
      ((float*)(ldsc + 65536 + 2048))[TID] = ssq;
    }
    __syncthreads();
    if (TID < 32) {
      const float* red = (const float*)(ldsc + 65536 + 2048);
      float tot = 0.f;
#pragma unroll
      for (int r8 = 0; r8 < 8; ++r8) tot += red[r8 * 32 + TID];
      atomicAdd(&sumsq[c], tot);
    }
#pragma unroll 1
    for (int u = 0; u < 2; ++u) {
      const int j = rg + 8 * u;
      c2f v[16];
#pragma unroll
      for (int k = 0; k < 16; ++k) v[k] = X[(16 * k + j) * 32 + ch];
      dft16<-1>(v);
#pragma unroll
      for (int i = 0; i < 16; ++i) {
        const int q = (i >> 2) + 4 * (i & 3);
        X[(16 * q + j) * 32 + ch] = cmul(v[i], TW[(j * q) & 255]);
      }
    }
    __syncthreads();
#pragma unroll 1
    for (int u = 0; u < 2; ++u) {
      const int q = rg + 8 * u;
      c2f v[16];
#pragma unroll
      for (int j = 0; j < 16; ++j) v[j] = X[(16 * q + j) * 32 + ch];
      dft16<-1>(v);
      c2f twv[16];
      {
        const c2f st = big_tw(16, t2);
        twv[0] = big_tw(q, t2);
#pragma unroll
        for (int pp = 1; pp < 16; ++pp) twv[pp] = cmul(twv[pp - 1], st);
      }
#pragma unroll
      for (int i = 0; i < 16; ++i) {
        const int pp = (i >> 2) + 4 * (i & 3);
        const int r = 16 * q + pp;
        const c2f o = cmul(v[i], twv[pp]);
        S[((long)cc * 32768 + r * 128 + t2) * 32 + ch] = pk2(o.x, o.y);
      }
    }
  }
}
__device__ __forceinline__ void ph_fft_mid(const Params& p, char* lds_all) {
  const int hv = fresh_tid() >> 8;
  char* my = lds_all + hv * LDS_HALF;
  c2f* XS = (c2f*)my;
  c2f* TW = (c2f*)(my + 65536);
  unsigned* S = (unsigned*)(p.ws + OFF_S);
  const int ch = TID & 31, rg = TID >> 5;
  fft_tw_init(TW);
  unsigned rs[16];
  {
    const int pi0 = (int)blockIdx.x;
    const int P0 = pi0 & 127, cc0 = pi0 >> 7;
    const int f10 = (P0 == 0) ? (hv ? 128 : 0) : (hv ? 256 - P0 : P0);
    const int r0 = 16 * (f10 & 15) + (f10 >> 4);
    const long gb0 = ((long)cc0 * 32768 + r0 * 128) * 32 + ch;
#pragma unroll
    for (int k = 0; k < 16; ++k) rs[k] = S[gb0 + (8 * k + rg) * 32];
  }
  for (int pi = (int)blockIdx.x; pi < 4096; pi += (int)gridDim.x) {
    const int P = pi & 127, cc = pi >> 7;
    const int f1 = (P == 0) ? (hv ? 128 : 0) : (hv ? 256 - P : P);
    const int r = 16 * (f1 & 15) + (f1 >> 4);
    const long gbase = ((long)cc * 32768 + r * 128) * 32 + ch;
    const c2f* XP = (P == 0) ? (const c2f*)XS : (const c2f*)(lds_all + (hv ^ 1) * LDS_HALF);
    __syncthreads();
    {
      const int j = rg;
      c2f v[16];
#pragma unroll
      for (int k = 0; k < 16; ++k) { const unsigned w_ = rs[k]; v[k] = mk2(bf2f(w_ & 0xffffu), bf2f(w_ >> 16)); }
      dft16<-1>(v);
#pragma unroll
      for (int i = 0; i < 16; ++i) {
        const int q = (i >> 2) + 4 * (i & 3);
        XS[(8 * q + j) * 32 + ch] = cmul(v[i], TW[(2 * j * q) & 255]);
      }
    }
    {
      const int pin = pi + (int)gridDim.x;
      if (pin < 4096) {
        const int Pn = pin & 127, ccn = pin >> 7;
        const int f1n = (Pn == 0) ? (hv ? 128 : 0) : (hv ? 256 - Pn : Pn);
        const int rn = 16 * (f1n & 15) + (f1n >> 4);
        const long gbn = ((long)ccn * 32768 + rn * 128) * 32 + ch;
#pragma unroll
        for (int k = 0; k < 16; ++k) rs[k] = S[gbn + (8 * k + rg) * 32];
      }
    }
    __syncthreads();
    c2f a[2][8];
#pragma unroll
    for (int u = 0; u < 2; ++u) {
      const int q = rg + 8 * u;
#pragma unroll
      for (int j = 0; j < 8; ++j) a[u][j] = XS[(8 * q + j) * 32 + ch];
      dft8<-1>(a[u]);
#pragma unroll
      for (int pp = 0; pp < 8; ++pp) XS[(8 * q + pp) * 32 + ch] = a[u][2 * (pp & 3) + (pp >> 2)];
    }
    __syncthreads();
    c2f m[2][8];
#pragma unroll
    for (int u = 0; u < 2; ++u) {
      const int q = rg + 8 * u;
      const int sbase = (f1 != 0) ? (127 - 8 * q) : ((q > 0) ? (135 - 8 * q) : 8);
      const c2f* xpb = XP + sbase * 32 + ch;
      const c2f bw0 = (f1 == 0 && q == 0) ? XP[ch] : xpb[0];
#pragma unroll
      for (int pp = 0; pp < 8; ++pp) {
        const c2f bw = (pp == 0) ? bw0 : xpb[-32 * pp];
        const c2f aw = a[u][2 * (pp & 3) + (pp >> 2)];
        const c2f bc = (c2f){bw.x, -bw.y};
        const c2f dd = cmul(aw, aw) - cmul(bc, bc);
        m[u][pp] = (c2f){0.25f * dd.y, -0.25f * dd.x};
      }
      dft8<1>(m[u]);
    }
    __syncthreads();
#pragma unroll
    for (int u = 0; u < 2; ++u) {
      const int q = rg + 8 * u;
#pragma unroll
      for (int i = 0; i < 8; ++i) {
        const int j = (i >> 1) + 4 * (i & 1);
        XS[(8 * q + j) * 32 + ch] = cmulc(m[u][i], TW[(2 * q * j) & 255]);
      }
    }
    __syncthreads();
    {
      const int j = rg;
      c2f v[16];
#pragma unroll
      for (int q = 0; q < 16; ++q) v[q] = XS[(8 * q + j) * 32 + ch];
      dft16<1>(v);
      c2f twv[16];
      {
        const c2f st = big_tw(f1, 8);
        twv[0] = big_tw(f1, j);
#pragma unroll
        for (int k = 1; k < 16; ++k) twv[k] = cmul(twv[k - 1], st);
      }
#pragma unroll
      for (int i = 0; i < 16; ++i) {
        const int k = (i >> 2) + 4 * (i & 3);
        const int t2 = 8 * k + j;
        const c2f o = cmulc(v[i], twv[k]);
        S[gbase + t2 * 32] = pk2(o.x, o.y);
      }
    }
  }
}
__device__ __forceinline__ void ph_fft_c(const Params& p, int g, char* ldsc) {
  c2f* X = (c2f*)ldsc;
  c2f* TW = (c2f*)(ldsc + 65536);
  const unsigned* S = (const unsigned*)(p.ws + OFF_S);
  const bf16_t* z = (const bf16_t*)(p.ws + OFF_Z);
  bf16_t* x0 = (bf16_t*)(p.ws + OFF_X0);
  const float* sumsq = (const float*)(p.ws + OFF_SUMSQ);
  const int ch = TID & 31, rg = TID >> 5;
  fft_tw_init(TW);
  unsigned raw[2][16];
  {
    const int it0 = BID;
    const int t20 = it0 & 127, cc0 = it0 >> 7;
#pragma unroll
    for (int u = 0; u < 2; ++u)
#pragma unroll
      for (int pp = 0; pp < 16; ++pp) raw[u][pp] = S[((long)cc0 * 32768 + (16 * (rg + 8 * u) + pp) * 128 + t20) * 32 + ch];
  }
  for (int it = BID; it < 4096; it += GSZ) {
    const int t2 = it & 127, cc = it >> 7;
    const int c = g * 1024 + cc * 32 + ch;
    __syncthreads();
    unsigned short zz[2][8], xx[2][8];
#pragma unroll
    for (int u = 0; u < 2; ++u)
#pragma unroll
      for (int k = 0; k < 8; ++k) {
        const long gi = (long)(128 * (16 * k + rg + 8 * u) + t2) * D + c;
        zz[u][k] = z[gi];
        xx[u][k] = x0[gi];
      }
#pragma unroll
    for (int u = 0; u < 2; ++u) {
      const int q = rg + 8 * u;
      c2f v[16];
#pragma unroll
      for (int pp = 0; pp < 16; ++pp) { const unsigned w_ = raw[u][pp]; v[pp] = mk2(bf2f(w_ & 0xffffu), bf2f(w_ >> 16)); }
      dft16<1>(v);
#pragma unroll
      for (int i = 0; i < 16; ++i) {
        const int j = (i >> 2) + 4 * (i & 3);
        X[(16 * q + j) * 32 + ch] = cmulc(v[i], TW[(q * j) & 255]);
      }
    }
    {
      const int itn = it + GSZ;
      if (itn < 4096) {
        const int t2n = itn & 127, ccn = itn >> 7;
#pragma unroll
        for (int u = 0; u < 2; ++u)
#pragma unroll
          for (int pp = 0; pp < 16; ++pp) raw[u][pp] = S[((long)ccn * 32768 + (16 * (rg + 8 * u) + pp) * 128 + t2n) * 32 + ch];
      }
    }
    __syncthreads();
    const float nrm = rsqrtf(sumsq[c] + 1e-6f) * (1.f / (32768.f * KSCALE));
    const float sk = p.skip[c];
#pragma unroll
    for (int u = 0; u < 2; ++u) {
      const int j = rg + 8 * u;
      c2f v[16];
#pragma unroll
      for (int q = 0; q < 16; ++q) v[q] = X[(16 * q + j) * 32 + ch];
      dft16<1>(v);
#pragma unroll
      for (int i = 0; i < 16; ++i) {
        const int k = (i >> 2) + 4 * (i & 3);
        if (k < 8) {
          const int t1 = 16 * k + j;
          const long gi = (long)(128 * t1 + t2) * D + c;
          const float y = v[i].x * nrm + sk * bf2f(zz[u][k]);
          x0[gi] = f2bf(bf2f(xx[u][k]) * y);
        }
      }
    }
  }
}
__device__ __forceinline__ void ph_gemm_hyo(const Params& p, bf16_t* lds) {
  GEMM_IDS
  const bf16_t* A = (const bf16_t*)(p.ws + OFF_X0);
  const bf16_t* Bt = (const bf16_t*)(p.ws + OFF_WHO);
  bf16_t* ro = (bf16_t*)(p.ws + OFF_RETOUT);
  const bf16_t* gates = (const bf16_t*)(p.ws + OFF_GATES);
  bool primed = false;
  XCD_TILE_LOOP(t, 128 * 16) {
    int tm, tn;
    tile_map(t, 128, 16, tm, tn);
    f32x4 acc[4][4];
    acc_zero(acc);
#if !SKIP_HY
    const bf16_t *nA = nullptr, *nB = nullptr;
    if (t + (int)GSZ < 128 * 16) { int tm2, tn2; tile_map(t + GSZ, 128, 16, tm2, tn2); nA = A + (long)tm2 * 128 * D; nB = Bt + (long)tn2 * 128 * D; }
    gemm_acc<true>(acc, A + (long)tm * 128 * D, D, Bt + (long)tn * 128 * D, D, D, lds, nA, nB, primed);
    primed = nA != nullptr;
#endif
#pragma unroll
    for (int mi = 0; mi < 4; ++mi) {
      const int m = tm * 128 + 64 * wm + 16 * mi + l15;
#pragma unroll
      for (int ni = 0; ni < 4; ++ni) {
        const int n = tn * 128 + 64 * wn + 16 * ni + 4 * l4;
        const u32x2 r0 = *(const u32x2*)(ro + (long)m * D + n);
        const u32x2 g0 = *(const u32x2*)(gates + (long)m * 4096 + n);
        const u32x2 g1 = *(const u32x2*)(gates + (long)m * 4096 + 2048 + n);
        f32x4 o;
        o[0] = bf2f(g0.x & 0xffffu) * bf2f(r0.x & 0xffffu) + bf2f(g1.x & 0xffffu) * acc[mi][ni][0];
        o[1] = bf2f(g0.x >> 16) * bf2f(r0.x >> 16) + bf2f(g1.x >> 16) * acc[mi][ni][1];
        o[2] = bf2f(g0.y & 0xffffu) * bf2f(r0.y & 0xffffu) + bf2f(g1.y & 0xffffu) * acc[mi][ni][2];
        o[3] = bf2f(g0.y >> 16) * bf2f(r0.y >> 16) + bf2f(g1.y >> 16) * acc[mi][ni][3];
        *(u32x2*)(ro + (long)m * D + n) = pk4(o);
      }
    }
  }
}
__device__ __forceinline__ void ph_gemm_wout(const Params& p, bf16_t* lds) {
  GEMM_IDS
  const bf16_t* A = (const bf16_t*)(p.ws + OFF_RETOUT);
  const bf16_t* Bt = (const bf16_t*)(p.ws + OFF_WOUT);
  const float* gate = (const float*)(p.ws + OFF_MODS) + 5 * D;
  bool primed = false;
  XCD_TILE_LOOP(t, 128 * 16) {
    int tm, tn;
    tile_map(t, 128, 16, tm, tn);
    f32x4 acc[4][4];
    acc_zero(acc);
    const bf16_t *nA = nullptr, *nB = nullptr;
    if (t + (int)GSZ < 128 * 16) { int tm2, tn2; tile_map(t + GSZ, 128, 16, tm2, tn2); nA = A + (long)tm2 * 128 * D; nB = Bt + (long)tn2 * 128 * D; }
    gemm_acc<true>(acc, A + (long)tm * 128 * D, D, Bt + (long)tn * 128 * D, D, D, lds, nA, nB, primed);
    primed = nA != nullptr;
#pragma unroll
    for (int mi = 0; mi < 4; ++mi) {
      const int m = tm * 128 + 64 * wm + 16 * mi + l15;
#pragma unroll
      for (int ni = 0; ni < 4; ++ni) {
        const int n = tn * 128 + 64 * wn + 16 * ni + 4 * l4;
        float* op = p.out + (long)m * D + n;
        const f32x4 gt = *(const f32x4*)(gate + n);
        const f32x4 rs = *(const f32x4*)(op);
        *(f32x4*)(op) = rs + gt * acc[mi][ni];
      }
    }
  }
}


#define EPI_HEAD static constexpr bool PERM = false, AFTER_DRAIN = false;
typedef const f32x4 (&acc8_t)[2][2][4][2];
struct EpiSwiglu {
  EPI_HEAD
  bf16_t* H;
  __device__ __forceinline__ void operator()(acc8_t acc, const pg8::Unit& u, int wr, int wc, int fr, int fq) const {
#pragma unroll
    for (int ai = 0; ai < 2; ++ai)
#pragma unroll
      for (int m = 0; m < 4; ++m) {
        const int row = u.pm * 256 + ai * 128 + wr * 64 + m * 16 + fr;
#pragma unroll
        for (int n = 0; n < 2; ++n) {
          f32x4 o;
#pragma unroll
          for (int j = 0; j < 4; ++j) o[j] = silu_f(acc[ai][0][m][n][j]) * acc[ai][1][m][n][j];
          *(u32x2*)(H + (long)row * DFF + u.pn * 128 + wc * 32 + n * 16 + fq * 4) = pk4(o);
        }
      }
  }
};
struct EpiDown {
  EPI_HEAD
  const float* res; float* out; const float* gate;
  __device__ __forceinline__ void operator()(acc8_t acc, const pg8::Unit& u, int wr, int wc, int fr, int fq) const {
#pragma unroll
    for (int ai = 0; ai < 2; ++ai)
#pragma unroll
      for (int m = 0; m < 4; ++m) {
        const long ro = (long)(u.pm * 256 + ai * 128 + wr * 64 + m * 16 + fr) * D;
#pragma unroll
        for (int bj = 0; bj < 2; ++bj)
#pragma unroll
          for (int n = 0; n < 2; ++n) {
            const int col = u.pn * 256 + bj * 128 + wc * 32 + n * 16 + fq * 4;
            const f32x4 gt = *(const f32x4*)(gate + col);
            const f32x4 rs = *(const f32x4*)(res + ro + col);
            *(f32x4*)(out + ro + col) = rs + 0.5f * gt * acc[ai][bj][m][n];
          }
      }
  }
};
struct EpiPlain {
  EPI_HEAD
  bf16_t* C; int ldc;
  __device__ __forceinline__ void operator()(acc8_t acc, const pg8::Unit& u, int wr, int wc, int fr, int fq) const {
#pragma unroll
    for (int ai = 0; ai < 2; ++ai)
#pragma unroll
      for (int m = 0; m < 4; ++m) {
        const long ro = (long)(u.pm * 256 + ai * 128 + wr * 64 + m * 16 + fr) * ldc;
#pragma unroll
        for (int bj = 0; bj < 2; ++bj)
#pragma unroll
          for (int n = 0; n < 2; ++n) {
            const int col = u.pn * 256 + bj * 128 + wc * 32 + n * 16 + fq * 4;
            *(u32x2*)(C + ro + col) = pk4(acc[ai][bj][m][n]);
          }
      }
  }
};
struct EpiHyo {
  EPI_HEAD
  bf16_t* ro; const bf16_t* gates;
  __device__ __forceinline__ void operator()(acc8_t acc, const pg8::Unit& u, int wr, int wc, int fr, int fq) const {
#pragma unroll
    for (int ai = 0; ai < 2; ++ai)
#pragma unroll
      for (int m = 0; m < 4; ++m) {
        const long row = u.pm * 256 + ai * 128 + wr * 64 + m * 16 + fr;
#pragma unroll
        for (int bj = 0; bj < 2; ++bj)
#pragma unroll
          for (int n = 0; n < 2; ++n) {
            const int col = u.pn * 256 + bj * 128 + wc * 32 + n * 16 + fq * 4;
            const u32x2 r0 = *(const u32x2*)(ro + row * D + col);
            const u32x2 g0 = *(const u32x2*)(gates + row * 4096 + col);
            const u32x2 g1 = *(const u32x2*)(gates + row * 4096 + 2048 + col);
            const f32x4 a = acc[ai][bj][m][n];
            f32x4 o;
            o[0] = bf2f(g0.x & 0xffffu) * bf2f(r0.x & 0xffffu) + bf2f(g1.x & 0xffffu) * a[0];
            o[1] = bf2f(g0.x >> 16) * bf2f(r0.x >> 16) + bf2f(g1.x >> 16) * a[1];
            o[2] = bf2f(g0.y & 0xffffu) * bf2f(r0.y & 0xffffu) + bf2f(g1.y & 0xffffu) * a[2];
            o[3] = bf2f(g0.y >> 16) * bf2f(r0.y >> 16) + bf2f(g1.y >> 16) * a[3];
            *(u32x2*)(ro + row * D + col) = pk4(o);
          }
      }
  }
};
struct EpiWout {
  EPI_HEAD
  float* out; const float* gate;
  __device__ __forceinline__ void operator()(acc8_t acc, const pg8::Unit& u, int wr, int wc, int fr, int fq) const {
#pragma unroll
    for (int ai = 0; ai < 2; ++ai)
#pragma unroll
      for (int m = 0; m < 4; ++m) {
        const long ro = (long)(u.pm * 256 + ai * 128 + wr * 64 + m * 16 + fr) * D;
#pragma unroll
        for (int bj = 0; bj < 2; ++bj)
#pragma unroll
          for (int n = 0; n < 2; ++n) {
            const int col = u.pn * 256 + bj * 128 + wc * 32 + n * 16 + fq * 4;
            const f32x4 gt = *(const f32x4*)(gate + col);
            const f32x4 rs = *(const f32x4*)(out + ro + col);
            *(f32x4*)(out + ro + col) = rs + gt * acc[ai][bj][m][n];
          }
      }
  }
};
struct EpiWinA {
  EPI_HEAD
  bf16_t *q, *kk, *kTf, *kTb, *vT, *sg; const float2* rope; const float* lg;
  __device__ __forceinline__ void operator()(acc8_t acc, const pg8::Unit& u, int wr, int wc, int fr, int fq) const {
    const int pn = u.pn;
    if (pn < 8) {
      const bool isq = pn < 4;
      const int hh = wc >> 1, hf = wc & 1;
      const int head = 2 * (isq ? pn : pn - 4) + hh;
      const float scl = isq ? 0.08838834764831845f : 1.f;
      const float lgf = lg[head], lgb = lg[8 + head];
#pragma unroll
      for (int ai = 0; ai < 2; ++ai)
#pragma unroll
        for (int m = 0; m < 4; ++m) {
          const int t = u.pm * 256 + ai * 128 + wr * 64 + m * 16 + fr;
          const int pos = hf ? (t & 63) : (t >> 6);
          const int jc = t & 127;
          const float zf = __expf(lgf * (float)(127 - jc)), zb = __expf(lgb * (float)jc);
#pragma unroll
          for (int n = 0; n < 2; ++n) {
            const int i0 = 16 * n + 4 * fq;
            f32x4 o1, o2;
#pragma unroll
            for (int j = 0; j < 4; ++j) {
              const float2 cs = rope[pos * 32 + i0 + j];
              const float x1 = acc[ai][0][m][n][j] * scl, x2 = acc[ai][1][m][n][j] * scl;
              o1[j] = x1 * cs.x - x2 * cs.y;
              o2[j] = x1 * cs.y + x2 * cs.x;
            }
            const int cb = head * 128 + hf * 64 + i0;
            bf16_t* dp = (isq ? q : kk) + (long)t * 1024 + cb;
            *(u32x2*)(dp) = pk4(o1);
            *(u32x2*)(dp + 32) = pk4(o2);
            if (!isq) {
#pragma unroll
              for (int j = 0; j < 4; ++j) {
                kTf[(long)(cb + j) * TT + t] = f2bf(o1[j] * zf);
                kTb[(long)(cb + j) * TT + t] = f2bf(o1[j] * zb);
                kTf[(long)(cb + 32 + j) * TT + t] = f2bf(o2[j] * zf);
                kTb[(long)(cb + 32 + j) * TT + t] = f2bf(o2[j] * zb);
              }
            }
          }
        }
    } else if (pn < 16) {
#pragma unroll
      for (int ai = 0; ai < 2; ++ai)
#pragma unroll
        for (int m = 0; m < 4; ++m) {
          const int t = u.pm * 256 + ai * 128 + wr * 64 + m * 16 + fr;
#pragma unroll
          for (int bj = 0; bj < 2; ++bj)
#pragma unroll
            for (int n = 0; n < 2; ++n) {
              const int ch = (pn - 8) * 256 + bj * 128 + wc * 32 + n * 16 + fq * 4;
#pragma unroll
              for (int j = 0; j < 4; ++j) vT[(long)(ch + j) * TT + t] = f2bf(acc[ai][bj][m][n][j]);
            }
        }
    } else {
#pragma unroll
      for (int ai = 0; ai < 2; ++ai)
#pragma unroll
        for (int m = 0; m < 4; ++m) {
          const long t = u.pm * 256 + ai * 128 + wr * 64 + m * 16 + fr;
#pragma unroll
          for (int bj = 0; bj < 2; ++bj)
#pragma unroll
            for (int n = 0; n < 2; ++n) {
              const int col = (pn - 16) * 256 + bj * 128 + wc * 32 + n * 16 + fq * 4;
              f32x4 o;
#pragma unroll
              for (int j = 0; j < 4; ++j) o[j] = silu_f(acc[ai][bj][m][n][j]);
              *(u32x2*)(sg + t * D + col) = pk4(o);
            }
        }
    }
  }
};
struct EpiWinB {
  EPI_HEAD
  bf16_t *phy, *gates;
  __device__ __forceinline__ void operator()(acc8_t acc, const pg8::Unit& u, int wr, int wc, int fr, int fq) const {
    const int pn = u.pn;
#pragma unroll
    for (int ai = 0; ai < 2; ++ai)
#pragma unroll
      for (int m = 0; m < 4; ++m) {
        const long t = u.pm * 256 + ai * 128 + wr * 64 + m * 16 + fr;
#pragma unroll
        for (int bj = 0; bj < 2; ++bj)
#pragma unroll
          for (int n = 0; n < 2; ++n) {
            const int cl = bj * 128 + wc * 32 + n * 16 + fq * 4;
            if (pn < 48) {
              *(u32x2*)(phy + t * 6144 + (pn - 24) * 256 + cl) = pk4(acc[ai][bj][m][n]);
            } else {
              f32x4 o;
#pragma unroll
              for (int j = 0; j < 4; ++j) o[j] = sigm_f(acc[ai][bj][m][n][j]);
              *(u32x2*)(gates + t * 4096 + (pn - 48) * 256 + cl) = pk4(o);
            }
          }
      }
  }
};
template <class Epi>
__device__ __forceinline__ void big_gemm(char* lds_all, const bf16_t* A, const bf16_t* Bt, int K, int nM, int nN, int pn0, const Epi& E) {
  pg8::Gemm g;
  g.A = A; g.Bt = Bt; g.M = nM * 256; g.N = 0; g.K = K;
  pg8::TileOrder S;
  S.init(nM, nN, pn0, (int)gridDim.x, (int)blockIdx.x);
  pg8::gemm_phase(( __attribute__((address_space(3))) unsigned char*)lds_all, g, S, E);
}

__device__ __forceinline__ void ph_ctx_up(const Params& p, char* lds_all) {
  GEMM_IDS
  const int hv = fresh_tid() >> 8;
  bf16_t* lds = (bf16_t*)(lds_all + hv * LDS_HALF);
  u32x2* xch = (u32x2*)lds_all;
  const bf16_t* A = (const bf16_t*)(p.ws + OFF_AR) + (long)T * D;
  const bf16_t* Bt = (const bf16_t*)(p.ws + OFF_WBIG);
  bf16_t* H = (bf16_t*)(p.ws + OFF_H);
  for (int it = (int)blockIdx.x; it < 88; it += (int)gridDim.x) {
    const int tmc = it / 44, P = it % 44;
    f32x4 acc[4][4];
    acc_zero(acc);
    gemm_acc<true>(acc, A + (long)tmc * 128 * D, D, Bt + (long)(256 * P + 128 * hv) * D, D, D, lds);
    if (hv == 0) {
#pragma unroll
      for (int mi = 0; mi < 4; ++mi)
#pragma unroll
        for (int ni = 0; ni < 4; ++ni) {
          f32x4 o;
#pragma unroll
          for (int r = 0; r < 4; ++r) o[r] = silu_f(acc[mi][ni][r]);
          xch[(mi * 4 + ni) * 256 + TID] = pk4(o);
        }
    }
    __syncthreads();
    if (hv == 1) {
#pragma unroll
      for (int mi = 0; mi < 4; ++mi) {
        const int m = T + tmc * 128 + 64 * wm + 16 * mi + l15;
#pragma unroll
        for (int ni = 0; ni < 4; ++ni) {
          const int n = 128 * P + 64 * wn + 16 * ni + 4 * l4;
          const u32x2 w = xch[(mi * 4 + ni) * 256 + TID];
          f32x4 o;
          o[0] = bf2f(w.x & 0xffffu) * acc[mi][ni][0];
          o[1] = bf2f(w.x >> 16) * acc[mi][ni][1];
          o[2] = bf2f(w.y & 0xffffu) * acc[mi][ni][2];
          o[3] = bf2f(w.y >> 16) * acc[mi][ni][3];
          *(u32x2*)(H + (long)m * DFF + n) = pk4(o);
        }
      }
    }
  }
}
__device__ __forceinline__ void ph_ctx_down(const Params& p, bf16_t* lds) {
  GEMM_IDS
  const bf16_t* A = (const bf16_t*)(p.ws + OFF_H) + (long)T * DFF;
  const bf16_t* Bt = (const bf16_t*)(p.ws + OFF_WDOWN);
  const float* gate = (const float*)(p.ws + OFF_MODS) + NMOD + 2 * D;
  float* outc = (float*)(p.ws + OFF_CTX1);
  for (int it = BID; it < 128; it += GSZ) {
    const int ks = it & 3, tn = (it >> 2) & 15, tmc = it >> 6;
    f32x4 acc[4][4];
    acc_zero(acc);
    gemm_acc<true>(acc, A + (long)tmc * 128 * DFF + ks * 1408, DFF, Bt + (long)tn * 128 * DFF + ks * 1408, DFF, 1408, lds);
#pragma unroll
    for (int mi = 0; mi < 4; ++mi) {
      const int m = tmc * 128 + 64 * wm + 16 * mi + l15;
#pragma unroll
      for (int ni = 0; ni < 4; ++ni) {
        const int n = tn * 128 + 64 * wn + 16 * ni + 4 * l4;
        const f32x4 gt = *(const f32x4*)(gate + n);
#pragma unroll
        for (int r = 0; r < 4; ++r) atomicAdd(outc + (long)m * D + n + r, 0.5f * gt[r] * acc[mi][ni][r]);
      }
    }
  }
}
__device__ __forceinline__ void ph_ctx1_init(const Params& p) {
  f32x4* o = (f32x4*)(p.ws + OFF_CTX1);
  const f32x4* src = (const f32x4*)p.ctx;
  for (int i = BID * 256 + TID; i < 256 * D / 4; i += GSZ * 256) o[i] = src[i];
}
__device__ __forceinline__ void ph_ctx_win(const Params& p, char* lds_all) {
  GEMM_IDS
  const int hv = fresh_tid() >> 8;
  bf16_t* lds = (bf16_t*)(lds_all + hv * LDS_HALF);
  float* xacc = (float*)(lds_all + LDS_HALF);
  const bf16_t* A = (const bf16_t*)(p.ws + OFF_AR) + (long)T * D + hv * 1024;
  const bf16_t* Bt = (const bf16_t*)(p.ws + OFF_WBIG) + hv * 1024;
  bf16_t* kTf = (bf16_t*)(p.ws + OFF_KTF);
  bf16_t* kTb = (bf16_t*)(p.ws + OFF_KTB);
  bf16_t* vT = (bf16_t*)(p.ws + OFF_VT);
  for (int it = (int)blockIdx.x; it < 48; it += (int)gridDim.x) {
    f32x4 acc[4][4];
    acc_zero(acc);
    const bool isk = it < 16;
    const int u2 = it - 16;
    const int tmc = isk ? (it >> 3) : (u2 >> 4);
    const int kt8 = it & 7, tv = u2 & 15;
    if (isk)
      gemm_acc<true>(acc, A + (long)tmc * 128 * D, D, Bt + (long)(1024 + kt8 * 128) * D, D, 1024, lds);
    else
      gemm_acc<false>(acc, A + (long)tmc * 128 * D, D, Bt + (long)(2048 + tv * 128) * D, D, 1024, lds);
    if (hv == 1) {
#pragma unroll
      for (int mi = 0; mi < 4; ++mi)
#pragma unroll
        for (int ni = 0; ni < 4; ++ni) *(f32x4*)(xacc + ((mi * 4 + ni) * 256 + TID) * 4) = acc[mi][ni];
    }
    __syncthreads();
    if (hv == 0) {
#pragma unroll
      for (int mi = 0; mi < 4; ++mi)
#pragma unroll
        for (int ni = 0; ni < 4; ++ni) acc[mi][ni] += *(const f32x4*)(xacc + ((mi * 4 + ni) * 256 + TID) * 4);
      if (isk) {
        const int P = kt8 >> 1, sx = kt8 & 1;
        const int head = 2 * P + wn;
        const float lgf = p.lg[head], lgb = p.lg[8 + head];
#pragma unroll
        for (int mi = 0; mi < 4; ++mi) {
          const int m = T + tmc * 128 + 64 * wm + 16 * mi + l15;
          const int jc = m & 127;
          const float zf = __expf(lgf * (float)(127 - jc)), zb = __expf(lgb * (float)jc);
#pragma unroll
          for (int ni = 0; ni < 4; ++ni) {
            const int hf = ni >> 1, i0 = 16 * (ni & 1) + 4 * l4;
            const int cb = head * 128 + hf * 64 + i0 + 32 * sx;
#pragma unroll
            for (int r = 0; r < 4; ++r) {
              kTf[(long)(cb + r) * TT + m] = f2bf(acc[mi][ni][r] * zf);
              kTb[(long)(cb + r) * TT + m] = f2bf(acc[mi][ni][r] * zb);
            }
          }
        }
      } else {
#pragma unroll
        for (int mi = 0; mi < 4; ++mi) {
          const int m0 = T + tmc * 128 + 64 * wm + 16 * mi + 4 * l4;
#pragma unroll
          for (int ni = 0; ni < 4; ++ni) {
            const int ch = tv * 128 + 64 * wn + 16 * ni + l15;
            *(u32x2*)(vT + (long)ch * TT + m0) = pk4(acc[mi][ni]);
          }
        }
      }
    }
  }
}

#define XB_TMO      128
#define XB_XCNT(j)  (256  + 64 * (j))
#define XB_XSUB(j)  (1280 + 64 * (j))
#define XB_XGEN(j)  (2304 + 64 * (j))
#define XB_TOP      3328
#define XB_TOPGEN   3392
#define XCD_BAR_WORDS 3456
#define XB_SPIN_CAP (1u << 18)
#define LAS __attribute__((address_space(3)))

__device__ __forceinline__ unsigned xb_ld(unsigned* p)              { return __hip_atomic_load(p, __ATOMIC_RELAXED, __HIP_MEMORY_SCOPE_AGENT); }
__device__ __forceinline__ unsigned xb_add(unsigned* p, unsigned v) { return __hip_atomic_fetch_add(p, v, __ATOMIC_RELAXED, __HIP_MEMORY_SCOPE_AGENT); }
__device__ __forceinline__ unsigned xb_xcc_id() { return (unsigned)__builtin_amdgcn_s_getreg((3 << 11) | 20) & 0xFu; }
#define XB_SPIN(cond, bar) do { unsigned _sp = 0; while (cond) { __builtin_amdgcn_s_sleep(1); \
    if ((++_sp & 255u) == 0u) { if (xb_ld(&(bar)[XB_TMO])) break; if (_sp > XB_SPIN_CAP) { atomicAdd(&(bar)[XB_TMO], 1u); break; } } } } while (0)

struct XcdBarrier {
    unsigned* bar; unsigned x;
    volatile LAS unsigned* st;
};

__device__ __forceinline__ XcdBarrier xcd_barrier_post(unsigned* bar, volatile LAS unsigned* st) {
    XcdBarrier b; b.bar = bar; b.x = xb_xcc_id(); b.st = st;
    if (threadIdx.x == 0) (void)xb_add(&bar[XB_XCNT(b.x)], 1u);
    return b;
}
__device__ __forceinline__ void xcd_barrier_complete(unsigned* bar, unsigned x, unsigned& nloc, unsigned& nx) {
    const unsigned G = gridDim.x * gridDim.y * gridDim.z;
    unsigned sum, cnt, mine, sp = 0u;
    for (;;) {
        sum = 0u; cnt = 0u; mine = 0u;
#pragma unroll
        for (unsigned j = 0; j < 16; ++j) { const unsigned c = xb_ld(&bar[XB_XCNT(j)]); sum += c; cnt += (c > 0u) ? 1u : 0u; mine = (j == x) ? c : mine; }
        if (sum == G) break;
        __builtin_amdgcn_s_sleep(1);
        if ((++sp & 255u) == 0u) { if (xb_ld(&bar[XB_TMO])) break; if (sp > XB_SPIN_CAP) { atomicAdd(&bar[XB_TMO], 1u); break; } }
    }
    nloc = mine > 0u ? mine : 1u; nx = cnt > 0u ? cnt : 1u;
}

__device__ __forceinline__ void xcd_barrier(const XcdBarrier& b) {
    asm volatile("s_waitcnt vmcnt(0)" ::: "memory");
    __syncthreads();
    if (threadIdx.x == 0) {
        unsigned* bar = b.bar;
        __builtin_amdgcn_s_waitcnt(0);
        unsigned nloc = b.st[0], nx = b.st[1];
        if (nloc == 0u) { xcd_barrier_complete(bar, b.x, nloc, nx); b.st[0] = nloc; b.st[1] = nx; }
        const unsigned old = xb_add(&bar[XB_XSUB(b.x)], 1u);
        const unsigned gen = old / nloc;
        if (old + 1u == (gen + 1u) * nloc) {
            __builtin_amdgcn_fence(__ATOMIC_RELEASE, "agent");
            asm volatile("s_waitcnt vmcnt(0)" ::: "memory");
            const unsigned og = xb_add(&bar[XB_TOP], 1u);
            const unsigned tg = og / nx;
            if (og + 1u == (tg + 1u) * nx) xb_add(&bar[XB_TOPGEN], 1u);
            else XB_SPIN(xb_ld(&bar[XB_TOPGEN]) == tg, bar);
            __builtin_amdgcn_fence(__ATOMIC_ACQUIRE, "agent");
            xb_add(&bar[XB_XGEN(b.x)], 1u);
            asm volatile("s_waitcnt vmcnt(0)" ::: "memory");
        } else {
            XB_SPIN(xb_ld(&bar[XB_XGEN(b.x)]) == gen, bar);
            __builtin_amdgcn_fence(__ATOMIC_ACQUIRE, "agent");
            asm volatile("s_waitcnt vmcnt(0)" ::: "memory");
        }
    }
    __syncthreads();
}


__device__ __forceinline__ void gbar(unsigned* ctr, unsigned target) {
  asm volatile("s_waitcnt vmcnt(0) lgkmcnt(0)" ::: "memory");
  __syncthreads();
  if (threadIdx.x == 0) {
    __builtin_amdgcn_fence(__ATOMIC_RELEASE, "agent");
    asm volatile("s_waitcnt vmcnt(0)" ::: "memory");
    __hip_atomic_fetch_add(ctr, 1u, __ATOMIC_RELAXED, __HIP_MEMORY_SCOPE_AGENT);
    unsigned spins = 0;
    while (__hip_atomic_load(ctr, __ATOMIC_RELAXED, __HIP_MEMORY_SCOPE_AGENT) < target) {
      __builtin_amdgcn_s_sleep(2);
      if (++spins > (1u << 20)) break;
    }
    __builtin_amdgcn_fence(__ATOMIC_ACQUIRE, "agent");
    asm volatile("s_waitcnt vmcnt(0)" ::: "memory");
  }
  __syncthreads();
}
#ifndef SKIP_HY
#define SKIP_HY 0
#endif
#ifndef ONLY_NORM
#define ONLY_NORM 0
#endif
#ifndef SKIP_MIXER
#define SKIP_MIXER 0
#endif

__global__ void __launch_bounds__(512, 2) mega(Params p, int lo, int hi) {
  __shared__ __attribute__((aligned(1024))) char ldsc_all[LDS_BYTES];
#define ldsc (ldsc_all + (fresh_tid() >> 8) * LDS_HALF)
  cg::grid_group grid = cg::this_grid();
#define lds ((bf16_t*)ldsc)
#define ldsf ((float*)ldsc)
  char* ws = p.ws;
  volatile LAS unsigned* xb_st = (volatile LAS unsigned*)(ldsc_all + LDS_BYTES - 16);
  if (threadIdx.x == 0) { xb_st[0] = 0u; xb_st[1] = 0u; }
  __syncthreads();
  const XcdBarrier xb = xcd_barrier_post((unsigned*)(ws + OFF_BAR), xb_st);
#define PH(k, body) if (lo <= (k) && (k) < hi) { body; if ((k) + 1 < hi) xcd_barrier(xb); }
  if (lo < 0) grid.sync();
  PH(0, ph_mods_partial(p, ldsf))
  PH(2, ph_prenorm(p, p.x, p.ctx, TT, p.norm_g, 0);
        conv_weight(p.ffn_up, 2048, 11264, 11264, (bf16_t*)(ws + OFF_WBIG), 2, ldsf);
        conv_weight(p.ffn_down, 5632, 2048, 2048, (bf16_t*)(ws + OFF_WDOWN), 0, ldsf);
        conv_weight(p.w4, 64, 4096, 4096, (bf16_t*)(ws + OFF_W4T), 0, ldsf);
        conv_weight(p.w_ret_o, 2048, 2048, 2048, (bf16_t*)(ws + OFF_WRO), 0, ldsf);
        conv_weight(p.w_hy_o, 2048, 2048, 2048, (bf16_t*)(ws + OFF_WHO), 0, ldsf);
        conv_weight(p.w_out, 2048, 2048, 2048, (bf16_t*)(ws + OFF_WOUT), 0, ldsf);
        ph_misc0(p))
  PH(3, big_gemm(ldsc_all, (const bf16_t*)(ws + OFF_AR), (const bf16_t*)(ws + OFF_WBIG), 2048, 64, 44, 0, EpiSwiglu{(bf16_t*)(ws + OFF_H)});
        ph_ctx_up(p, ldsc_all); ph_ctx1_init(p))
  PH(4, big_gemm(ldsc_all, (const bf16_t*)(ws + OFF_H), (const bf16_t*)(ws + OFF_WDOWN), 5632, 64, 8, 0, EpiDown{p.x, p.out, (const float*)(ws + OFF_MODS) + 2 * D});
        ph_ctx_down(p, lds))
  PH(5, ph_prenorm(p, p.out, (const float*)(ws + OFF_CTX1), TT, p.norm_g + D, 1);
        conv_weight(p.w_in, 2048, 16384, 16384, (bf16_t*)(ws + OFF_WBIG), 3, ldsf))
#if !SKIP_MIXER
  PH(6, big_gemm(ldsc_all, (const bf16_t*)(ws + OFF_AR), (const bf16_t*)(ws + OFF_WBIG), 2048, 64, 24, 0,
                 EpiWinA{(bf16_t*)(ws + OFF_Q), (bf16_t*)(ws + OFF_K), (bf16_t*)(ws + OFF_KTF), (bf16_t*)(ws + OFF_KTB), (bf16_t*)(ws + OFF_VT), (bf16_t*)(ws + OFF_SG), (const float2*)(ws + OFF_ROPE), p.lg});
        ph_ctx_win(p, ldsc_all))
  PH(7, ph_ret_kv_p(p, lds))
  PH(8, ph_ret_scan(p))
  PH(9, ph_ret_out(p, ldsc_all))
  PH(11, big_gemm(ldsc_all, (const bf16_t*)(ws + OFF_Y), (const bf16_t*)(ws + OFF_WRO), 2048, 64, 8, 0, EpiPlain{(bf16_t*)(ws + OFF_RETOUT), D}))
  PH(12, big_gemm(ldsc_all, (const bf16_t*)(ws + OFF_AR), (const bf16_t*)(ws + OFF_WBIG), 2048, 64, 40, 24, EpiWinB{(bf16_t*)(ws + OFF_PHY), (bf16_t*)(ws + OFF_GATES)}))
#if !SKIP_HY
  PH(13, ph_hy_conv(p); ph_taps(p, 0, lds); ph_taps(p, 1, lds))
#endif
#if !SKIP_HY
  PH(15, ph_fft_a(p, 0, ldsc))
  PH(16, ph_fft_mid(p, ldsc_all))
  PH(17, ph_fft_c(p, 0, ldsc))
  PH(19, ph_fft_a(p, 1, ldsc))
  PH(20, ph_fft_mid(p, ldsc_all))
  PH(21, ph_fft_c(p, 1, ldsc))
#endif
  PH(26, big_gemm(ldsc_all, (const bf16_t*)(ws + OFF_X0), (const bf16_t*)(ws + OFF_WHO), 2048, 64, 8, 0, EpiHyo{(bf16_t*)(ws + OFF_RETOUT), (const bf16_t*)(ws + OFF_GATES)}))
  PH(27, big_gemm(ldsc_all, (const bf16_t*)(ws + OFF_RETOUT), (const bf16_t*)(ws + OFF_WOUT), 2048, 64, 8, 0, EpiWout{p.out, (const float*)(ws + OFF_MODS) + 5 * D}))
#endif
  PH(28, ph_prenorm(p, p.out, p.out, T, p.norm_g + 2 * D, 2);
         conv_weight(p.ffn_up + (long)2048 * 11264, 2048, 11264, 11264, (bf16_t*)(ws + OFF_WBIG), 2, ldsf);
         conv_weight(p.ffn_down + (long)5632 * 2048, 5632, 2048, 2048, (bf16_t*)(ws + OFF_WDOWN), 0, ldsf))
  PH(29, big_gemm(ldsc_all, (const bf16_t*)(ws + OFF_AR), (const bf16_t*)(ws + OFF_WBIG), 2048, 64, 44, 0, EpiSwiglu{(bf16_t*)(ws + OFF_H)}))
  PH(30, big_gemm(ldsc_all, (const bf16_t*)(ws + OFF_H), (const bf16_t*)(ws + OFF_WDOWN), 5632, 64, 8, 0, EpiDown{p.out, p.out, (const float*)(ws + OFF_MODS) + 8 * D}))
  PH(31, ph_final_norm(p))
}

extern "C" void kernel_launch(void* const* d_in, const int* in_sizes, int n_in, void* d_out, int out_size, void* d_ws,
                              size_t ws_size, hipStream_t stream) {
  if (ws_size < (size_t)WS_NEED || n_in < 29) {
    fprintf(stderr, "workspace too small: %zu\n", ws_size);
    return;
  }
  static int grid_blocks = 0;
  if (!grid_blocks) {
    int dev = 0, cus = 0, per_cu = 0;
    hipGetDevice(&dev);
    hipDeviceGetAttribute(&cus, hipDeviceAttributeMultiprocessorCount, dev);
    hipOccupancyMaxActiveBlocksPerMultiprocessor(&per_cu, mega, 512, 0);
    if (per_cu > 1) per_cu = 1;
    if (per_cu < 1) per_cu = 1;
    grid_blocks = cus * per_cu;
  }
  Params p{};
  const float** pp = (const float**)&p;
  for (int i = 0; i < 29; ++i) pp[i] = (const float*)d_in[i];
  p.out = (float*)d_out;
  p.ws = (char*)d_ws;
  hipMemsetAsync((char*)d_ws + OFF_BAR, 0, XCD_BAR_WORDS * 4, stream);
  hipMemsetAsync((char*)d_ws + OFF_MODS, 0, 2 * NMOD * 4, stream);
  int lo = 0, hi = NPH;
  void* args[] = {&p, &lo, &hi};
  hipError_t e = hipLaunchCooperativeKernel((void*)mega, dim3(grid_blocks), dim3(512), args, 0, stream);
  if (e != hipSuccess) fprintf(stderr, "cooperative launch failed: %s (grid %d)\n", hipGetErrorString(e), grid_blocks);
}
```

```cpp
#include <hip/hip_runtime.h>
#include <hip/hip_cooperative_groups.h>
#include <cstdio>
namespace cg = cooperative_groups;

typedef unsigned short bf16_t;
typedef short bf16x8 __attribute__((ext_vector_type(8)));
typedef float f32x4 __attribute__((ext_vector_type(4)));
typedef unsigned u32x2 __attribute__((ext_vector_type(2)));
typedef unsigned u32x4 __attribute__((ext_vector_type(4)));

__device__ __forceinline__ int fresh_tid() { int t = (int)threadIdx.x; asm volatile("" : "+v"(t)); return t; }
#define TID (fresh_tid() & 255)
#define BID ((int)(blockIdx.x * 2u) + (fresh_tid() >> 8))
#define GSZ ((int)(gridDim.x * 2u))
constexpr int T = 16384, TT = 16640, D = 2048, DFF = 5632;
constexpr long MiB = 1l << 20;
constexpr int NMOD = 18432;
constexpr long OFF_MODSPART = 0;
constexpr long OFF_MODS = 5 * MiB;
constexpr long OFF_SUMSQ = 5 * MiB + 512 * 1024;
constexpr long OFF_ROPE = 6 * MiB;
constexpr long OFF_BAR = 5 * MiB + 768 * 1024;
constexpr long OFF_CTX1 = 7 * MiB;
constexpr long OFF_H3B = 13 * MiB, OFF_W4T = 15 * MiB;
constexpr long OFF_TAPS = 104 * MiB, OFF_TAPS1 = 40 * MiB;
constexpr long OFF_WRO = 16 * MiB, OFF_WHO = 24 * MiB, OFF_WOUT = 32 * MiB;
constexpr long OFF_WBIG = 40 * MiB, OFF_WDOWN = 84 * MiB;
constexpr long OFF_AR = 106 * MiB;
constexpr long OFF_H = 171 * MiB;
constexpr long OFF_Q = 171 * MiB, OFF_K = 203 * MiB, OFF_KTF = 235 * MiB, OFF_KTB = 268 * MiB, OFF_VT = 301 * MiB,
               OFF_SG = 366 * MiB, OFF_KVT = 430 * MiB, OFF_P = 560 * MiB, OFF_Y = 592 * MiB;
constexpr long OFF_RETOUT = 171 * MiB, OFF_GATES = 235 * MiB, OFF_X0 = 363 * MiB, OFF_Z = 427 * MiB, OFF_PHY = 491 * MiB;
constexpr long OFF_S = 491 * MiB, OFF_KC = 40 * MiB;
constexpr long WS_NEED = 683 * MiB;
constexpr int LDS_HALF = 69632;
constexpr int LDS_BYTES = 2 * LDS_HALF;
constexpr int NPH = 32;
#ifndef SKIP_HY
#define SKIP_HY 0
#endif

struct Params {
  const float *x, *c, *ctx, *c_ctx, *w_ada, *b_ada, *norm_g, *ffn_up, *ffn_down, *w_in, *lg, *gn_g, *gn_b, *w_ret_o,
      *conv_w, *conv_b, *w1, *b1, *w2, *b2, *w3, *b3, *w4, *freq, *decay, *skip, *w_hy_o, *w_out, *fin_g;
  float* out;
  char* ws;
};

__device__ __forceinline__ float bf2f(unsigned h) { return __uint_as_float(h << 16); }
typedef float f32x2_t __attribute__((ext_vector_type(2)));
typedef __bf16 bf16x2_t __attribute__((ext_vector_type(2)));
__device__ __forceinline__ unsigned pk2(float lo, float hi) {
  const f32x2_t v = {lo, hi};
  const bf16x2_t b = __builtin_convertvector(v, bf16x2_t);
  return __builtin_bit_cast(unsigned, b);
}
__device__ __forceinline__ bf16_t f2bf(float f) { return (bf16_t)(pk2(f, 0.f) & 0xffffu); }
__device__ __forceinline__ u32x2 pk4(f32x4 v) {
  u32x2 r;
  r.x = pk2(v[0], v[1]);
  r.y = pk2(v[2], v[3]);
  return r;
}
__device__ __forceinline__ float wave_sum(float v) {
#pragma unroll
  for (int o = 32; o > 0; o >>= 1) v += __shfl_xor(v, o);
  return v;
}
__device__ __forceinline__ float silu_f(float v) { return v * __builtin_amdgcn_rcpf(1.f + __expf(-v)); }
__device__ __forceinline__ float sigm_f(float v) { return __builtin_amdgcn_rcpf(1.f + __expf(-v)); }

typedef __attribute__((address_space(3))) unsigned lds_u32_t;
template <bool SWAP>
__device__ __forceinline__ void gemm_acc(f32x4 (&acc)[4][4], const bf16_t* A, long lda, const bf16_t* Bt, long ldb, int K,
                                         bf16_t* lds, const bf16_t* nA = nullptr, const bf16_t* nB = nullptr,
                                         bool primed = false, long nlda = -1, long nldb = -1) {
  const int tid = TID, lane = tid & 63, w = tid >> 6, wm = w >> 1, wn = w & 1;
  char* ldsb = (char*)lds;
  const int chunk = (tid & 7) ^ ((tid >> 4) & 7);
  const int oa = (tid >> 3) * (int)lda + chunk * 8, ob = (tid >> 3) * (int)ldb + chunk * 8;
  const int sa = 32 * (int)lda, sb = 32 * (int)ldb;
  const int nk = K >> 6;
  if (!primed) {
    __syncthreads();
#pragma unroll
    for (int i = 0; i < 4; ++i) {
      __builtin_amdgcn_global_load_lds((const unsigned*)(A + (oa + i * sa)), (lds_u32_t*)(ldsb + tid * 16 + i * 4096), 16, 0, 0);
      __builtin_amdgcn_global_load_lds((const unsigned*)(Bt + (ob + i * sb)), (lds_u32_t*)(ldsb + 16384 + tid * 16 + i * 4096), 16, 0, 0);
    }
  }
  asm volatile("s_waitcnt vmcnt(0)" ::: "memory");
  __syncthreads();
  const int l15 = lane & 15, l4 = lane >> 4;
  const int o0 = l15 * 128 + ((l4 ^ (l15 >> 1)) << 4);
  for (int kt = 0; kt < nk; ++kt) {
    const int cur = kt & 1;
    if (kt + 1 < nk) {
      char* d = ldsb + (cur ^ 1) * 32768 + tid * 16;
#pragma unroll
      for (int i = 0; i < 4; ++i) {
        __builtin_amdgcn_global_load_lds((const unsigned*)(A + (oa + i * sa + (kt + 1) * 64)), (lds_u32_t*)(d + i * 4096), 16, 0, 0);
        __builtin_amdgcn_global_load_lds((const unsigned*)(Bt + (ob + i * sb + (kt + 1) * 64)), (lds_u32_t*)(d + 16384 + i * 4096), 16, 0, 0);
      }
    }
    const char* la = ldsb + cur * 32768 + (64 * wm) * 128;
    const char* lb = ldsb + cur * 32768 + 16384 + (64 * wn) * 128;
#pragma unroll
    for (int ks = 0; ks < 2; ++ks) {
      bf16x8 af[4], bfr[4];
#pragma unroll
      for (int i = 0; i < 4; ++i) {
        af[i] = *(const bf16x8*)(la + i * 2048 + (o0 ^ (ks * 64)));
        bfr[i] = *(const bf16x8*)(lb + i * 2048 + (o0 ^ (ks * 64)));
      }
#pragma unroll
      for (int mi = 0; mi < 4; ++mi)
#pragma unroll
        for (int ni = 0; ni < 4; ++ni) {
          if (SWAP)
            acc[mi][ni] = __builtin_amdgcn_mfma_f32_16x16x32_bf16(bfr[ni], af[mi], acc[mi][ni], 0, 0, 0);
          else
            acc[mi][ni] = __builtin_amdgcn_mfma_f32_16x16x32_bf16(af[mi], bfr[ni], acc[mi][ni], 0, 0, 0);
        }
    }
    asm volatile("s_waitcnt vmcnt(0)" ::: "memory");
    __syncthreads();
  }
  if (nA != nullptr) {
    const int la2 = (nlda < 0) ? (int)lda : (int)nlda, lb2 = (nldb < 0) ? (int)ldb : (int)nldb;
    const int oa2 = (tid >> 3) * la2 + chunk * 8, ob2 = (tid >> 3) * lb2 + chunk * 8;
#pragma unroll
    for (int i = 0; i < 4; ++i) {
      __builtin_amdgcn_global_load_lds((const unsigned*)(nA + (oa2 + i * 32 * la2)), (lds_u32_t*)(ldsb + tid * 16 + i * 4096), 16, 0, 0);
      __builtin_amdgcn_global_load_lds((const unsigned*)(nB + (ob2 + i * 32 * lb2)), (lds_u32_t*)(ldsb + 16384 + tid * 16 + i * 4096), 16, 0, 0);
    }
  }
}
__device__ __forceinline__ void acc_zero(f32x4 (&acc)[4][4]) {
#pragma unroll
  for (int i = 0; i < 4; ++i)
#pragma unroll
    for (int j = 0; j < 4; ++j) acc[i][j] = (f32x4){0.f, 0.f, 0.f, 0.f};
}
__device__ __forceinline__ void tile_map(int t, int ntm, int ntn, int& tm, int& tn) {
  const int GM = 8;
  const int per = GM * ntn;
  const int g = t / per, fm = g * GM;
  const int gsz = (ntm - fm) < GM ? (ntm - fm) : GM;
  const int rem = t - g * per;
  tn = rem / gsz;
  tm = fm + rem % gsz;
}

namespace pg8 {
#define PG8_LAS __attribute__((address_space(3)))
constexpr int BM = 256, BK = 64, HALF = 128, HTB = HALF * BK * 2  , STAGE_BYTES = 8 * HTB, NXCD = 8, WGM = 8;

__host__ __device__ __forceinline__ int lds_byte(int r, int c) { const int st = (r >> 4) * 2 + (c >> 5), rr = r & 15, cc = c & 31, ob = rr * 64 + cc * 2; return st * 1024 + (ob ^ (((ob >> 9) & 1) << 5)); }
__host__ __device__ __forceinline__ void stage_rc(int b, int& R, int& C) { const int st = b / 1024, sb = b % 1024, swz = sb ^ (((sb >> 9) & 1) << 5); R = (st >> 1) * 16 + swz / 64; C = (st & 1) * 32 + (swz % 64) / 2; }
__host__ __device__ __forceinline__ int perm32(int rho) { const int n = rho >> 4, i = rho & 15; return 8 * (i >> 2) + 4 * n + (i & 3); }

struct Unit { int pm, pn; };
struct Gemm { const bf16_t* A; const bf16_t* Bt; int M, N, K; };

struct TileOrder {
  int nM, nN, nwg, G, c, pn0;
  __device__ __forceinline__ void init(int nM_, int nN_, int pn0_, int G_, int c_) { nM = nM_; nN = nN_; nwg = nM_ * nN_; G = G_; c = c_; pn0 = pn0_; }
  __device__ __forceinline__ bool next(int i, Unit& u) const {
    const long L = (long)i * G + c;
    if (L >= nwg) return false;
    int wgid = (int)L;
    { const int q = nwg / NXCD, r = nwg % NXCD, xcd = wgid % NXCD, off = wgid / NXCD; wgid = (xcd < r ? xcd * (q + 1) : r * (q + 1) + (xcd - r) * q) + off; }
    const int nig = WGM * nN, gid = wgid / nig, fm = gid * WGM, gsz = (nM - fm) < WGM ? (nM - fm) : WGM;
    u.pm = fm + ((wgid % nig) % gsz);
    u.pn = pn0 + (wgid % nig) / gsz;
    return true;
  }
  __device__ __forceinline__ void a_ready(const Unit&) const {}
  __device__ __forceinline__ void done(const Unit&) const {}
};

template <class Epi, class Sched>
__device__ __forceinline__ void gemm_phase(PG8_LAS unsigned char* lds, const Gemm g, const Sched& S, const Epi& E) {
    const int tid = threadIdx.x, wid = __builtin_amdgcn_readfirstlane(tid >> 6), lane = tid & 63, wr = wid >> 2, wc = wid & 3, fr = lane & 15, fq = lane >> 4;
    const int K = g.K, nt = K / BK;
#define PG8_STAMP() do { } while (0)
    PG8_STAMP();
    unsigned voffA[2], voffB[2];
#pragma unroll
    for (int i = 0; i < 2; ++i) { int R, C; stage_rc(tid * 16 + i * 8192, R, C); const int Rb = Epi::PERM ? ((R & ~31) + perm32(R & 31)) : R;
        voffA[i] = (unsigned)(R * K + C) * 2u; voffB[i] = (unsigned)(Rb * K + C) * 2u; }
    const size_t kstep = (size_t)(BK * 2);
    const size_t hstep = (size_t)HALF * K * 2;
    const size_t tstep = 2 * hstep;
    const unsigned ldsw = (unsigned)wid * 1024u;
    const int aoff = lds_byte(wr * 64 + fr, fq * 8), boff = lds_byte(wc * 32 + fr, fq * 8);
#define PG8_SA(b, h) (((b) * 2 + (h)) * HTB)
#define PG8_SB(b, h) ((4 + (b) * 2 + (h)) * HTB)
#define PG8_STAGE(bufoff, gbase, voff) do { _Pragma("unroll") for (int _i = 0; _i < 2; ++_i) \
        __builtin_amdgcn_global_load_lds((const unsigned*)((const char*)(gbase) + (voff)[_i]), (PG8_LAS unsigned*)(lds + (bufoff) + ldsw + _i * 8192), 16, 0, 0); } while (0)
#define PG8_LDA(dst, b, h) do { _Pragma("unroll") for (int m = 0; m < 4; ++m) _Pragma("unroll") for (int k = 0; k < 2; ++k) dst[m][k] = *(const PG8_LAS bf16x8*)(lds + PG8_SA(b, h) + aoff + m * 2048 + k * 1024); } while (0)
#define PG8_LDB(dst, b, h) do { _Pragma("unroll") for (int n = 0; n < 2; ++n) _Pragma("unroll") for (int k = 0; k < 2; ++k) dst[n][k] = *(const PG8_LAS bf16x8*)(lds + PG8_SB(b, h) + boff + n * 2048 + k * 1024); } while (0)
#define PG8_MMA(ai, bj, At, Bt) do { __builtin_amdgcn_s_setprio(1); _Pragma("unroll") for (int m = 0; m < 4; ++m) _Pragma("unroll") for (int n = 0; n < 2; ++n) _Pragma("unroll") for (int k = 0; k < 2; ++k) \
        acc[ai][bj][m][n] = __builtin_amdgcn_mfma_f32_16x16x32_bf16(Bt[n][k], At[m][k], acc[ai][bj][m][n], 0, 0, 0); __builtin_amdgcn_s_setprio(0); } while (0)
#define PG8_WAIT_V(n) asm volatile("s_waitcnt vmcnt(" #n ")" ::: "memory")
#define PG8_WAIT_L(n) asm volatile("s_waitcnt lgkmcnt(" #n ")" ::: "memory")
#define PG8_BAR __builtin_amdgcn_s_barrier()
#define PG8_SCHED __builtin_amdgcn_sched_barrier(0)
    Unit cur, nxt; int ui = 0;
    if (!S.next(0, cur)) return;
    f32x4 acc[2][2][4][2];
#pragma unroll
    for (int a = 0; a < 2; ++a)
#pragma unroll
        for (int b = 0; b < 2; ++b)
#pragma unroll
            for (int m = 0; m < 4; ++m)
#pragma unroll
                for (int n = 0; n < 2; ++n) acc[a][b][m][n] = (f32x4){0.f, 0.f, 0.f, 0.f};
    bf16x8 At[4][2], B0[2][2], B1[2][2];
    const char* cA = (const char*)g.A + (size_t)cur.pm * tstep; const char* cB = (const char*)g.Bt + (size_t)cur.pn * tstep;
    S.a_ready(cur);
    PG8_STAGE(PG8_SB(0, 0), cB, voffB); PG8_STAGE(PG8_SA(0, 0), cA, voffA); PG8_STAGE(PG8_SB(0, 1), cB + hstep, voffB); PG8_STAGE(PG8_SA(0, 1), cA + hstep, voffA);
    if (wr == 1) PG8_BAR;
    PG8_WAIT_V(4); PG8_BAR;
    PG8_STAGE(PG8_SB(1, 0), cB + kstep, voffB); PG8_STAGE(PG8_SA(1, 0), cA + kstep, voffA); PG8_STAGE(PG8_SB(1, 1), cB + hstep + kstep, voffB);
    PG8_WAIT_V(6); PG8_BAR;
    PG8_STAMP();
    for (;;) {
        const bool has_next = S.next(ui + 1, nxt);
        const char* nA = has_next ? (const char*)g.A + (size_t)nxt.pm * tstep : cA; const char* nB = has_next ? (const char*)g.Bt + (size_t)nxt.pn * tstep : cB;
        for (int t = 0; t < nt; t += 2) {
            const bool last = (t == nt - 2);
            const char* a1 = cA + (size_t)(t + 1) * kstep;
            const char* a2 = last ? nA : cA + (size_t)(t + 2) * kstep; const char* b2 = last ? nB : cB + (size_t)(t + 2) * kstep;
            const char* a3 = a2 + kstep; const char* b3 = b2 + kstep;
            if (last && has_next) S.a_ready(nxt);
            PG8_LDB(B0, 0, 0); PG8_SCHED; PG8_LDA(At, 0, 0); PG8_STAGE(PG8_SA(1, 1), a1 + hstep, voffA);
            PG8_WAIT_L(8); PG8_BAR; PG8_WAIT_L(0); PG8_MMA(0, 0, At, B0); PG8_BAR; PG8_SCHED;
            PG8_LDB(B1, 0, 1); PG8_STAGE(PG8_SB(0, 0), b2, voffB);
            PG8_BAR; PG8_WAIT_L(0); PG8_MMA(0, 1, At, B1); PG8_BAR;
            PG8_LDA(At, 0, 1); PG8_STAGE(PG8_SA(0, 0), a2, voffA);
            PG8_BAR; PG8_WAIT_L(0); PG8_MMA(1, 0, At, B0); PG8_BAR; PG8_SCHED;
            PG8_STAGE(PG8_SB(0, 1), b2 + hstep, voffB);
            PG8_WAIT_V(6); PG8_BAR; PG8_MMA(1, 1, At, B1); PG8_BAR;
            PG8_LDB(B0, 1, 0); PG8_SCHED; PG8_LDA(At, 1, 0); PG8_STAGE(PG8_SA(0, 1), a2 + hstep, voffA);
            PG8_WAIT_L(8); PG8_BAR; PG8_WAIT_L(0); PG8_MMA(0, 0, At, B0); PG8_BAR; PG8_SCHED;
            PG8_LDB(B1, 1, 1); PG8_STAGE(PG8_SB(1, 0), b3, voffB);
            PG8_BAR; PG8_WAIT_L(0); PG8_MMA(0, 1, At, B1); PG8_BAR;
            PG8_LDA(At, 1, 1); PG8_STAGE(PG8_SA(1, 0), a3, voffA);
            PG8_BAR; PG8_WAIT_L(0); PG8_MMA(1, 0, At, B0); PG8_BAR; PG8_SCHED;
            PG8_STAGE(PG8_SB(1, 1), b3 + hstep, voffB);
            PG8_WAIT_V(6); PG8_BAR; PG8_MMA(1, 1, At, B1); PG8_BAR;
        }
        PG8_STAMP();
        if constexpr (!Epi::AFTER_DRAIN) { E(acc, cur, wr, wc, fr, fq); S.done(cur); }
        PG8_STAMP();
        if (!has_next) break;
#pragma unroll
        for (int a = 0; a < 2; ++a)
#pragma unroll
            for (int b = 0; b < 2; ++b)
#pragma unroll
                for (int m = 0; m < 4; ++m)
#pragma unroll
                    for (int n = 0; n < 2; ++n) acc[a][b][m][n] = (f32x4){0.f, 0.f, 0.f, 0.f};
        cur = nxt; cA = nA; cB = nB; ++ui;
    }
    PG8_WAIT_V(0);
    if (wr == 0) PG8_BAR;
    PG8_BAR;
    if constexpr (Epi::AFTER_DRAIN) { E.fused(acc, cur, wr, wc, fr, fq, lds, wid, lane); S.done(cur); }
    PG8_STAMP();
#undef PG8_STAMP
#undef PG8_SA
#undef PG8_SB
#undef PG8_STAGE
#undef PG8_LDA
#undef PG8_LDB
#undef PG8_MMA
#undef PG8_WAIT_V
#undef PG8_WAIT_L
#undef PG8_BAR
#undef PG8_SCHED
}
}
#define XCD_TILE_LOOP(t, ntiles)                                                                      \
  for (int t0_ = 0; t0_ < (ntiles); t0_ += GSZ)                                                        \
    if (const int t = t0_ + ((BID >> 1) & 7) * (GSZ >> 3) + (((BID >> 4) << 1) | (BID & 1)); t < (ntiles))
__device__ __forceinline__ void conv_weight(const float* src, int K, int ld, int N, bf16_t* dst, int mode, float* sm) {
  const int ntn = N >> 7, ntk = K >> 6;
  const int tid = TID;
  for (int t = BID; t < ntn * ntk; t += GSZ) {
    const int tn = t % ntn, tk = t / ntn;
    const int n0 = tn * 128, k0 = tk * 64;
    __syncthreads();
    {
      const int j = tid & 127, i = tid >> 7;
      const int n = n0 + j;
      int col = n;
      if (mode == 2) {
        const int P = n >> 8, c = n & 255;
        col = (c < 128) ? (128 * P + c) : (DFF + 128 * P + c - 128);
      } else if (mode == 3) {
        if (n < 2048) {
          const int P = n >> 8, c = n & 255, sx = c >> 7, c1 = c & 127;
          col = P * 256 + (c1 >> 6) * 128 + ((c1 >> 5) & 1) * 64 + (c1 & 31) + 32 * sx;
        }
      }
      float v[32];
#pragma unroll
      for (int r = 0; r < 32; ++r) v[r] = src[(long)(k0 + i + 2 * r) * ld + col];
#pragma unroll
      for (int r = 0; r < 32; ++r) sm[(i + 2 * r) * 129 + j] = v[r];
    }
    __syncthreads();
    {
      const int q = tid & 7, jj = tid >> 3;
#pragma unroll
      for (int r = 0; r < 4; ++r) {
        const int nn = jj + 32 * r;
        float v[8];
#pragma unroll
        for (int e = 0; e < 8; ++e) v[e] = sm[(q * 8 + e) * 129 + nn];
        u32x4 o;
        o.x = pk2(v[0], v[1]);
        o.y = pk2(v[2], v[3]);
        o.z = pk2(v[4], v[5]);
        o.w = pk2(v[6], v[7]);
        *(u32x4*)(dst + (long)(n0 + nn) * K + k0 + q * 8) = o;
      }
    }
  }
}

__device__ __forceinline__ void ph_mods_partial(const Params& p, float* sm) {
  float* part = (float*)(p.ws + OFF_MODSPART);
  for (int it = BID; it < 576; it += GSZ) {
    const int ks = it / 18, cch = it % 18;
    __syncthreads();
    if (TID < 128) {
      const int k = ks * 64 + (TID & 63);
      const float v = (TID < 64) ? p.c[k] : p.c_ctx[k];
      sm[TID] = v / (1.f + expf(-v));
    }
    __syncthreads();
    const int n = cch * 1024 + TID * 4;
    f32x4 a0 = (f32x4){0.f, 0.f, 0.f, 0.f}, a1 = a0;
    const float* wp = p.w_ada + (long)(ks * 64) * NMOD + n;
#pragma unroll 8
    for (int k = 0; k < 64; ++k) {
      const f32x4 w = *(const f32x4*)(wp + (long)k * NMOD);
      a0 += w * sm[k];
      a1 += w * sm[64 + k];
    }
    if (ks == 0) {
      const f32x4 bb = *(const f32x4*)(p.b_ada + n);
      a0 += bb;
      a1 += bb;
    }
    float* mods = (float*)(p.ws + OFF_MODS);
#pragma unroll
    for (int r = 0; r < 4; ++r) {
      atomicAdd(mods + n + r, a0[r]);
      atomicAdd(mods + NMOD + n + r, a1[r]);
    }
  }
}
__device__ __forceinline__ void ph_mods_reduce(const Params& p) {
  const float* part = (const float*)(p.ws + OFF_MODSPART);
  float* mods = (float*)(p.ws + OFF_MODS);
  for (int i = BID * 256 + TID; i < 2 * NMOD; i += GSZ * 256) {
    const int v = i / NMOD, n = i % NMOD;
    float s = p.b_ada[n];
    for (int ks = 0; ks < 32; ++ks) s += part[(long)(ks * 2 + v) * NMOD + n];
    mods[i] = s;
  }
}
__device__ __forceinline__ void ph_misc0(const Params& p) {
  float* sumsq = (float*)(p.ws + OFF_SUMSQ);
  float2* rope = (float2*)(p.ws + OFF_ROPE);
  bf16_t* h3 = (bf16_t*)(p.ws + OFF_H3B);
  const int gt = BID * 256 + TID, gs = GSZ * 256;
  for (int i = gt; i < 2048; i += gs) sumsq[i] = 0.f;
  for (int i = gt; i < 256 * 32; i += gs) {
    const int pos = i >> 5, k = i & 31;
    const float inv = exp2f(-(float)k * (13.287712379549449f / 32.f));
    const float ang = (float)pos * inv;
    rope[i] = make_float2(cosf(ang), sinf(ang));
  }
  const int lane = TID & 63;
  const int gw = BID * 4 + (TID >> 6), nw = GSZ * 4;
  const float fq = p.freq[lane];
  for (int j = gw; j < 16384; j += nw) {
    const float wj = (6.2831855f * (float)j) / 16384.f;
    float feat = 0.f;
    if (lane == 0)
      feat = (float)j / 16383.f;
    else if (lane <= 16) {
      const float f = 1e-4f + (float)(lane - 1) * ((15.f - 1e-4f) / 15.f);
      feat = cosf(f * wj);
    } else if (lane <= 32) {
      const float f = 1e-4f + (float)(lane - 17) * ((15.f - 1e-4f) / 15.f);
      feat = -sinf(f * wj);
    }
    float a = p.b1[lane];
    for (int e = 0; e < 33; ++e) a += __shfl(feat, e) * p.w1[e * 64 + lane];
    float h = sinf(fq * a);
    a = p.b2[lane];
    for (int k = 0; k < 64; ++k) a += __shfl(h, k) * p.w2[k * 64 + lane];
    h = sinf(fq * a);
    a = p.b3[lane];
    for (int k = 0; k < 64; ++k) a += __shfl(h, k) * p.w3[k * 64 + lane];
    h = sinf(fq * a);
    h3[j * 64 + lane] = f2bf(h);
  }
}
__device__ __forceinline__ void ph_prenorm(const Params& p, const float* xl, const float* xc, int rows, const float* g, int slot) {
  const float* mods = (const float*)(p.ws + OFF_MODS);
  bf16_t* A = (bf16_t*)(p.ws + OFF_AR);
  const int lane = TID & 63;
  const int gw = BID * 4 + (TID >> 6), nw = GSZ * 4;
  for (int r = gw; r < rows; r += nw) {
    const float* src = (r < T) ? xl + (long)r * D : xc + (long)(r - T) * D;
    const float* md = mods + ((r < T) ? 0 : NMOD);
    f32x4 v[8];
    float ss = 0.f;
#pragma unroll
    for (int i = 0; i < 8; ++i) {
      v[i] = *(const f32x4*)(src + i * 256 + lane * 4);
      ss += v[i][0] * v[i][0] + v[i][1] * v[i][1] + v[i][2] * v[i][2] + v[i][3] * v[i][3];
    }
    ss = wave_sum(ss);
    const float rstd = rsqrtf(ss * (1.f / 2048.f) + 1e-6f);
#pragma unroll
    for (int i = 0; i < 8; ++i) {
      const int c = i * 256 + lane * 4;
      const f32x4 gg = *(const f32x4*)(g + c);
      const f32x4 sh = *(const f32x4*)(md + (3 * slot) * D + c);
      const f32x4 sc = *(const f32x4*)(md + (3 * slot + 1) * D + c);
      const f32x4 y = v[i] * rstd * gg;
      const f32x4 o = y * (1.f + sc) + sh;
      *(u32x2*)(A + (long)r * D + c) = pk4(o);
    }
  }
}
__device__ __forceinline__ void ph_final_norm(const Params& p) {
  const int lane = TID & 63;
  const int gw = BID * 4 + (TID >> 6), nw = GSZ * 4;
  for (int r = gw; r < T; r += nw) {
    float* src = p.out + (long)r * D;
    f32x4 v[8];
    float ss = 0.f;
#pragma unroll
    for (int i = 0; i < 8; ++i) {
      v[i] = *(const f32x4*)(src + i * 256 + lane * 4);
      ss += v[i][0] * v[i][0] + v[i][1] * v[i][1] + v[i][2] * v[i][2] + v[i][3] * v[i][3];
    }
    ss = wave_sum(ss);
    const float rstd = rsqrtf(ss * (1.f / 2048.f) + 1e-6f);
#pragma unroll
    for (int i = 0; i < 8; ++i) {
      const int c = i * 256 + lane * 4;
      const f32x4 gg = *(const f32x4*)(p.fin_g + c);
      *(f32x4*)(src + c) = v[i] * rstd * gg;
    }
  }
}

#define GEMM_IDS                                                                       \
  const int lane = TID & 63, wv = TID >> 6, wm = wv >> 1, wn = wv & 1; \
  const int l15 = lane & 15, l4 = lane >> 4;                                           \
  (void)l15; (void)l4; (void)wm; (void)wn;

__device__ __forceinline__ void ph_gemm_up(const Params& p, int rows, bf16_t* lds) {
  GEMM_IDS
  const bf16_t* A = (const bf16_t*)(p.ws + OFF_AR);
  const bf16_t* Bt = (const bf16_t*)(p.ws + OFF_WBIG);
  bf16_t* H = (bf16_t*)(p.ws + OFF_H);
  const int ntm = rows >> 7, ntn = 88;
  bool primed = false;
  XCD_TILE_LOOP(t, ntm * ntn) {
    int tm, tn;
    tile_map(t, ntm, ntn, tm, tn);
    f32x4 acc[4][4];
    acc_zero(acc);
    const bf16_t *nA = nullptr, *nB = nullptr;
    if (t + (int)GSZ < ntm * ntn) { int tm2, tn2; tile_map(t + GSZ, ntm, ntn, tm2, tn2); nA = A + (long)tm2 * 128 * D; nB = Bt + (long)tn2 * 128 * D; }
    gemm_acc<true>(acc, A + (long)tm * 128 * D, D, Bt + (long)tn * 128 * D, D, D, lds, nA, nB, primed);
    primed = nA != nullptr;
#pragma unroll
    for (int mi = 0; mi < 4; ++mi) {
      const int m = tm * 128 + 64 * wm + 16 * mi + l15;
#pragma unroll
      for (int ni = 0; ni < 2; ++ni) {
        const int hc = (tn * 2 + wn) * 32 + 16 * ni + 4 * l4;
        f32x4 o;
#pragma unroll
        for (int r = 0; r < 4; ++r) o[r] = silu_f(acc[mi][ni][r]) * acc[mi][ni + 2][r];
        *(u32x2*)(H + (long)m * DFF + hc) = pk4(o);
      }
    }
  }
}
__device__ __forceinline__ void ph_gemm_down(const Params& p, int rows, int slot, const float* resl, const float* resc, float* outl, float* outc,
                             bf16_t* lds) {
  GEMM_IDS
  const bf16_t* A = (const bf16_t*)(p.ws + OFF_H);
  const bf16_t* Bt = (const bf16_t*)(p.ws + OFF_WDOWN);
  const float* mods = (const float*)(p.ws + OFF_MODS);
  const int ntm = rows >> 7, ntn = 16;
  bool primed = false;
  XCD_TILE_LOOP(t, ntm * ntn) {
    int tm, tn;
    tile_map(t, ntm, ntn, tm, tn);
    f32x4 acc[4][4];
    acc_zero(acc);
    const bf16_t *nA = nullptr, *nB = nullptr;
    if (t + (int)GSZ < ntm * ntn) { int tm2, tn2; tile_map(t + GSZ, ntm, ntn, tm2, tn2); nA = A + (long)tm2 * 128 * DFF; nB = Bt + (long)tn2 * 128 * DFF; }
    gemm_acc<true>(acc, A + (long)tm * 128 * DFF, DFF, Bt + (long)tn * 128 * DFF, DFF, DFF, lds, nA, nB, primed);
    primed = nA != nullptr;
    const bool lat = tm < 128;
    const float* gate = mods + (lat ? 0 : NMOD) + (3 * slot + 2) * D;
#pragma unroll
    for (int mi = 0; mi < 4; ++mi) {
      const int m = tm * 128 + 64 * wm + 16 * mi + l15;
      const float* rp = lat ? resl + (long)m * D : resc + (long)(m - T) * D;
      float* op = lat ? outl + (long)m * D : outc + (long)(m - T) * D;
#pragma unroll
      for (int ni = 0; ni < 4; ++ni) {
        const int n = tn * 128 + 64 * wn + 16 * ni + 4 * l4;
        const f32x4 gt = *(const f32x4*)(gate + n);
        const f32x4 rs = *(const f32x4*)(rp + n);
        *(f32x4*)(op + n) = rs + 0.5f * gt * acc[mi][ni];
      }
    }
  }
}
__device__ __forceinline__ void ph_gemm_plain(const bf16_t* A, const bf16_t* Bt, bf16_t* C, int M, int N, int K, bf16_t* lds) {
  GEMM_IDS
  const int ntm = M >> 7, ntn = N >> 7;
  bool primed = false;
  XCD_TILE_LOOP(t, ntm * ntn) {
    int tm, tn;
    tile_map(t, ntm, ntn, tm, tn);
    f32x4 acc[4][4];
    acc_zero(acc);
    const bf16_t *nA = nullptr, *nB = nullptr;
    if (t + (int)GSZ < ntm * ntn) { int tm2, tn2; tile_map(t + GSZ, ntm, ntn, tm2, tn2); nA = A + (long)tm2 * 128 * K; nB = Bt + (long)tn2 * 128 * K; }
    gemm_acc<true>(acc, A + (long)tm * 128 * K, K, Bt + (long)tn * 128 * K, K, K, lds, nA, nB, primed);
    primed = nA != nullptr;
#pragma unroll
    for (int mi = 0; mi < 4; ++mi) {
      const int m = tm * 128 + 64 * wm + 16 * mi + l15;
#pragma unroll
      for (int ni = 0; ni < 4; ++ni) {
        const int n = tn * 128 + 64 * wn + 16 * ni + 4 * l4;
        *(u32x2*)(C + (long)m * N + n) = pk4(acc[mi][ni]);
      }
    }
  }
}
__device__ __forceinline__ void ph_gemm_win_a(const Params& p, bf16_t* lds) {
  GEMM_IDS
  const bf16_t* A = (const bf16_t*)(p.ws + OFF_AR);
  const bf16_t* Bt = (const bf16_t*)(p.ws + OFF_WBIG);
  bf16_t* q = (bf16_t*)(p.ws + OFF_Q);
  bf16_t* kk = (bf16_t*)(p.ws + OFF_K);
  bf16_t* kTf = (bf16_t*)(p.ws + OFF_KTF);
  bf16_t* kTb = (bf16_t*)(p.ws + OFF_KTB);
  bf16_t* vT = (bf16_t*)(p.ws + OFF_VT);
  bf16_t* sg = (bf16_t*)(p.ws + OFF_SG);
  const float2* rope = (const float2*)(p.ws + OFF_ROPE);
  const int n_lat = 128 * 48, n_ctx = 2 * 24;
  XCD_TILE_LOOP(t, n_lat + n_ctx) {
    int tm, tn;
    if (t < n_lat)
      tile_map(t, 128, 48, tm, tn);
    else {
      const int u = t - n_lat;
      tm = 128 + u / 24;
      tn = 8 + u % 24;
    }
    f32x4 acc[4][4];
    acc_zero(acc);
    const bf16_t* Ap = A + (long)tm * 128 * D;
    const bf16_t* Bp = Bt + (long)tn * 128 * D;
    if (tn >= 16 && tn < 32) {
      gemm_acc<false>(acc, Ap, D, Bp, D, D, lds);
#pragma unroll
      for (int mi = 0; mi < 4; ++mi) {
        const int m0 = tm * 128 + 64 * wm + 16 * mi + 4 * l4;
#pragma unroll
        for (int ni = 0; ni < 4; ++ni) {
          const int ch = (tn - 16) * 128 + 64 * wn + 16 * ni + l15;
          *(u32x2*)(vT + (long)ch * TT + m0) = pk4(acc[mi][ni]);
        }
      }
    } else {
      gemm_acc<true>(acc, Ap, D, Bp, D, D, lds);
      if (tn < 8) {
        const float scl = 0.08838834764831845f;
#pragma unroll
        for (int mi = 0; mi < 4; ++mi) {
          const int m = tm * 128 + 64 * wm + 16 * mi + l15;
          const int pos = (wn == 0) ? (m >> 6) : (m & 63);
#pragma unroll
          for (int ni = 0; ni < 2; ++ni) {
            const int i0 = 16 * ni + 4 * l4;
            f32x4 o1, o2;
#pragma unroll
            for (int r = 0; r < 4; ++r) {
              const float2 cs = rope[pos * 32 + i0 + r];
              const float x1 = acc[mi][ni][r] * scl, x2 = acc[mi][ni + 2][r] * scl;
              o1[r] = x1 * cs.x - x2 * cs.y;
              o2[r] = x1 * cs.y + x2 * cs.x;
            }
            bf16_t* dp = q + (long)m * 1024 + tn * 128 + 64 * wn + i0;
            *(u32x2*)(dp) = pk4(o1);
            *(u32x2*)(dp + 32) = pk4(o2);
          }
        }
      } else if (tn < 16) {
        const int head = tn - 8;
        const float lgf = p.lg[head], lgb = p.lg[8 + head];
#pragma unroll
        for (int mi = 0; mi < 4; ++mi) {
          const int m = tm * 128 + 64 * wm + 16 * mi + l15;
          const bool lat = m < T;
          const int pos = (wn == 0) ? ((m >> 6) & 255) : (m & 63);
          const int j = m & 127;
          const float zf = __expf(lgf * (float)(127 - j)), zb = __expf(lgb * (float)j);
#pragma unroll
          for (int ni = 0; ni < 2; ++ni) {
            const int i0 = 16 * ni + 4 * l4;
            f32x4 o1, o2;
#pragma unroll
            for (int r = 0; r < 4; ++r) {
              float2 cs = rope[pos * 32 + i0 + r];
              if (!lat) cs = make_float2(1.f, 0.f);
              const float x1 = acc[mi][ni][r], x2 = acc[mi][ni + 2][r];
              o1[r] = x1 * cs.x - x2 * cs.y;
              o2[r] = x1 * cs.y + x2 * cs.x;
            }
            const int cb = head * 128 + 64 * wn + i0;
            if (lat) {
              bf16_t* dp = kk + (long)m * 1024 + cb;
              *(u32x2*)(dp) = pk4(o1);
              *(u32x2*)(dp + 32) = pk4(o2);
            }
#pragma unroll
            for (int r = 0; r < 4; ++r) {
              kTf[(long)(cb + r) * TT + m] = f2bf(o1[r] * zf);
              kTb[(long)(cb + r) * TT + m] = f2bf(o1[r] * zb);
              kTf[(long)(cb + 32 + r) * TT + m] = f2bf(o2[r] * zf);
              kTb[(long)(cb + 32 + r) * TT + m] = f2bf(o2[r] * zb);
            }
          }
        }
      } else {
#pragma unroll
        for (int mi = 0; mi < 4; ++mi) {
          const int m = tm * 128 + 64 * wm + 16 * mi + l15;
#pragma unroll
          for (int ni = 0; ni < 4; ++ni) {
            const int n = (tn - 32) * 128 + 64 * wn + 16 * ni + 4 * l4;
            f32x4 o;
#pragma unroll
            for (int r = 0; r < 4; ++r) o[r] = silu_f(acc[mi][ni][r]);
            *(u32x2*)(sg + (long)m * D + n) = pk4(o);
          }
        }
      }
    }
  }
}
__device__ __forceinline__ void ph_gemm_win_b(const Params& p, bf16_t* lds) {
  GEMM_IDS
  const bf16_t* A = (const bf16_t*)(p.ws + OFF_AR);
  const bf16_t* Bt = (const bf16_t*)(p.ws + OFF_WBIG);
  bf16_t* phy = (bf16_t*)(p.ws + OFF_PHY);
  bf16_t* gates = (bf16_t*)(p.ws + OFF_GATES);
  bool primed = false;
  XCD_TILE_LOOP(t, 128 * 80) {
    int tm, tn;
    tile_map(t, 128, 80, tm, tn);
    tn += 48;
    f32x4 acc[4][4];
    acc_zero(acc);
    const bf16_t *nA = nullptr, *nB = nullptr;
    if (t + (int)GSZ < 128 * 80) { int tm2, tn2; tile_map(t + GSZ, 128, 80, tm2, tn2); tn2 += 48; nA = A + (long)tm2 * 128 * D; nB = Bt + (long)tn2 * 128 * D; }
    gemm_acc<true>(acc, A + (long)tm * 128 * D, D, Bt + (long)tn * 128 * D, D, D, lds, nA, nB, primed);
    primed = nA != nullptr;
#pragma unroll
    for (int mi = 0; mi < 4; ++mi) {
      const int m = tm * 128 + 64 * wm + 16 * mi + l15;
#pragma unroll
      for (int ni = 0; ni < 4; ++ni) {
        const int nl = 64 * wn + 16 * ni + 4 * l4;
        if (tn < 96) {
          *(u32x2*)(phy + (long)m * 6144 + (tn - 48) * 128 + nl) = pk4(acc[mi][ni]);
        } else {
          f32x4 o;
#pragma unroll
          for (int r = 0; r < 4; ++r) o[r] = sigm_f(acc[mi][ni][r]);
          *(u32x2*)(gates + (long)m * 4096 + (tn - 96) * 128 + nl) = pk4(o);
        }
      }
    }
  }
}
__device__ __forceinline__ void ph_ret_kv_p(const Params& p, bf16_t* lds) {
  GEMM_IDS
  const bf16_t* q = (const bf16_t*)(p.ws + OFF_Q);
  const bf16_t* kk = (const bf16_t*)(p.ws + OFF_K);
  const bf16_t* kTf = (const bf16_t*)(p.ws + OFF_KTF);
  const bf16_t* kTb = (const bf16_t*)(p.ws + OFF_KTB);
  const bf16_t* vT = (const bf16_t*)(p.ws + OFF_VT);
  bf16_t* kvT = (bf16_t*)(p.ws + OFF_KVT);
  bf16_t* P = (bf16_t*)(p.ws + OFF_P);
  const int n1 = 130 * 8 * 2 * 2, n2 = 128 * 8;
  bool primed = false;
  for (int t = BID; t < n1; t += GSZ) {
    f32x4 acc[4][4];
    acc_zero(acc);
    {
      const int half = t & 1, d = (t >> 1) & 1, h = (t >> 2) & 7, ci = t >> 5;
      const bf16_t* Ap = vT + (long)(h * 256 + half * 128) * TT + ci * 128;
      const bf16_t* Bp = (d ? kTb : kTf) + (long)(h * 128) * TT + ci * 128;
      const bf16_t *nAp = nullptr, *nBp = nullptr;
      if (t + GSZ < n1) {
        const int t2 = t + GSZ, half2 = t2 & 1, d2 = (t2 >> 1) & 1, h2 = (t2 >> 2) & 7, ci2 = t2 >> 5;
        nAp = vT + (long)(h2 * 256 + half2 * 128) * TT + ci2 * 128;
        nBp = (d2 ? kTb : kTf) + (long)(h2 * 128) * TT + ci2 * 128;
      }
      gemm_acc<true>(acc, Ap, TT, Bp, TT, 128, lds, nAp, nBp, primed);
      primed = nAp != nullptr;
      bf16_t* o = kvT + ((long)(d * 130 + ci) * 8 + h) * 32768 + (long)(half * 128) * 128;
#pragma unroll
      for (int mi = 0; mi < 4; ++mi) {
        const int m = 64 * wm + 16 * mi + l15;
#pragma unroll
        for (int ni = 0; ni < 4; ++ni) {
          const int n = 64 * wn + 16 * ni + 4 * l4;
          *(u32x2*)(o + m * 128 + n) = pk4(acc[mi][ni]);
        }
      }
    }
  }
  bool primed2 = false;
  for (int u = BID; u < n2; u += GSZ) {
    f32x4 acc[4][4];
    acc_zero(acc);
    {
      const int h = u & 7, ci = u >> 3;
      const bf16_t* Ap = q + (long)ci * 128 * 1024 + h * 128;
      const bf16_t* Bp = kk + (long)ci * 128 * 1024 + h * 128;
      const bf16_t *nAp = nullptr, *nBp = nullptr;
      if (u + GSZ < n2) {
        const int u2 = u + GSZ, h2 = u2 & 7, ci2 = u2 >> 3;
        nAp = q + (long)ci2 * 128 * 1024 + h2 * 128;
        nBp = kk + (long)ci2 * 128 * 1024 + h2 * 128;
      }
      gemm_acc<true>(acc, Ap, 1024, Bp, 1024, 128, lds, nAp, nBp, primed2);
      primed2 = nAp != nullptr;
      const float lgf = p.lg[h], nlgb = -p.lg[8 + h];
      bf16_t* o = P + (long)(ci * 8 + h) * 16384;
#pragma unroll
      for (int mi = 0; mi < 4; ++mi) {
        const int a = 64 * wm + 16 * mi + l15;
#pragma unroll
        for (int ni = 0; ni < 4; ++ni) {
          const int b0 = 64 * wn + 16 * ni + 4 * l4;
          f32x4 ov;
#pragma unroll
          for (int r = 0; r < 4; ++r) {
            const int b = b0 + r;
            const int dd = a - b;
            const float dcy = (dd == 0) ? 2.f : __expf((dd > 0 ? lgf : nlgb) * (float)dd);
            ov[r] = acc[mi][ni][r] * dcy;
          }
          *(u32x2*)(o + a * 128 + b0) = pk4(ov);
        }
      }
    }
  }
}
__device__ __forceinline__ void ph_ret_scan(const Params& p) {
  unsigned* kv = (unsigned*)(p.ws + OFF_KVT);
  for (int it = BID * 256 + TID; it < 262144; it += GSZ * 256) {
    const int d = it >> 17, e2 = it & 131071, h = e2 >> 14, off = e2 & 16383;
    const float dec = expf(p.lg[d * 8 + h] * 128.f);
    unsigned* base = kv + ((long)d * 130 * 8 + h) * 16384 + off;
    float s0 = 0.f, s1 = 0.f;
    for (int sb = 0; sb < 130; sb += 10) {
      unsigned vv[10];
#pragma unroll
      for (int k = 0; k < 10; ++k) {
        const int step = sb + k;
        const int ci = (d == 0) ? ((step < 2) ? (128 + step) : (step - 2)) : (129 - step);
        vv[k] = base[(long)ci * 131072];
      }
#pragma unroll
      for (int k = 0; k < 10; ++k) {
        const int step = sb + k;
        const int ci = (d == 0) ? ((step < 2) ? (128 + step) : (step - 2)) : (129 - step);
        base[(long)ci * 131072] = pk2(s0, s1);
        s0 = s0 * dec + bf2f(vv[k] & 0xffffu);
        s1 = s1 * dec + bf2f(vv[k] >> 16);
      }
    }
  }
}
__device__ __forceinline__ void ph_ret_out(const Params& p, char* lds_all) {
  GEMM_IDS
  const int half = fresh_tid() >> 8;
  bf16_t* lds = (bf16_t*)(lds_all + half * LDS_HALF);
  float2* part = (float2*)(lds_all + 65536);
  const bf16_t* q = (const bf16_t*)(p.ws + OFF_Q);
  const bf16_t* vT = (const bf16_t*)(p.ws + OFF_VT);
  const bf16_t* kvT = (const bf16_t*)(p.ws + OFF_KVT);
  const bf16_t* P = (const bf16_t*)(p.ws + OFF_P);
  const bf16_t* sg = (const bf16_t*)(p.ws + OFF_SG);
  bf16_t* Y = (bf16_t*)(p.ws + OFF_Y);
  bool primed = false;
  for (int it = (int)blockIdx.x; it < 1024; it += (int)gridDim.x) {
    const int h = it & 7, ci = it >> 3;
    const float lgf = p.lg[h], lgb = p.lg[8 + h];
    f32x4 acc[4][4];
    acc_zero(acc);
    const bf16_t* Aq = q + (long)ci * 128 * 1024 + h * 128;
    const bf16_t* Sb = kvT + ((long)(130 + ci) * 8 + h) * 32768 + (long)(half * 128) * 128;
    const bf16_t* Sf = kvT + ((long)(ci)*8 + h) * 32768 + (long)(half * 128) * 128;
    const bf16_t* Ap = P + (long)(ci * 8 + h) * 16384;
    const bf16_t* Vp = vT + (long)(h * 256 + half * 128) * TT + ci * 128;
    const bf16_t *nAq = nullptr, *nSb = nullptr;
    if (it + (int)gridDim.x < 1024) {
      const int it2 = it + (int)gridDim.x, h2 = it2 & 7, ci2 = it2 >> 3;
      nAq = q + (long)ci2 * 128 * 1024 + h2 * 128;
      nSb = kvT + ((long)(130 + ci2) * 8 + h2) * 32768 + (long)(half * 128) * 128;
    }
    gemm_acc<true>(acc, Aq, 1024, Sb, 128, 128, lds, Aq, Sf, primed);
#pragma unroll
    for (int mi = 0; mi < 4; ++mi) {
      const int a = 64 * wm + 16 * mi + l15;
      const float ratio = __expf(lgb * (float)(128 - a) - lgf * (float)(a + 1));
#pragma unroll
      for (int ni = 0; ni < 4; ++ni) acc[mi][ni] *= ratio;
    }
    gemm_acc<true>(acc, Aq, 1024, Sf, 128, 128, lds, Ap, Vp, true, 128, TT);
#pragma unroll
    for (int mi = 0; mi < 4; ++mi) {
      const int a = 64 * wm + 16 * mi + l15;
      const float xf = __expf(lgf * (float)(a + 1));
#pragma unroll
      for (int ni = 0; ni < 4; ++ni) acc[mi][ni] *= xf;
    }
    gemm_acc<true>(acc, Ap, 128, Vp, TT, 128, lds, nAq, nSb, true, 1024, 128);
    primed = nAq != nullptr;
#pragma unroll
    for (int mi = 0; mi < 4; ++mi) {
      float s1 = 0.f, s2 = 0.f;
#pragma unroll
      for (int ni = 0; ni < 4; ++ni)
#pragma unroll
        for (int r = 0; r < 4; ++r) {
          const float v = acc[mi][ni][r];
          s1 += v;
          s2 += v * v;
        }
      s1 += __shfl_xor(s1, 16);
      s2 += __shfl_xor(s2, 16);
      s1 += __shfl_xor(s1, 32);
      s2 += __shfl_xor(s2, 32);
      if (l4 == 0) part[(half * 2 + wn) * 128 + 64 * wm + 16 * mi + l15] = make_float2(s1, s2);
    }
    __syncthreads();
#pragma unroll
    for (int mi = 0; mi < 4; ++mi) {
      const int a = 64 * wm + 16 * mi + l15;
      const float2 p0 = part[a], p1 = part[128 + a], p2 = part[256 + a], p3 = part[384 + a];
      const float mean = ((p0.x + p1.x) + (p2.x + p3.x)) * (1.f / 256.f);
      const float ex2 = ((p0.y + p1.y) + (p2.y + p3.y)) * (1.f / 256.f);
      const float rs = rsqrtf(fmaxf(ex2 - mean * mean, 0.f) + 1e-6f);
      const long t = (long)ci * 128 + a;
#pragma unroll
      for (int ni = 0; ni < 4; ++ni) {
        const int c = h * 256 + half * 128 + 64 * wn + 16 * ni + 4 * l4;
        const u32x2 graw = *(const u32x2*)(sg + t * D + c);
        const f32x4 gg = *(const f32x4*)(p.gn_g + c), gb = *(const f32x4*)(p.gn_b + c);
        f32x4 o;
        o[0] = ((acc[mi][ni][0] - mean) * rs * gg[0] + gb[0]) * bf2f(graw.x & 0xffffu);
        o[1] = ((acc[mi][ni][1] - mean) * rs * gg[1] + gb[1]) * bf2f(graw.x >> 16);
        o[2] = ((acc[mi][ni][2] - mean) * rs * gg[2] + gb[2]) * bf2f(graw.y & 0xffffu);
        o[3] = ((acc[mi][ni][3] - mean) * rs * gg[3] + gb[3]) * bf2f(graw.y >> 16);
        *(u32x2*)(Y + t * D + c) = pk4(o);
      }
    }
  }
}
__device__ __forceinline__ void ph_ret_gn(const Params& p) {
  bf16_t* Y = (bf16_t*)(p.ws + OFF_Y);
  const bf16_t* sg = (const bf16_t*)(p.ws + OFF_SG);
  const int lane = TID & 63;
  const int gw = BID * 4 + (TID >> 6), nw = GSZ * 4;
  for (int t = gw; t < T; t += nw) {
    u32x2 raw[8], graw[8];
#pragma unroll
    for (int h = 0; h < 8; ++h) {
      raw[h] = *(const u32x2*)(Y + (long)t * D + h * 256 + lane * 4);
      graw[h] = *(const u32x2*)(sg + (long)t * D + h * 256 + lane * 4);
    }
#pragma unroll
    for (int h = 0; h < 8; ++h) {
      const int c = h * 256 + lane * 4;
      float v[4] = {bf2f(raw[h].x & 0xffffu), bf2f(raw[h].x >> 16), bf2f(raw[h].y & 0xffffu), bf2f(raw[h].y >> 16)};
      const float mean = wave_sum(v[0] + v[1] + v[2] + v[3]) * (1.f / 256.f);
      float q = 0.f;
#pragma unroll
      for (int r = 0; r < 4; ++r) {
        v[r] -= mean;
        q += v[r] * v[r];
      }
      const float rs = rsqrtf(wave_sum(q) * (1.f / 256.f) + 1e-6f);
      const float gv[4] = {bf2f(graw[h].x & 0xffffu), bf2f(graw[h].x >> 16), bf2f(graw[h].y & 0xffffu), bf2f(graw[h].y >> 16)};
      const f32x4 gg = *(const f32x4*)(p.gn_g + c), gb = *(const f32x4*)(p.gn_b + c);
      f32x4 o;
#pragma unroll
      for (int r = 0; r < 4; ++r) o[r] = (v[r] * rs * gg[r] + gb[r]) * gv[r];
      *(u32x2*)(Y + (long)t * D + c) = pk4(o);
    }
  }
}
__device__ __forceinline__ void hy_conv_row(const u32x4 (&rm)[3], const u32x4 (&r0)[3], const u32x4 (&rp)[3], const float (&wv)[3][3][8],
                                            const float (&bv)[3][8], bf16_t* x0p, bf16_t* zp) {
  float u[3][8];
#pragma unroll
  for (int s3 = 0; s3 < 3; ++s3) {
#pragma unroll
    for (int e = 0; e < 8; ++e) u[s3][e] = bv[s3][e];
#pragma unroll
    for (int dt = 0; dt < 3; ++dt) {
      const u32x4 raw = (dt == 0) ? rm[s3] : ((dt == 1) ? r0[s3] : rp[s3]);
      const unsigned rw[4] = {raw.x, raw.y, raw.z, raw.w};
#pragma unroll
      for (int e = 0; e < 4; ++e) {
        u[s3][2 * e] += bf2f(rw[e] & 0xffffu) * wv[s3][dt][2 * e];
        u[s3][2 * e + 1] += bf2f(rw[e] >> 16) * wv[s3][dt][2 * e + 1];
      }
    }
  }
  u32x4 o0, oz;
  o0.x = pk2(u[0][0], u[0][1]);
  o0.y = pk2(u[0][2], u[0][3]);
  o0.z = pk2(u[0][4], u[0][5]);
  o0.w = pk2(u[0][6], u[0][7]);
  oz.x = pk2(u[1][0] * u[2][0], u[1][1] * u[2][1]);
  oz.y = pk2(u[1][2] * u[2][2], u[1][3] * u[2][3]);
  oz.z = pk2(u[1][4] * u[2][4], u[1][5] * u[2][5]);
  oz.w = pk2(u[1][6] * u[2][6], u[1][7] * u[2][7]);
  *(u32x4*)x0p = o0;
  *(u32x4*)zp = oz;
}
__device__ __forceinline__ void ph_hy_conv(const Params& p) {
  const bf16_t* phy = (const bf16_t*)(p.ws + OFF_PHY);
  bf16_t* x0 = (bf16_t*)(p.ws + OFF_X0);
  bf16_t* z = (bf16_t*)(p.ws + OFF_Z);
  const int c0 = TID * 8;
  float wv[3][3][8], bv[3][8];
#pragma unroll
  for (int s3 = 0; s3 < 3; ++s3) {
#pragma unroll
    for (int e = 0; e < 8; ++e) bv[s3][e] = p.conv_b[s3 * 2048 + c0 + e];
#pragma unroll
    for (int dt = 0; dt < 3; ++dt)
#pragma unroll
      for (int e = 0; e < 8; ++e) wv[s3][dt][e] = p.conv_w[dt * 6144 + s3 * 2048 + c0 + e];
  }
  const int nrows = T / GSZ;
  const int t0 = BID * nrows;
  u32x4 w0[3], w1[3], w2[3], w3[3], n0[3], n1[3];
#define HYC_LD(dst, tt)                                                                                   \
  {                                                                                                       \
    const int tt_ = (tt);                                                                                 \
    _Pragma("unroll") for (int s3 = 0; s3 < 3; ++s3)                                                      \
      dst[s3] = (tt_ >= 0 && tt_ < T) ? *(const u32x4*)(phy + (long)tt_ * 6144 + s3 * 2048 + c0) : (u32x4){0u, 0u, 0u, 0u}; \
  }
  HYC_LD(w0, t0 - 1)
  HYC_LD(w1, t0)
  HYC_LD(w2, t0 + 1)
  HYC_LD(w3, t0 + 2)
  for (int k = 0; k < nrows; k += 2) {
    const int t = t0 + k;
    HYC_LD(n0, t + 3)
    HYC_LD(n1, t + 4)
    hy_conv_row(w0, w1, w2, wv, bv, x0 + (long)t * D + c0, z + (long)t * D + c0);
    hy_conv_row(w1, w2, w3, wv, bv, x0 + (long)(t + 1) * D + c0, z + (long)(t + 1) * D + c0);
#pragma unroll
    for (int s3 = 0; s3 < 3; ++s3) { w0[s3] = w2[s3]; w1[s3] = w3[s3]; w2[s3] = n0[s3]; w3[s3] = n1[s3]; }
  }
#undef HYC_LD
}

typedef float c2f __attribute__((ext_vector_type(2)));
__device__ __forceinline__ c2f mk2(float a, float b) { return (c2f){a, b}; }
__device__ __forceinline__ c2f cmul(c2f a, c2f b) { return a.xx * b + a.yy * (c2f){-b.y, b.x}; }
__device__ __forceinline__ c2f cmulc(c2f a, c2f b) { return a.xx * (c2f){b.x, -b.y} + a.yy * (c2f){b.y, b.x}; }
__device__ __forceinline__ c2f cadd(c2f a, c2f b) { return a + b; }
__device__ __forceinline__ c2f csub(c2f a, c2f b) { return a - b; }
__device__ __forceinline__ constexpr float w16c(int m) {
  m &= 15;
  return m == 0 ? 1.f : m == 1 ? 0.92387953251f : m == 2 ? 0.70710678119f : m == 3 ? 0.38268343237f : m == 4 ? 0.f
       : m == 5 ? -0.38268343237f : m == 6 ? -0.70710678119f : m == 7 ? -0.92387953251f : m == 8 ? -1.f
       : m == 9 ? -0.92387953251f : m == 10 ? -0.70710678119f : m == 11 ? -0.38268343237f : m == 12 ? 0.f
       : m == 13 ? 0.38268343237f : m == 14 ? 0.70710678119f : 0.92387953251f;
}
__device__ __forceinline__ constexpr float w16s(int m) { return w16c(m - 4); }
template <int SGN>
__device__ __forceinline__ void dft4(c2f& a0, c2f& a1, c2f& a2, c2f& a3) {
  const c2f s02 = cadd(a0, a2), d02 = csub(a0, a2), s13 = cadd(a1, a3), d13 = csub(a1, a3);
  const c2f jd = mk2(-(float)SGN * d13.y, (float)SGN * d13.x);
  a0 = cadd(s02, s13);
  a1 = cadd(d02, jd);
  a2 = csub(s02, s13);
  a3 = csub(d02, jd);
}
template <int SGN>
__device__ __forceinline__ void dft16(c2f (&v)[16]) {
#pragma unroll
  for (int b = 0; b < 4; ++b) dft4<SGN>(v[b], v[4 + b], v[8 + b], v[12 + b]);
#pragma unroll
  for (int c = 1; c < 4; ++c)
#pragma unroll
    for (int b = 1; b < 4; ++b) {
      const float wr = w16c(b * c), wi = (float)SGN * w16s(b * c);
      const c2f t = v[4 * c + b];
      v[4 * c + b] = t.xx * (c2f){wr, wi} + t.yy * (c2f){-wi, wr};
    }
#pragma unroll
  for (int c = 0; c < 4; ++c) dft4<SGN>(v[4 * c], v[4 * c + 1], v[4 * c + 2], v[4 * c + 3]);
}
template <int SGN>
__device__ __forceinline__ void dft8(c2f (&v)[8]) {
  dft4<SGN>(v[0], v[2], v[4], v[6]);
  dft4<SGN>(v[1], v[3], v[5], v[7]);
#pragma unroll
  for (int c = 1; c < 4; ++c) {
    const float wr = w16c(2 * c), wi = (float)SGN * w16s(2 * c);
    const c2f t = v[2 * c + 1];
    v[2 * c + 1] = t.xx * (c2f){wr, wi} + t.yy * (c2f){-wi, wr};
  }
#pragma unroll
  for (int c = 0; c < 4; ++c) {
    const c2f t = v[2 * c], u = v[2 * c + 1];
    v[2 * c] = cadd(t, u);
    v[2 * c + 1] = csub(t, u);
  }
}
__device__ __forceinline__ void fft_tw_init(c2f* TW) {
  __syncthreads();
  {
    float s, c;
    sincospif((float)TID * (1.f / 128.f), &s, &c);
    TW[TID] = mk2(c, -s);
  }
  __syncthreads();
}
__device__ __forceinline__ c2f big_tw(int f1, int t2) {
  const float rev = (float)(f1 * t2) * (1.f / 32768.f);
  return mk2(__builtin_amdgcn_cosf(rev), -__builtin_amdgcn_sinf(rev));
}
__device__ __forceinline__ void ph_taps(const Params& p, int g, bf16_t* lds) {
  GEMM_IDS
  const bf16_t* A = (const bf16_t*)(p.ws + OFF_H3B);
  const bf16_t* W = (const bf16_t*)(p.ws + OFF_W4T);
  bf16_t* TP = (bf16_t*)(p.ws + (g ? OFF_TAPS1 : OFF_TAPS));
  bool primed = false;
  for (int t = BID; t < 128 * 16; t += GSZ) {
    const int tn = t & 15, tm = t >> 4;
    const int wrow = (tn < 8) ? (g * 1024 + tn * 128) : (2048 + g * 1024 + (tn - 8) * 128);
    f32x4 acc[4][4];
    acc_zero(acc);
    const bf16_t *nA = nullptr, *nB = nullptr;
    if (t + GSZ < 128 * 16) {
      const int t2 = t + GSZ, tn2 = t2 & 15, tm2 = t2 >> 4;
      const int wrow2 = (tn2 < 8) ? (g * 1024 + tn2 * 128) : (2048 + g * 1024 + (tn2 - 8) * 128);
      nA = A + (long)tm2 * 128 * 64;
      nB = W + (long)wrow2 * 64;
    }
    gemm_acc<true>(acc, A + (long)tm * 128 * 64, 64, W + (long)wrow * 64, 64, 64, lds, nA, nB, primed);
    primed = nA != nullptr;
#pragma unroll
    for (int mi = 0; mi < 4; ++mi) {
      const int m = tm * 128 + 64 * wm + 16 * mi + l15;
#pragma unroll
      for (int ni = 0; ni < 4; ++ni) {
        const int n = tn * 128 + 64 * wn + 16 * ni + 4 * l4;
        *(u32x2*)(TP + (long)m * 2048 + n) = pk4(acc[mi][ni]);
      }
    }
  }
}
constexpr float KSCALE = 2.0f;
__device__ __forceinline__ void ph_fft_a(const Params& p, int g, char* ldsc) {
  c2f* X = (c2f*)ldsc;
  c2f* TW = (c2f*)(ldsc + 65536);
  const bf16_t* z = (const bf16_t*)(p.ws + OFF_Z);
  const bf16_t* TP = (const bf16_t*)(p.ws + (g ? OFF_TAPS1 : OFF_TAPS));
  float* sumsq = (float*)(p.ws + OFF_SUMSQ);
  unsigned* S = (unsigned*)(p.ws + OFF_S);
  const int ch = TID & 31, rg = TID >> 5;
  fft_tw_init(TW);
  for (int it = BID; it < 4096; it += GSZ) {
    const int t2 = it & 127, cc = it >> 7;
    const int c = g * 1024 + cc * 32 + ch;
    __syncthreads();
    {
      const float dec = fabsf(p.decay[c]);
      float ssq = 0.f;
      unsigned short rz[16], rt[32];
#pragma unroll
      for (int i = 0; i < 16; ++i) rz[i] = z[(long)(128 * (rg + 8 * i) + t2) * D + c];
#pragma unroll
      for (int i = 0; i < 32; ++i) {
        const int half = i >> 4, t1 = half * 128 + rg + 8 * (i & 15), j = 128 * t1 + t2;
        int jj = half ? (32768 - j) : j;
        if (jj >= 16384) jj = 0;
        rt[i] = TP[(long)jj * 2048 + half * 1024 + cc * 32 + ch];
      }
      const float cdec = dec * (1.f / 16383.f);
      const float rho = __expf(-1024.f * cdec), rinv = __expf(1024.f * cdec);
      float w0 = __expf(-(float)(128 * rg + t2) * cdec);
      float w1 = __expf(-(float)(16384 - 128 * rg - t2) * cdec);
#pragma unroll
      for (int i = 0; i < 32; ++i) {
        const int half = i >> 4, t1 = half * 128 + rg + 8 * (i & 15);
        float val = bf2f(rt[i]) * (half ? w1 : w0);
        if (half) w1 *= rinv; else w0 *= rho;
        if (i == 16 && rg == 0 && t2 == 0) val = 0.f;
        ssq += val * val;
        const float zr = (i < 16) ? bf2f(rz[i & 15]) : 0.f;
        X[t1 * 32 + ch] = mk2(zr, val * KSCALE);
      }
      ((float*)(ldsc + 65536 + 2048))[TID] = ssq;
    }
    __syncthreads();
    if (TID < 32) {
      const float* red = (const float*)(ldsc + 65536 + 2048);
      float tot = 0.f;
#pragma unroll
      for (int r8 = 0; r8 < 8; ++r8) tot += red[r8 * 32 + TID];
      atomicAdd(&sumsq[c], tot);
    }
#pragma unroll 1
    for (int u = 0; u < 2; ++u) {
      const int j = rg + 8 * u;
      c2f v[16];
#pragma unroll
      for (int k = 0; k < 16; ++k) v[k] = X[(16 * k + j) * 32 + ch];
      dft16<-1>(v);
#pragma unroll
      for (int i = 0; i < 16; ++i) {
        const int q = (i >> 2) + 4 * (i & 3);
        X[(16 * q + j) * 32 + ch] = cmul(v[i], TW[(j * q) & 255]);
      }
    }
    __syncthreads();
#pragma unroll 1
    for (int u = 0; u < 2; ++u) {
      const int q = rg + 8 * u;
      c2f v[16];
#pragma unroll
      for (int j = 0; j < 16; ++j) v[j] = X[(16 * q + j) * 32 + ch];
      dft16<-1>(v);
      c2f twv[16];
      {
        const c2f st = big_tw(16, t2);
        twv[0] = big_tw(q, t2);
#pragma unroll
        for (int pp = 1; pp < 16; ++pp) twv[pp] = cmul(twv[pp - 1], st);
      }
#pragma unroll
      for (int i = 0; i < 16; ++i) {
        const int pp = (i >> 2) + 4 * (i & 3);
        const int r = 16 * q + pp;
        const c2f o = cmul(v[i], twv[pp]);
        S[((long)cc * 32768 + r * 128 + t2) * 32 + ch] = pk2(o.x, o.y);
      }
    }
  }
}
__device__ __forceinline__ void ph_fft_mid(const Params& p, char* lds_all) {
  const int hv = fresh_tid() >> 8;
  char* my = lds_all + hv * LDS_HALF;
  c2f* XS = (c2f*)my;
  c2f* TW = (c2f*)(my + 65536);
  unsigned* S = (unsigned*)(p.ws + OFF_S);
  const int ch = TID & 31, rg = TID >> 5;
  fft_tw_init(TW);
  unsigned rs[16];
  {
    const int pi0 = (int)blockIdx.x;
    const int P0 = pi0 & 127, cc0 = pi0 >> 7;
    const int f10 = (P0 == 0) ? (hv ? 128 : 0) : (hv ? 256 - P0 : P0);
    const int r0 = 16 * (f10 & 15) + (f10 >> 4);
    const long gb0 = ((long)cc0 * 32768 + r0 * 128) * 32 + ch;
#pragma unroll
    for (int k = 0; k < 16; ++k) rs[k] = S[gb0 + (8 * k + rg) * 32];
  }
  for (int pi = (int)blockIdx.x; pi < 4096; pi += (int)gridDim.x) {
    const int P = pi & 127, cc = pi >> 7;
    const int f1 = (P == 0) ? (hv ? 128 : 0) : (hv ? 256 - P : P);
    const int r = 16 * (f1 & 15) + (f1 >> 4);
    const long gbase = ((long)cc * 32768 + r * 128) * 32 + ch;
    const c2f* XP = (P == 0) ? (const c2f*)XS : (const c2f*)(lds_all + (hv ^ 1) * LDS_HALF);
    __syncthreads();
    {
      const int j = rg;
      c2f v[16];
#pragma unroll
      for (int k = 0; k < 16; ++k) { const unsigned w_ = rs[k]; v[k] = mk2(bf2f(w_ & 0xffffu), bf2f(w_ >> 16)); }
      dft16<-1>(v);
#pragma unroll
      for (int i = 0; i < 16; ++i) {
        const int q = (i >> 2) + 4 * (i & 3);
        XS[(8 * q + j) * 32 + ch] = cmul(v[i], TW[(2 * j * q) & 255]);
      }
    }
    {
      const int pin = pi + (int)gridDim.x;
      if (pin < 4096) {
        const int Pn = pin & 127, ccn = pin >> 7;
        const int f1n = (Pn == 0) ? (hv ? 128 : 0) : (hv ? 256 - Pn : Pn);
        const int rn = 16 * (f1n & 15) + (f1n >> 4);
        const long gbn = ((long)ccn * 32768 + rn * 128) * 32 + ch;
#pragma unroll
        for (int k = 0; k < 16; ++k) rs[k] = S[gbn + (8 * k + rg) * 32];
      }
    }
    __syncthreads();
    c2f a[2][8];
#pragma unroll
    for (int u = 0; u < 2; ++u) {
      const int q = rg + 8 * u;
#pragma unroll
      for (int j = 0; j < 8; ++j) a[u][j] = XS[(8 * q + j) * 32 + ch];
      dft8<-1>(a[u]);
#pragma unroll
      for (int pp = 0; pp < 8; ++pp) XS[(8 * q + pp) * 32 + ch] = a[u][2 * (pp & 3) + (pp >> 2)];
    }
    __syncthreads();
    c2f m[2][8];
#pragma unroll
    for (int u = 0; u < 2; ++u) {
      const int q = rg + 8 * u;
      const int sbase = (f1 != 0) ? (127 - 8 * q) : ((q > 0) ? (135 - 8 * q) : 8);
      const c2f* xpb = XP + sbase * 32 + ch;
      const c2f bw0 = (f1 == 0 && q == 0) ? XP[ch] : xpb[0];
#pragma unroll
      for (int pp = 0; pp < 8; ++pp) {
        const c2f bw = (pp == 0) ? bw0 : xpb[-32 * pp];
        const c2f aw = a[u][2 * (pp & 3) + (pp >> 2)];
        const c2f bc = (c2f){bw.x, -bw.y};
        const c2f dd = cmul(aw, aw) - cmul(bc, bc);
        m[u][pp] = (c2f){0.25f * dd.y, -0.25f * dd.x};
      }
      dft8<1>(m[u]);
    }
    __syncthreads();
#pragma unroll
    for (int u = 0; u < 2; ++u) {
      const int q = rg + 8 * u;
#pragma unroll
      for (int i = 0; i < 8; ++i) {
        const int j = (i >> 1) + 4 * (i & 1);
        XS[(8 * q + j) * 32 + ch] = cmulc(m[u][i], TW[(2 * q * j) & 255]);
      }
    }
    __syncthreads();
    {
      const int j = rg;
      c2f v[16];
#pragma unroll
      for (int q = 0; q < 16; ++q) v[q] = XS[(8 * q + j) * 32 + ch];
      dft16<1>(v);
      c2f twv[16];
      {
        const c2f st = big_tw(f1, 8);
        twv[0] = big_tw(f1, j);
#pragma unroll
        for (int k = 1; k < 16; ++k) twv[k] = cmul(twv[k - 1], st);
      }
#pragma unroll
      for (int i = 0; i < 16; ++i) {
        const int k = (i >> 2) + 4 * (i & 3);
        const int t2 = 8 * k + j;
        const c2f o = cmulc(v[i], twv[k]);
        S[gbase + t2 * 32] = pk2(o.x, o.y);
      }
    }
  }
}
__device__ __forceinline__ void ph_fft_c(const Params& p, int g, char* ldsc) {
  c2f* X = (c2f*)ldsc;
  c2f* TW = (c2f*)(ldsc + 65536);
  const unsigned* S = (const unsigned*)(p.ws + OFF_S);
  const bf16_t* z = (const bf16_t*)(p.ws + OFF_Z);
  bf16_t* x0 = (bf16_t*)(p.ws + OFF_X0);
  const float* sumsq = (const float*)(p.ws + OFF_SUMSQ);
  const int ch = TID & 31, rg = TID >> 5;
  fft_tw_init(TW);
  unsigned raw[2][16];
  {
    const int it0 = BID;
    const int t20 = it0 & 127, cc0 = it0 >> 7;
#pragma unroll
    for (int u = 0; u < 2; ++u)
#pragma unroll
      for (int pp = 0; pp < 16; ++pp) raw[u][pp] = S[((long)cc0 * 32768 + (16 * (rg + 8 * u) + pp) * 128 + t20) * 32 + ch];
  }
  for (int it = BID; it < 4096; it += GSZ) {
    const int t2 = it & 127, cc = it >> 7;
    const int c = g * 1024 + cc * 32 + ch;
    __syncthreads();
    unsigned short zz[2][8], xx[2][8];
#pragma unroll
    for (int u = 0; u < 2; ++u)
#pragma unroll
      for (int k = 0; k < 8; ++k) {
        const long gi = (long)(128 * (16 * k + rg + 8 * u) + t2) * D + c;
        zz[u][k] = z[gi];
        xx[u][k] = x0[gi];
      }
#pragma unroll
    for (int u = 0; u < 2; ++u) {
      const int q = rg + 8 * u;
      c2f v[16];
#pragma unroll
      for (int pp = 0; pp < 16; ++pp) { const unsigned w_ = raw[u][pp]; v[pp] = mk2(bf2f(w_ & 0xffffu), bf2f(w_ >> 16)); }
      dft16<1>(v);
#pragma unroll
      for (int i = 0; i < 16; ++i) {
        const int j = (i >> 2) + 4 * (i & 3);
        X[(16 * q + j) * 32 + ch] = cmulc(v[i], TW[(q * j) & 255]);
      }
    }
    {
      const int itn = it + GSZ;
      if (itn < 4096) {
        const int t2n = itn & 127, ccn = itn >> 7;
#pragma unroll
        for (int u = 0; u < 2; ++u)
#pragma unroll
          for (int pp = 0; pp < 16; ++pp) raw[u][pp] = S[((long)ccn * 32768 + (16 * (rg + 8 * u) + pp) * 128 + t2n) * 32 + ch];
      }
    }
    __syncthreads();
    const float nrm = rsqrtf(sumsq[c] + 1e-6f) * (1.f / (32768.f * KSCALE));
    const float sk = p.skip[c];
#pragma unroll
    for (int u = 0; u < 2; ++u) {
      const int j = rg + 8 * u;
      c2f v[16];
#pragma unroll
      for (int q = 0; q < 16; ++q) v[q] = X[(16 * q + j) * 32 + ch];
      dft16<1>(v);
#pragma unroll
      for (int i = 0; i < 16; ++i) {
        const int k = (i >> 2) + 4 * (i & 3);
        if (k < 8) {
          const int t1 = 16 * k + j;
          const long gi = (long)(128 * t1 + t2) * D + c;
          const float y = v[i].x * nrm + sk * bf2f(zz[u][k]);
          x0[gi] = f2bf(bf2f(xx[u][k]) * y);
        }
      }
    }
  }
}
__device__ __forceinline__ void ph_gemm_hyo(const Params& p, bf16_t* lds) {
  GEMM_IDS
  const bf16_t* A = (const bf16_t*)(p.ws + OFF_X0);
  const bf16_t* Bt = (const bf16_t*)(p.ws + OFF_WHO);
  bf16_t* ro = (bf16_t*)(p.ws + OFF_RETOUT);
  const bf16_t* gates = (const bf16_t*)(p.ws + OFF_GATES);
  bool primed = false;
  XCD_TILE_LOOP(t, 128 * 16) {
    int tm, tn;
    tile_map(t, 128, 16, tm, tn);
    f32x4 acc[4][4];
    acc_zero(acc);
#if !SKIP_HY
    const bf16_t *nA = nullptr, *nB = nullptr;
    if (t + (int)GSZ < 128 * 16) { int tm2, tn2; tile_map(t + GSZ, 128, 16, tm2, tn2); nA = A + (long)tm2 * 128 * D; nB = Bt + (long)tn2 * 128 * D; }
    gemm_acc<true>(acc, A + (long)tm * 128 * D, D, Bt + (long)tn * 128 * D, D, D, lds, nA, nB, primed);
    primed = nA != nullptr;
#endif
#pragma unroll
    for (int mi = 0; mi < 4; ++mi) {
      const int m = tm * 128 + 64 * wm + 16 * mi + l15;
#pragma unroll
      for (int ni = 0; ni < 4; ++ni) {
        const int n = tn * 128 + 64 * wn + 16 * ni + 4 * l4;
        const u32x2 r0 = *(const u32x2*)(ro + (long)m * D + n);
        const u32x2 g0 = *(const u32x2*)(gates + (long)m * 4096 + n);
        const u32x2 g1 = *(const u32x2*)(gates + (long)m * 4096 + 2048 + n);
        f32x4 o;
        o[0] = bf2f(g0.x & 0xffffu) * bf2f(r0.x & 0xffffu) + bf2f(g1.x & 0xffffu) * acc[mi][ni][0];
        o[1] = bf2f(g0.x >> 16) * bf2f(r0.x >> 16) + bf2f(g1.x >> 16) * acc[mi][ni][1];
        o[2] = bf2f(g0.y & 0xffffu) * bf2f(r0.y & 0xffffu) + bf2f(g1.y & 0xffffu) * acc[mi][ni][2];
        o[3] = bf2f(g0.y >> 16) * bf2f(r0.y >> 16) + bf2f(g1.y >> 16) * acc[mi][ni][3];
        *(u32x2*)(ro + (long)m * D + n) = pk4(o);
      }
    }
  }
}
__device__ __forceinline__ void ph_gemm_wout(const Params& p, bf16_t* lds) {
  GEMM_IDS
  const bf16_t* A = (const bf16_t*)(p.ws + OFF_RETOUT);
  const bf16_t* Bt = (const bf16_t*)(p.ws + OFF_WOUT);
  const float* gate = (const float*)(p.ws + OFF_MODS) + 5 * D;
  bool primed = false;
  XCD_TILE_LOOP(t, 128 * 16) {
    int tm, tn;
    tile_map(t, 128, 16, tm, tn);
    f32x4 acc[4][4];
    acc_zero(acc);
    const bf16_t *nA = nullptr, *nB = nullptr;
    if (t + (int)GSZ < 128 * 16) { int tm2, tn2; tile_map(t + GSZ, 128, 16, tm2, tn2); nA = A + (long)tm2 * 128 * D; nB = Bt + (long)tn2 * 128 * D; }
    gemm_acc<true>(acc, A + (long)tm * 128 * D, D, Bt + (long)tn * 128 * D, D, D, lds, nA, nB, primed);
    primed = nA != nullptr;
#pragma unroll
    for (int mi = 0; mi < 4; ++mi) {
      const int m = tm * 128 + 64 * wm + 16 * mi + l15;
#pragma unroll
      for (int ni = 0; ni < 4; ++ni) {
        const int n = tn * 128 + 64 * wn + 16 * ni + 4 * l4;
        float* op = p.out + (long)m * D + n;
        const f32x4 gt = *(const f32x4*)(gate + n);
        const f32x4 rs = *(const f32x4*)(op);
        *(f32x4*)(op) = rs + gt * acc[mi][ni];
      }
    }
  }
}


#define EPI_HEAD static constexpr bool PERM = false, AFTER_DRAIN = false;
typedef const f32x4 (&acc8_t)[2][2][4][2];
struct EpiSwiglu {
  EPI_HEAD
  bf16_t* H;
  __device__ __forceinline__ void operator()(acc8_t acc, const pg8::Unit& u, int wr, int wc, int fr, int fq) const {
#pragma unroll
    for (int ai = 0; ai < 2; ++ai)
#pragma unroll
      for (int m = 0; m < 4; ++m) {
        const int row = u.pm * 256 + ai * 128 + wr * 64 + m * 16 + fr;
#pragma unroll
        for (int n = 0; n < 2; ++n) {
          f32x4 o;
#pragma unroll
          for (int j = 0; j < 4; ++j) o[j] = silu_f(acc[ai][0][m][n][j]) * acc[ai][1][m][n][j];
          *(u32x2*)(H + (long)row * DFF + u.pn * 128 + wc * 32 + n * 16 + fq * 4) = pk4(o);
        }
      }
  }
};
struct EpiDown {
  EPI_HEAD
  const float* res; float* out; const float* gate;
  __device__ __forceinline__ void operator()(acc8_t acc, const pg8::Unit& u, int wr, int wc, int fr, int fq) const {
#pragma unroll
    for (int ai = 0; ai < 2; ++ai)
#pragma unroll
      for (int m = 0; m < 4; ++m) {
        const long ro = (long)(u.pm * 256 + ai * 128 + wr * 64 + m * 16 + fr) * D;
#pragma unroll
        for (int bj = 0; bj < 2; ++bj)
#pragma unroll
          for (int n = 0; n < 2; ++n) {
            const int col = u.pn * 256 + bj * 128 + wc * 32 + n * 16 + fq * 4;
            const f32x4 gt = *(const f32x4*)(gate + col);
            const f32x4 rs = *(const f32x4*)(res + ro + col);
            *(f32x4*)(out + ro + col) = rs + 0.5f * gt * acc[ai][bj][m][n];
          }
      }
  }
};
struct EpiPlain {
  EPI_HEAD
  bf16_t* C; int ldc;
  __device__ __forceinline__ void operator()(acc8_t acc, const pg8::Unit& u, int wr, int wc, int fr, int fq) const {
#pragma unroll
    for (int ai = 0; ai < 2; ++ai)
#pragma unroll
      for (int m = 0; m < 4; ++m) {
        const long ro = (long)(u.pm * 256 + ai * 128 + wr * 64 + m * 16 + fr) * ldc;
#pragma unroll
        for (int bj = 0; bj < 2; ++bj)
#pragma unroll
          for (int n = 0; n < 2; ++n) {
            const int col = u.pn * 256 + bj * 128 + wc * 32 + n * 16 + fq * 4;
            *(u32x2*)(C + ro + col) = pk4(acc[ai][bj][m][n]);
          }
      }
  }
};
struct EpiHyo {
  EPI_HEAD
  bf16_t* ro; const bf16_t* gates;
  __device__ __forceinline__ void operator()(acc8_t acc, const pg8::Unit& u, int wr, int wc, int fr, int fq) const {
#pragma unroll
    for (int ai = 0; ai < 2; ++ai)
#pragma unroll
      for (int m = 0; m < 4; ++m) {
        const long row = u.pm * 256 + ai * 128 + wr * 64 + m * 16 + fr;
#pragma unroll
        for (int bj = 0; bj < 2; ++bj)
#pragma unroll
          for (int n = 0; n < 2; ++n) {
            const int col = u.pn * 256 + bj * 128 + wc * 32 + n * 16 + fq * 4;
            const u32x2 r0 = *(const u32x2*)(ro + row * D + col);
            const u32x2 g0 = *(const u32x2*)(gates + row * 4096 + col);
            const u32x2 g1 = *(const u32x2*)(gates + row * 4096 + 2048 + col);
            const f32x4 a = acc[ai][bj][m][n];
            f32x4 o;
            o[0] = bf2f(g0.x & 0xffffu) * bf2f(r0.x & 0xffffu) + bf2f(g1.x & 0xffffu) * a[0];
            o[1] = bf2f(g0.x >> 16) * bf2f(r0.x >> 16) + bf2f(g1.x >> 16) * a[1];
            o[2] = bf2f(g0.y & 0xffffu) * bf2f(r0.y & 0xffffu) + bf2f(g1.y & 0xffffu) * a[2];
            o[3] = bf2f(g0.y >> 16) * bf2f(r0.y >> 16) + bf2f(g1.y >> 16) * a[3];
            *(u32x2*)(ro + row * D + col) = pk4(o);
          }
      }
  }
};
struct EpiWout {
  EPI_HEAD
  float* out; const float* gate;
  __device__ __forceinline__ void operator()(acc8_t acc, const pg8::Unit& u, int wr, int wc, int fr, int fq) const {
#pragma unroll
    for (int ai = 0; ai < 2; ++ai)
#pragma unroll
      for (int m = 0; m < 4; ++m) {
        const long ro = (long)(u.pm * 256 + ai * 128 + wr * 64 + m * 16 + fr) * D;
#pragma unroll
        for (int bj = 0; bj < 2; ++bj)
#pragma unroll
          for (int n = 0; n < 2; ++n) {
            const int col = u.pn * 256 + bj * 128 + wc * 32 + n * 16 + fq * 4;
            const f32x4 gt = *(const f32x4*)(gate + col);
            const f32x4 rs = *(const f32x4*)(out + ro + col);
            *(f32x4*)(out + ro + col) = rs + gt * acc[ai][bj][m][n];
          }
      }
  }
};
struct EpiWinA {
  EPI_HEAD
  bf16_t *q, *kk, *kTf, *kTb, *vT, *sg; const float2* rope; const float* lg;
  __device__ __forceinline__ void operator()(acc8_t acc, const pg8::Unit& u, int wr, int wc, int fr, int fq) const {
    const int pn = u.pn;
    if (pn < 8) {
      const bool isq = pn < 4;
      const int hh = wc >> 1, hf = wc & 1;
      const int head = 2 * (isq ? pn : pn - 4) + hh;
      const float scl = isq ? 0.08838834764831845f : 1.f;
      const float lgf = lg[head], lgb = lg[8 + head];
#pragma unroll
      for (int ai = 0; ai < 2; ++ai)
#pragma unroll
        for (int m = 0; m < 4; ++m) {
          const int t = u.pm * 256 + ai * 128 + wr * 64 + m * 16 + fr;
          const int pos = hf ? (t & 63) : (t >> 6);
          const int jc = t & 127;
          const float zf = __expf(lgf * (float)(127 - jc)), zb = __expf(lgb * (float)jc);
#pragma unroll
          for (int n = 0; n < 2; ++n) {
            const int i0 = 16 * n + 4 * fq;
            f32x4 o1, o2;
#pragma unroll
            for (int j = 0; j < 4; ++j) {
              const float2 cs = rope[pos * 32 + i0 + j];
              const float x1 = acc[ai][0][m][n][j] * scl, x2 = acc[ai][1][m][n][j] * scl;
              o1[j] = x1 * cs.x - x2 * cs.y;
              o2[j] = x1 * cs.y + x2 * cs.x;
            }
            const int cb = head * 128 + hf * 64 + i0;
            bf16_t* dp = (isq ? q : kk) + (long)t * 1024 + cb;
            *(u32x2*)(dp) = pk4(o1);
            *(u32x2*)(dp + 32) = pk4(o2);
            if (!isq) {
#pragma unroll
              for (int j = 0; j < 4; ++j) {
                kTf[(long)(cb + j) * TT + t] = f2bf(o1[j] * zf);
                kTb[(long)(cb + j) * TT + t] = f2bf(o1[j] * zb);
                kTf[(long)(cb + 32 + j) * TT + t] = f2bf(o2[j] * zf);
                kTb[(long)(cb + 32 + j) * TT + t] = f2bf(o2[j] * zb);
              }
            }
          }
        }
    } else if (pn < 16) {
#pragma unroll
      for (int ai = 0; ai < 2; ++ai)
#pragma unroll
        for (int m = 0; m < 4; ++m) {
          const int t = u.pm * 256 + ai * 128 + wr * 64 + m * 16 + fr;
#pragma unroll
          for (int bj = 0; bj < 2; ++bj)
#pragma unroll
            for (int n = 0; n < 2; ++n) {
              const int ch = (pn - 8) * 256 + bj * 128 + wc * 32 + n * 16 + fq * 4;
#pragma unroll
              for (int j = 0; j < 4; ++j) vT[(long)(ch + j) * TT + t] = f2bf(acc[ai][bj][m][n][j]);
            }
        }
    } else {
#pragma unroll
      for (int ai = 0; ai < 2; ++ai)
#pragma unroll
        for (int m = 0; m < 4; ++m) {
          const long t = u.pm * 256 + ai * 128 + wr * 64 + m * 16 + fr;
#pragma unroll
          for (int bj = 0; bj < 2; ++bj)
#pragma unroll
            for (int n = 0; n < 2; ++n) {
              const int col = (pn - 16) * 256 + bj * 128 + wc * 32 + n * 16 + fq * 4;
              f32x4 o;
#pragma unroll
              for (int j = 0; j < 4; ++j) o[j] = silu_f(acc[ai][bj][m][n][j]);
              *(u32x2*)(sg + t * D + col) = pk4(o);
            }
        }
    }
  }
};
struct EpiWinB {
  EPI_HEAD
  bf16_t *phy, *gates;
  __device__ __forceinline__ void operator()(acc8_t acc, const pg8::Unit& u, int wr, int wc, int fr, int fq) const {
    const int pn = u.pn;
#pragma unroll
    for (int ai = 0; ai < 2; ++ai)
#pragma unroll
      for (int m = 0; m < 4; ++m) {
        const long t = u.pm * 256 + ai * 128 + wr * 64 + m * 16 + fr;
#pragma unroll
        for (int bj = 0; bj < 2; ++bj)
#pragma unroll
          for (int n = 0; n < 2; ++n) {
            const int cl = bj * 128 + wc * 32 + n * 16 + fq * 4;
            if (pn < 48) {
              *(u32x2*)(phy + t * 6144 + (pn - 24) * 256 + cl) = pk4(acc[ai][bj][m][n]);
            } else {
              f32x4 o;
#pragma unroll
              for (int j = 0; j < 4; ++j) o[j] = sigm_f(acc[ai][bj][m][n][j]);
              *(u32x2*)(gates + t * 4096 + (pn - 48) * 256 + cl) = pk4(o);
            }
          }
      }
  }
};
template <class Epi>
__device__ __forceinline__ void big_gemm(char* lds_all, const bf16_t* A, const bf16_t* Bt, int K, int nM, int nN, int pn0, const Epi& E) {
  pg8::Gemm g;
  g.A = A; g.Bt = Bt; g.M = nM * 256; g.N = 0; g.K = K;
  pg8::TileOrder S;
  S.init(nM, nN, pn0, (int)gridDim.x, (int)blockIdx.x);
  pg8::gemm_phase(( __attribute__((address_space(3))) unsigned char*)lds_all, g, S, E);
}

__device__ __forceinline__ void ph_ctx_up(const Params& p, char* lds_all) {
  GEMM_IDS
  const int hv = fresh_tid() >> 8;
  bf16_t* lds = (bf16_t*)(lds_all + hv * LDS_HALF);
  u32x2* xch = (u32x2*)lds_all;
  const bf16_t* A = (const bf16_t*)(p.ws + OFF_AR) + (long)T * D;
  const bf16_t* Bt = (const bf16_t*)(p.ws + OFF_WBIG);
  bf16_t* H = (bf16_t*)(p.ws + OFF_H);
  for (int it = (int)blockIdx.x; it < 88; it += (int)gridDim.x) {
    const int tmc = it / 44, P = it % 44;
    f32x4 acc[4][4];
    acc_zero(acc);
    gemm_acc<true>(acc, A + (long)tmc * 128 * D, D, Bt + (long)(256 * P + 128 * hv) * D, D, D, lds);
    if (hv == 0) {
#pragma unroll
      for (int mi = 0; mi < 4; ++mi)
#pragma unroll
        for (int ni = 0; ni < 4; ++ni) {
          f32x4 o;
#pragma unroll
          for (int r = 0; r < 4; ++r) o[r] = silu_f(acc[mi][ni][r]);
          xch[(mi * 4 + ni) * 256 + TID] = pk4(o);
        }
    }
    __syncthreads();
    if (hv == 1) {
#pragma unroll
      for (int mi = 0; mi < 4; ++mi) {
        const int m = T + tmc * 128 + 64 * wm + 16 * mi + l15;
#pragma unroll
        for (int ni = 0; ni < 4; ++ni) {
          const int n = 128 * P + 64 * wn + 16 * ni + 4 * l4;
          const u32x2 w = xch[(mi * 4 + ni) * 256 + TID];
          f32x4 o;
          o[0] = bf2f(w.x & 0xffffu) * acc[mi][ni][0];
          o[1] = bf2f(w.x >> 16) * acc[mi][ni][1];
          o[2] = bf2f(w.y & 0xffffu) * acc[mi][ni][2];
          o[3] = bf2f(w.y >> 16) * acc[mi][ni][3];
          *(u32x2*)(H + (long)m * DFF + n) = pk4(o);
        }
      }
    }
  }
}
__device__ __forceinline__ void ph_ctx_down(const Params& p, bf16_t* lds) {
  GEMM_IDS
  const bf16_t* A = (const bf16_t*)(p.ws + OFF_H) + (long)T * DFF;
  const bf16_t* Bt = (const bf16_t*)(p.ws + OFF_WDOWN);
  const float* gate = (const float*)(p.ws + OFF_MODS) + NMOD + 2 * D;
  float* outc = (float*)(p.ws + OFF_CTX1);
  for (int it = BID; it < 128; it += GSZ) {
    const int ks = it & 3, tn = (it >> 2) & 15, tmc = it >> 6;
    f32x4 acc[4][4];
    acc_zero(acc);
    gemm_acc<true>(acc, A + (long)tmc * 128 * DFF + ks * 1408, DFF, Bt + (long)tn * 128 * DFF + ks * 1408, DFF, 1408, lds);
#pragma unroll
    for (int mi = 0; mi < 4; ++mi) {
      const int m = tmc * 128 + 64 * wm + 16 * mi + l15;
#pragma unroll
      for (int ni = 0; ni < 4; ++ni) {
        const int n = tn * 128 + 64 * wn + 16 * ni + 4 * l4;
        const f32x4 gt = *(const f32x4*)(gate + n);
#pragma unroll
        for (int r = 0; r < 4; ++r) atomicAdd(outc + (long)m * D + n + r, 0.5f * gt[r] * acc[mi][ni][r]);
      }
    }
  }
}
__device__ __forceinline__ void ph_ctx1_init(const Params& p) {
  f32x4* o = (f32x4*)(p.ws + OFF_CTX1);
  const f32x4* src = (const f32x4*)p.ctx;
  for (int i = BID * 256 + TID; i < 256 * D / 4; i += GSZ * 256) o[i] = src[i];
}
__device__ __forceinline__ void ph_ctx_win(const Params& p, char* lds_all) {
  GEMM_IDS
  const int hv = fresh_tid() >> 8;
  bf16_t* lds = (bf16_t*)(lds_all + hv * LDS_HALF);
  float* xacc = (float*)(lds_all + LDS_HALF);
  const bf16_t* A = (const bf16_t*)(p.ws + OFF_AR) + (long)T * D + hv * 1024;
  const bf16_t* Bt = (const bf16_t*)(p.ws + OFF_WBIG) + hv * 1024;
  bf16_t* kTf = (bf16_t*)(p.ws + OFF_KTF);
  bf16_t* kTb = (bf16_t*)(p.ws + OFF_KTB);
  bf16_t* vT = (bf16_t*)(p.ws + OFF_VT);
  for (int it = (int)blockIdx.x; it < 48; it += (int)gridDim.x) {
    f32x4 acc[4][4];
    acc_zero(acc);
    const bool isk = it < 16;
    const int u2 = it - 16;
    const int tmc = isk ? (it >> 3) : (u2 >> 4);
    const int kt8 = it & 7, tv = u2 & 15;
    if (isk)
      gemm_acc<true>(acc, A + (long)tmc * 128 * D, D, Bt + (long)(1024 + kt8 * 128) * D, D, 1024, lds);
    else
      gemm_acc<false>(acc, A + (long)tmc * 128 * D, D, Bt + (long)(2048 + tv * 128) * D, D, 1024, lds);
    if (hv == 1) {
#pragma unroll
      for (int mi = 0; mi < 4; ++mi)
#pragma unroll
        for (int ni = 0; ni < 4; ++ni) *(f32x4*)(xacc + ((mi * 4 + ni) * 256 + TID) * 4) = acc[mi][ni];
    }
    __syncthreads();
    if (hv == 0) {
#pragma unroll
      for (int mi = 0; mi < 4; ++mi)
#pragma unroll
        for (int ni = 0; ni < 4; ++ni) acc[mi][ni] += *(const f32x4*)(xacc + ((mi * 4 + ni) * 256 + TID) * 4);
      if (isk) {
        const int P = kt8 >> 1, sx = kt8 & 1;
        const int head = 2 * P + wn;
        const float lgf = p.lg[head], lgb = p.lg[8 + head];
#pragma unroll
        for (int mi = 0; mi < 4; ++mi) {
          const int m = T + tmc * 128 + 64 * wm + 16 * mi + l15;
          const int jc = m & 127;
          const float zf = __expf(lgf * (float)(127 - jc)), zb = __expf(lgb * (float)jc);
#pragma unroll
          for (int ni = 0; ni < 4; ++ni) {
            const int hf = ni >> 1, i0 = 16 * (ni & 1) + 4 * l4;
            const int cb = head * 128 + hf * 64 + i0 + 32 * sx;
#pragma unroll
            for (int r = 0; r < 4; ++r) {
              kTf[(long)(cb + r) * TT + m] = f2bf(acc[mi][ni][r] * zf);
              kTb[(long)(cb + r) * TT + m] = f2bf(acc[mi][ni][r] * zb);
            }
          }
        }
      } else {
#pragma unroll
        for (int mi = 0; mi < 4; ++mi) {
          const int m0 = T + tmc * 128 + 64 * wm + 16 * mi + 4 * l4;
#pragma unroll
          for (int ni = 0; ni < 4; ++ni) {
            const int ch = tv * 128 + 64 * wn + 16 * ni + l15;
            *(u32x2*)(vT + (long)ch * TT + m0) = pk4(acc[mi][ni]);
          }
        }
      }
    }
  }
}

#define XB_TMO      128
#define XB_XCNT(j)  (256  + 64 * (j))
#define XB_XSUB(j)  (1280 + 64 * (j))
#define XB_XGEN(j)  (2304 + 64 * (j))
#define XB_TOP      3328
#define XB_TOPGEN   3392
#define XCD_BAR_WORDS 3456
#define XB_SPIN_CAP (1u << 18)
#define LAS __attribute__((address_space(3)))

__device__ __forceinline__ unsigned xb_ld(unsigned* p)              { return __hip_atomic_load(p, __ATOMIC_RELAXED, __HIP_MEMORY_SCOPE_AGENT); }
__device__ __forceinline__ unsigned xb_add(unsigned* p, unsigned v) { return __hip_atomic_fetch_add(p, v, __ATOMIC_RELAXED, __HIP_MEMORY_SCOPE_AGENT); }
__device__ __forceinline__ unsigned xb_xcc_id() { return (unsigned)__builtin_amdgcn_s_getreg((3 << 11) | 20) & 0xFu; }
#define XB_SPIN(cond, bar) do { unsigned _sp = 0; while (cond) { __builtin_amdgcn_s_sleep(1); \
    if ((++_sp & 255u) == 0u) { if (xb_ld(&(bar)[XB_TMO])) break; if (_sp > XB_SPIN_CAP) { atomicAdd(&(bar)[XB_TMO], 1u); break; } } } } while (0)

struct XcdBarrier {
    unsigned* bar; unsigned x;
    volatile LAS unsigned* st;
};

__device__ __forceinline__ XcdBarrier xcd_barrier_post(unsigned* bar, volatile LAS unsigned* st) {
    XcdBarrier b; b.bar = bar; b.x = xb_xcc_id(); b.st = st;
    if (threadIdx.x == 0) (void)xb_add(&bar[XB_XCNT(b.x)], 1u);
    return b;
}
__device__ __forceinline__ void xcd_barrier_complete(unsigned* bar, unsigned x, unsigned& nloc, unsigned& nx) {
    const unsigned G = gridDim.x * gridDim.y * gridDim.z;
    unsigned sum, cnt, mine, sp = 0u;
    for (;;) {
        sum = 0u; cnt = 0u; mine = 0u;
#pragma unroll
        for (unsigned j = 0; j < 16; ++j) { const unsigned c = xb_ld(&bar[XB_XCNT(j)]); sum += c; cnt += (c > 0u) ? 1u : 0u; mine = (j == x) ? c : mine; }
        if (sum == G) break;
        __builtin_amdgcn_s_sleep(1);
        if ((++sp & 255u) == 0u) { if (xb_ld(&bar[XB_TMO])) break; if (sp > XB_SPIN_CAP) { atomicAdd(&bar[XB_TMO], 1u); break; } }
    }
    nloc = mine > 0u ? mine : 1u; nx = cnt > 0u ? cnt : 1u;
}

__device__ __forceinline__ void xcd_barrier(const XcdBarrier& b) {
    asm volatile("s_waitcnt vmcnt(0)" ::: "memory");
    __syncthreads();
    if (threadIdx.x == 0) {
        unsigned* bar = b.bar;
        __builtin_amdgcn_s_waitcnt(0);
        unsigned nloc = b.st[0], nx = b.st[1];
        if (nloc == 0u) { xcd_barrier_complete(bar, b.x, nloc, nx); b.st[0] = nloc; b.st[1] = nx; }
        const unsigned old = xb_add(&bar[XB_XSUB(b.x)], 1u);
        const unsigned gen = old / nloc;
        if (old + 1u == (gen + 1u) * nloc) {
            __builtin_amdgcn_fence(__ATOMIC_RELEASE, "agent");
            asm volatile("s_waitcnt vmcnt(0)" ::: "memory");
            const unsigned og = xb_add(&bar[XB_TOP], 1u);
            const unsigned tg = og / nx;
            if (og + 1u == (tg + 1u) * nx) xb_add(&bar[XB_TOPGEN], 1u);
            else XB_SPIN(xb_ld(&bar[XB_TOPGEN]) == tg, bar);
            __builtin_amdgcn_fence(__ATOMIC_ACQUIRE, "agent");
            xb_add(&bar[XB_XGEN(b.x)], 1u);
            asm volatile("s_waitcnt vmcnt(0)" ::: "memory");
        } else {
            XB_SPIN(xb_ld(&bar[XB_XGEN(b.x)]) == gen, bar);
            __builtin_amdgcn_fence(__ATOMIC_ACQUIRE, "agent");
            asm volatile("s_waitcnt vmcnt(0)" ::: "memory");
        }
    }
    __syncthreads();
}


__device__ __forceinline__ void gbar(unsigned* ctr, unsigned target) {
  asm volatile("s_waitcnt vmcnt(0) lgkmcnt(0)" ::: "memory");
  __syncthreads();
  if (threadIdx.x == 0) {
    __builtin_amdgcn_fence(__ATOMIC_RELEASE, "agent");
    asm volatile("s_waitcnt vmcnt(0)" ::: "memory");
    __hip_atomic_fetch_add(ctr, 1u, __ATOMIC_RELAXED, __HIP_MEMORY_SCOPE_AGENT);
    unsigned spins = 0;
    while (__hip_atomic_load(ctr, __ATOMIC_RELAXED, __HIP_MEMORY_SCOPE_AGENT) < target) {
      __builtin_amdgcn_s_sleep(2);
      if (++spins > (1u << 20)) break;
    }
    __builtin_amdgcn_fence(__ATOMIC_ACQUIRE, "agent");
    asm volatile("s_waitcnt vmcnt(0)" ::: "memory");
  }
  __syncthreads();
}
#ifndef SKIP_HY
#define SKIP_HY 0
#endif
#ifndef ONLY_NORM
#define ONLY_NORM 0
#endif
#ifndef SKIP_MIXER
#define SKIP_MIXER 0
#endif

__global__ void __launch_bounds__(512, 2) mega(Params p, int lo, int hi) {
  __shared__ __attribute__((aligned(1024))) char ldsc_all[LDS_BYTES];
#define ldsc (ldsc_all + (fresh_tid() >> 8) * LDS_HALF)
  cg::grid_group grid = cg::this_grid();
#define lds ((bf16_t*)ldsc)
#define ldsf ((float*)ldsc)
  char* ws = p.ws;
  volatile LAS unsigned* xb_st = (volatile LAS unsigned*)(ldsc_all + LDS_BYTES - 16);
  if (threadIdx.x == 0) { xb_st[0] = 0u; xb_st[1] = 0u; }
  __syncthreads();
  const XcdBarrier xb = xcd_barrier_post((unsigned*)(ws + OFF_BAR), xb_st);
#define PH(k, body) if (lo <= (k) && (k) < hi) { body; if ((k) + 1 < hi) xcd_barrier(xb); }
  if (lo < 0) grid.sync();
  PH(0, ph_mods_partial(p, ldsf))
  PH(2, ph_prenorm(p, p.x, p.ctx, TT, p.norm_g, 0);
        conv_weight(p.ffn_up, 2048, 11264, 11264, (bf16_t*)(ws + OFF_WBIG), 2, ldsf);
        conv_weight(p.ffn_down, 5632, 2048, 2048, (bf16_t*)(ws + OFF_WDOWN), 0, ldsf);
        conv_weight(p.w4, 64, 4096, 4096, (bf16_t*)(ws + OFF_W4T), 0, ldsf);
        conv_weight(p.w_ret_o, 2048, 2048, 2048, (bf16_t*)(ws + OFF_WRO), 0, ldsf);
        conv_weight(p.w_hy_o, 2048, 2048, 2048, (bf16_t*)(ws + OFF_WHO), 0, ldsf);
        conv_weight(p.w_out, 2048, 2048, 2048, (bf16_t*)(ws + OFF_WOUT), 0, ldsf);
        ph_misc0(p))
  PH(3, big_gemm(ldsc_all, (const bf16_t*)(ws + OFF_AR), (const bf16_t*)(ws + OFF_WBIG), 2048, 64, 44, 0, EpiSwiglu{(bf16_t*)(ws + OFF_H)});
        ph_ctx_up(p, ldsc_all); ph_ctx1_init(p))
  PH(4, big_gemm(ldsc_all, (const bf16_t*)(ws + OFF_H), (const bf16_t*)(ws + OFF_WDOWN), 5632, 64, 8, 0, EpiDown{p.x, p.out, (const float*)(ws + OFF_MODS) + 2 * D});
        ph_ctx_down(p, lds))
  PH(5, ph_prenorm(p, p.out, (const float*)(ws + OFF_CTX1), TT, p.norm_g + D, 1);
        conv_weight(p.w_in, 2048, 16384, 16384, (bf16_t*)(ws + OFF_WBIG), 3, ldsf))
#if !SKIP_MIXER
  PH(6, big_gemm(ldsc_all, (const bf16_t*)(ws + OFF_AR), (const bf16_t*)(ws + OFF_WBIG), 2048, 64, 24, 0,
                 EpiWinA{(bf16_t*)(ws + OFF_Q), (bf16_t*)(ws + OFF_K), (bf16_t*)(ws + OFF_KTF), (bf16_t*)(ws + OFF_KTB), (bf16_t*)(ws + OFF_VT), (bf16_t*)(ws + OFF_SG), (const float2*)(ws + OFF_ROPE), p.lg});
        ph_ctx_win(p, ldsc_all))
  PH(7, ph_ret_kv_p(p, lds))
  PH(8, ph_ret_scan(p))
  PH(9, ph_ret_out(p, ldsc_all))
  PH(11, big_gemm(ldsc_all, (const bf16_t*)(ws + OFF_Y), (const bf16_t*)(ws + OFF_WRO), 2048, 64, 8, 0, EpiPlain{(bf16_t*)(ws + OFF_RETOUT), D}))
  PH(12, big_gemm(ldsc_all, (const bf16_t*)(ws + OFF_AR), (const bf16_t*)(ws + OFF_WBIG), 2048, 64, 40, 24, EpiWinB{(bf16_t*)(ws + OFF_PHY), (bf16_t*)(ws + OFF_GATES)}))
#if !SKIP_HY
  PH(13, ph_hy_conv(p); ph_taps(p, 0, lds); ph_taps(p, 1, lds))
#endif
#if !SKIP_HY
  PH(15, ph_fft_a(p, 0, ldsc))
  PH(16, ph_fft_mid(p, ldsc_all))
  PH(17, ph_fft_c(p, 0, ldsc))
  PH(19, ph_fft_a(p, 1, ldsc))
  PH(20, ph_fft_mid(p, ldsc_all))
  PH(21, ph_fft_c(p, 1, ldsc))
#endif
  PH(26, big_gemm(ldsc_all, (const bf16_t*)(ws + OFF_X0), (const bf16_t*)(ws + OFF_WHO), 2048, 64, 8, 0, EpiHyo{(bf16_t*)(ws + OFF_RETOUT), (const bf16_t*)(ws + OFF_GATES)}))
  PH(27, big_gemm(ldsc_all, (const bf16_t*)(ws + OFF_RETOUT), (const bf16_t*)(ws + OFF_WOUT), 2048, 64, 8, 0, EpiWout{p.out, (const float*)(ws + OFF_MODS) + 5 * D}))
#endif
  PH(28, ph_prenorm(p, p.out, p.out, T, p.norm_g + 2 * D, 2);
         conv_weight(p.ffn_up + (long)2048 * 11264, 2048, 11264, 11264, (bf16_t*)(ws + OFF_WBIG), 2, ldsf);
         conv_weight(p.ffn_down + (long)5632 * 2048, 5632, 2048, 2048, (bf16_t*)(ws + OFF_WDOWN), 0, ldsf))
  PH(29, big_gemm(ldsc_all, (const bf16_t*)(ws + OFF_AR), (const bf16_t*)(ws + OFF_WBIG), 2048, 64, 44, 0, EpiSwiglu{(bf16_t*)(ws + OFF_H)}))
  PH(30, big_gemm(ldsc_all, (const bf16_t*)(ws + OFF_H), (const bf16_t*)(ws + OFF_WDOWN), 5632, 64, 8, 0, EpiDown{p.out, p.out, (const float*)(ws + OFF_MODS) + 8 * D}))
  PH(31, ph_final_norm(p))
}

extern "C" void kernel_launch(void* const* d_in, const int* in_sizes, int n_in, void* d_out, int out_size, void* d_ws,
                              size_t ws_size, hipStream_t stream) {
  if (ws_size < (size_t)WS_NEED || n_in < 29) {
    fprintf(stderr, "workspace too small: %zu\n", ws_size);
    return;
  }
  static int grid_blocks = 0;
  if (!grid_blocks) {
    int dev = 0, cus = 0, per_cu = 0;
    hipGetDevice(&dev);
    hipDeviceGetAttribute(&cus, hipDeviceAttributeMultiprocessorCount, dev);
    hipOccupancyMaxActiveBlocksPerMultiprocessor(&per_cu, mega, 512, 0);
    if (per_cu > 1) per_cu = 1;
    if (per_cu < 1) per_cu = 1;
    grid_blocks = cus * per_cu;
  }
  Params p{};
  const float** pp = (const float**)&p;
  for (int i = 0; i < 29; ++i) pp[i] = (const float*)d_in[i];
  p.out = (float*)d_out;
  p.ws = (char*)d_ws;
  hipMemsetAsync((char*)d_ws + OFF_BAR, 0, XCD_BAR_WORDS * 4, stream);
  hipMemsetAsync((char*)d_ws + OFF_MODS, 0, 2 * NMOD * 4, stream);
  int lo = 0, hi = NPH;
  void* args[] = {&p, &lo, &hi};
  hipError_t e = hipLaunchCooperativeKernel((void*)mega, dim3(grid_blocks), dim3(512), args, 0, stream);
  if (e != hipSuccess) fprintf(stderr, "cooperative launch failed: %s (grid %d)\n", hipGetErrorString(e), grid_blocks);
}
```

```cpp
#include <hip/hip_runtime.h>
#include <hip/hip_cooperative_groups.h>
#include <cstdio>
namespace cg = cooperative_groups;

typedef unsigned short bf16_t;
typedef short bf16x8 __attribute__((ext_vector_type(8)));
typedef float f32x4 __attribute__((ext_vector_type(4)));
typedef unsigned u32x2 __attribute__((ext_vector_type(2)));
typedef unsigned u32x4 __attribute__((ext_vector_type(4)));

__device__ __forceinline__ int fresh_tid() { int t = (int)threadIdx.x; asm volatile("" : "+v"(t)); return t; }
#define TID (fresh_tid() & 255)
#define BID ((int)(blockIdx.x * 2u) + (fresh_tid() >> 8))
#define GSZ ((int)(gridDim.x * 2u))
constexpr int T = 16384, TT = 16640, D = 2048, DFF = 5632;
constexpr long MiB = 1l << 20;
constexpr int NMOD = 18432;
constexpr long OFF_MODSPART = 0;
constexpr long OFF_MODS = 5 * MiB;
constexpr long OFF_SUMSQ = 5 * MiB + 512 * 1024;
constexpr long OFF_ROPE = 6 * MiB;
constexpr long OFF_BAR = 5 * MiB + 768 * 1024;
constexpr long OFF_CTX1 = 7 * MiB;
constexpr long OFF_H3B = 13 * MiB, OFF_W4T = 15 * MiB;
constexpr long OFF_TAPS = 104 * MiB, OFF_TAPS1 = 40 * MiB;
constexpr long OFF_WRO = 16 * MiB, OFF_WHO = 24 * MiB, OFF_WOUT = 32 * MiB;
constexpr long OFF_WBIG = 40 * MiB, OFF_WDOWN = 84 * MiB;
constexpr long OFF_AR = 106 * MiB;
constexpr long OFF_H = 171 * MiB;
constexpr long OFF_Q = 171 * MiB, OFF_K = 203 * MiB, OFF_KTF = 235 * MiB, OFF_KTB = 268 * MiB, OFF_VT = 301 * MiB,
               OFF_SG = 366 * MiB, OFF_KVT = 430 * MiB, OFF_P = 560 * MiB, OFF_Y = 592 * MiB;
constexpr long OFF_RETOUT = 171 * MiB, OFF_GATES = 235 * MiB, OFF_X0 = 363 * MiB, OFF_Z = 427 * MiB, OFF_PHY = 491 * MiB;
constexpr long OFF_S = 491 * MiB, OFF_KC = 40 * MiB;
constexpr long WS_NEED = 683 * MiB;
constexpr int LDS_HALF = 69632;
constexpr int LDS_BYTES = 2 * LDS_HALF;
constexpr int NPH = 32;
#ifndef SKIP_HY
#define SKIP_HY 0
#endif

struct Params {
  const float *x, *c, *ctx, *c_ctx, *w_ada, *b_ada, *norm_g, *ffn_up, *ffn_down, *w_in, *lg, *gn_g, *gn_b, *w_ret_o,
      *conv_w, *conv_b, *w1, *b1, *w2, *b2, *w3, *b3, *w4, *freq, *decay, *skip, *w_hy_o, *w_out, *fin_g;
  float* out;
  char* ws;
};

__device__ __forceinline__ float bf2f(unsigned h) { return __uint_as_float(h << 16); }
typedef float f32x2_t __attribute__((ext_vector_type(2)));
typedef __bf16 bf16x2_t __attribute__((ext_vector_type(2)));
__device__ __forceinline__ unsigned pk2(float lo, float hi) {
  const f32x2_t v = {lo, hi};
  const bf16x2_t b = __builtin_convertvector(v, bf16x2_t);
  return __builtin_bit_cast(unsigned, b);
}
__device__ __forceinline__ bf16_t f2bf(float f) { return (bf16_t)(pk2(f, 0.f) & 0xffffu); }
__device__ __forceinline__ u32x2 pk4(f32x4 v) {
  u32x2 r;
  r.x = pk2(v[0], v[1]);
  r.y = pk2(v[2], v[3]);
  return r;
}
__device__ __forceinline__ float wave_sum(float v) {
#pragma unroll
  for (int o = 32; o > 0; o >>= 1) v += __shfl_xor(v, o);
  return v;
}
__device__ __forceinline__ float silu_f(float v) { return v * __builtin_amdgcn_rcpf(1.f + __expf(-v)); }
__device__ __forceinline__ float sigm_f(float v) { return __builtin_amdgcn_rcpf(1.f + __expf(-v)); }

typedef __attribute__((address_space(3))) unsigned lds_u32_t;
template <bool SWAP>
__device__ __forceinline__ void gemm_acc(f32x4 (&acc)[4][4], const bf16_t* A, long lda, const bf16_t* Bt, long ldb, int K,
                                         bf16_t* lds, const bf16_t* nA = nullptr, const bf16_t* nB = nullptr,
                                         bool primed = false, long nlda = -1, long nldb = -1) {
  const int tid = TID, lane = tid & 63, w = tid >> 6, wm = w >> 1, wn = w & 1;
  char* ldsb = (char*)lds;
  const int chunk = (tid & 7) ^ ((tid >> 4) & 7);
  const int oa = (tid >> 3) * (int)lda + chunk * 8, ob = (tid >> 3) * (int)ldb + chunk * 8;
  const int sa = 32 * (int)lda, sb = 32 * (int)ldb;
  const int nk = K >> 6;
  if (!primed) {
    __syncthreads();
#pragma unroll
    for (int i = 0; i < 4; ++i) {
      __builtin_amdgcn_global_load_lds((const unsigned*)(A + (oa + i * sa)), (lds_u32_t*)(ldsb + tid * 16 + i * 4096), 16, 0, 0);
      __builtin_amdgcn_global_load_lds((const unsigned*)(Bt + (ob + i * sb)), (lds_u32_t*)(ldsb + 16384 + tid * 16 + i * 4096), 16, 0, 0);
    }
  }
  asm volatile("s_waitcnt vmcnt(0)" ::: "memory");
  __syncthreads();
  const int l15 = lane & 15, l4 = lane >> 4;
  const int o0 = l15 * 128 + ((l4 ^ (l15 >> 1)) << 4);
  for (int kt = 0; kt < nk; ++kt) {
    const int cur = kt & 1;
    if (kt + 1 < nk) {
      char* d = ldsb + (cur ^ 1) * 32768 + tid * 16;
#pragma unroll
      for (int i = 0; i < 4; ++i) {
        __builtin_amdgcn_global_load_lds((const unsigned*)(A + (oa + i * sa + (kt + 1) * 64)), (lds_u32_t*)(d + i * 4096), 16, 0, 0);
        __builtin_amdgcn_global_load_lds((const unsigned*)(Bt + (ob + i * sb + (kt + 1) * 64)), (lds_u32_t*)(d + 16384 + i * 4096), 16, 0, 0);
      }
    }
    const char* la = ldsb + cur * 32768 + (64 * wm) * 128;
    const char* lb = ldsb + cur * 32768 + 16384 + (64 * wn) * 128;
#pragma unroll
    for (int ks = 0; ks < 2; ++ks) {
      bf16x8 af[4], bfr[4];
#pragma unroll
      for (int i = 0; i < 4; ++i) {
        af[i] = *(const bf16x8*)(la + i * 2048 + (o0 ^ (ks * 64)));
        bfr[i] = *(const bf16x8*)(lb + i * 2048 + (o0 ^ (ks * 64)));
      }
#pragma unroll
      for (int mi = 0; mi < 4; ++mi)
#pragma unroll
        for (int ni = 0; ni < 4; ++ni) {
          if (SWAP)
            acc[mi][ni] = __builtin_amdgcn_mfma_f32_16x16x32_bf16(bfr[ni], af[mi], acc[mi][ni], 0, 0, 0);
          else
            acc[mi][ni] = __builtin_amdgcn_mfma_f32_16x16x32_bf16(af[mi], bfr[ni], acc[mi][ni], 0, 0, 0);
        }
    }
    asm volatile("s_waitcnt vmcnt(0)" ::: "memory");
    __syncthreads();
  }
  if (nA != nullptr) {
    const int la2 = (nlda < 0) ? (int)lda : (int)nlda, lb2 = (nldb < 0) ? (int)ldb : (int)nldb;
    const int oa2 = (tid >> 3) * la2 + chunk * 8, ob2 = (tid >> 3) * lb2 + chunk * 8;
#pragma unroll
    for (int i = 0; i < 4; ++i) {
      __builtin_amdgcn_global_load_lds((const unsigned*)(nA + (oa2 + i * 32 * la2)), (lds_u32_t*)(ldsb + tid * 16 + i * 4096), 16, 0, 0);
      __builtin_amdgcn_global_load_lds((const unsigned*)(nB + (ob2 + i * 32 * lb2)), (lds_u32_t*)(ldsb + 16384 + tid * 16 + i * 4096), 16, 0, 0);
    }
  }
}
__device__ __forceinline__ void acc_zero(f32x4 (&acc)[4][4]) {
#pragma unroll
  for (int i = 0; i < 4; ++i)
#pragma unroll
    for (int j = 0; j < 4; ++j) acc[i][j] = (f32x4){0.f, 0.f, 0.f, 0.f};
}
__device__ __forceinline__ void tile_map(int t, int ntm, int ntn, int& tm, int& tn) {
  const int GM = 8;
  const int per = GM * ntn;
  const int g = t / per, fm = g * GM;
  const int gsz = (ntm - fm) < GM ? (ntm - fm) : GM;
  const int rem = t - g * per;
  tn = rem / gsz;
  tm = fm + rem % gsz;
}

namespace pg8 {
#define PG8_LAS __attribute__((address_space(3)))
constexpr int BM = 256, BK = 64, HALF = 128, HTB = HALF * BK * 2  , STAGE_BYTES = 8 * HTB, NXCD = 8, WGM = 8;

__host__ __device__ __forceinline__ int lds_byte(int r, int c) { const int st = (r >> 4) * 2 + (c >> 5), rr = r & 15, cc = c & 31, ob = rr * 64 + cc * 2; return st * 1024 + (ob ^ (((ob >> 9) & 1) << 5)); }
__host__ __device__ __forceinline__ void stage_rc(int b, int& R, int& C) { const int st = b / 1024, sb = b % 1024, swz = sb ^ (((sb >> 9) & 1) << 5); R = (st >> 1) * 16 + swz / 64; C = (st & 1) * 32 + (swz % 64) / 2; }
__host__ __device__ __forceinline__ int perm32(int rho) { const int n = rho >> 4, i = rho & 15; return 8 * (i >> 2) + 4 * n + (i & 3); }

struct Unit { int pm, pn; };
struct Gemm { const bf16_t* A; const bf16_t* Bt; int M, N, K; };

struct TileOrder {
  int nM, nN, nwg, G, c, pn0;
  __device__ __forceinline__ void init(int nM_, int nN_, int pn0_, int G_, int c_) { nM = nM_; nN = nN_; nwg = nM_ * nN_; G = G_; c = c_; pn0 = pn0_; }
  __device__ __forceinline__ bool next(int i, Unit& u) const {
    const long L = (long)i * G + c;
    if (L >= nwg) return false;
    int wgid = (int)L;
    { const int q = nwg / NXCD, r = nwg % NXCD, xcd = wgid % NXCD, off = wgid / NXCD; wgid = (xcd < r ? xcd * (q + 1) : r * (q + 1) + (xcd - r) * q) + off; }
    const int nig = WGM * nN, gid = wgid / nig, fm = gid * WGM, gsz = (nM - fm) < WGM ? (nM - fm) : WGM;
    u.pm = fm + ((wgid % nig) % gsz);
    u.pn = pn0 + (wgid % nig) / gsz;
    return true;
  }
  __device__ __forceinline__ void a_ready(const Unit&) const {}
  __device__ __forceinline__ void done(const Unit&) const {}
};

template <class Epi, class Sched>
__device__ __forceinline__ void gemm_phase(PG8_LAS unsigned char* lds, const Gemm g, const Sched& S, const Epi& E) {
    const int tid = threadIdx.x, wid = __builtin_amdgcn_readfirstlane(tid >> 6), lane = tid & 63, wr = wid >> 2, wc = wid & 3, fr = lane & 15, fq = lane >> 4;
    const int K = g.K, nt = K / BK;
#define PG8_STAMP() do { } while (0)
    PG8_STAMP();
    unsigned voffA[2], voffB[2];
#pragma unroll
    for (int i = 0; i < 2; ++i) { int R, C; stage_rc(tid * 16 + i * 8192, R, C); const int Rb = Epi::PERM ? ((R & ~31) + perm32(R & 31)) : R;
        voffA[i] = (unsigned)(R * K + C) * 2u; voffB[i] = (unsigned)(Rb * K + C) * 2u; }
    const size_t kstep = (size_t)(BK * 2);
    const size_t hstep = (size_t)HALF * K * 2;
    const size_t tstep = 2 * hstep;
    const unsigned ldsw = (unsigned)wid * 1024u;
    const int aoff = lds_byte(wr * 64 + fr, fq * 8), boff = lds_byte(wc * 32 + fr, fq * 8);
#define PG8_SA(b, h) (((b) * 2 + (h)) * HTB)
#define PG8_SB(b, h) ((4 + (b) * 2 + (h)) * HTB)
#define PG8_STAGE(bufoff, gbase, voff) do { _Pragma("unroll") for (int _i = 0; _i < 2; ++_i) \
        __builtin_amdgcn_global_load_lds((const unsigned*)((const char*)(gbase) + (voff)[_i]), (PG8_LAS unsigned*)(lds + (bufoff) + ldsw + _i * 8192), 16, 0, 0); } while (0)
#define PG8_LDA(dst, b, h) do { _Pragma("unroll") for (int m = 0; m < 4; ++m) _Pragma("unroll") for (int k = 0; k < 2; ++k) dst[m][k] = *(const PG8_LAS bf16x8*)(lds + PG8_SA(b, h) + aoff + m * 2048 + k * 1024); } while (0)
#define PG8_LDB(dst, b, h) do { _Pragma("unroll") for (int n = 0; n < 2; ++n) _Pragma("unroll") for (int k = 0; k < 2; ++k) dst[n][k] = *(const PG8_LAS bf16x8*)(lds + PG8_SB(b, h) + boff + n * 2048 + k * 1024); } while (0)
#define PG8_MMA(ai, bj, At, Bt) do { __builtin_amdgcn_s_setprio(1); _Pragma("unroll") for (int m = 0; m < 4; ++m) _Pragma("unroll") for (int n = 0; n < 2; ++n) _Pragma("unroll") for (int k = 0; k < 2; ++k) \
        acc[ai][bj][m][n] = __builtin_amdgcn_mfma_f32_16x16x32_bf16(Bt[n][k], At[m][k], acc[ai][bj][m][n], 0, 0, 0); __builtin_amdgcn_s_setprio(0); } while (0)
#define PG8_WAIT_V(n) asm volatile("s_waitcnt vmcnt(" #n ")" ::: "memory")
#define PG8_WAIT_L(n) asm volatile("s_waitcnt lgkmcnt(" #n ")" ::: "memory")
#define PG8_BAR __builtin_amdgcn_s_barrier()
#define PG8_SCHED __builtin_amdgcn_sched_barrier(0)
    Unit cur, nxt; int ui = 0;
    if (!S.next(0, cur)) return;
    f32x4 acc[2][2][4][2];
#pragma unroll
    for (int a = 0; a < 2; ++a)
#pragma unroll
        for (int b = 0; b < 2; ++b)
#pragma unroll
            for (int m = 0; m < 4; ++m)
#pragma unroll
                for (int n = 0; n < 2; ++n) acc[a][b][m][n] = (f32x4){0.f, 0.f, 0.f, 0.f};
    bf16x8 At[4][2], B0[2][2], B1[2][2];
    const char* cA = (const char*)g.A + (size_t)cur.pm * tstep; const char* cB = (const char*)g.Bt + (size_t)cur.pn * tstep;
    S.a_ready(cur);
    PG8_STAGE(PG8_SB(0, 0), cB, voffB); PG8_STAGE(PG8_SA(0, 0), cA, voffA); PG8_STAGE(PG8_SB(0, 1), cB + hstep, voffB); PG8_STAGE(PG8_SA(0, 1), cA + hstep, voffA);
    if (wr == 1) PG8_BAR;
    PG8_WAIT_V(4); PG8_BAR;
    PG8_STAGE(PG8_SB(1, 0), cB + kstep, voffB); PG8_STAGE(PG8_SA(1, 0), cA + kstep, voffA); PG8_STAGE(PG8_SB(1, 1), cB + hstep + kstep, voffB);
    PG8_WAIT_V(6); PG8_BAR;
    PG8_STAMP();
    for (;;) {
        const bool has_next = S.next(ui + 1, nxt);
        const char* nA = has_next ? (const char*)g.A + (size_t)nxt.pm * tstep : cA; const char* nB = has_next ? (const char*)g.Bt + (size_t)nxt.pn * tstep : cB;
        for (int t = 0; t < nt; t += 2) {
            const bool last = (t == nt - 2);
            const char* a1 = cA + (size_t)(t + 1) * kstep;
            const char* a2 = last ? nA : cA + (size_t)(t + 2) * kstep; const char* b2 = last ? nB : cB + (size_t)(t + 2) * kstep;
            const char* a3 = a2 + kstep; const char* b3 = b2 + kstep;
            if (last && has_next) S.a_ready(nxt);
            PG8_LDB(B0, 0, 0); PG8_SCHED; PG8_LDA(At, 0, 0); PG8_STAGE(PG8_SA(1, 1), a1 + hstep, voffA);
            PG8_WAIT_L(8); PG8_BAR; PG8_WAIT_L(0); PG8_MMA(0, 0, At, B0); PG8_BAR; PG8_SCHED;
            PG8_LDB(B1, 0, 1); PG8_STAGE(PG8_SB(0, 0), b2, voffB);
            PG8_BAR; PG8_WAIT_L(0); PG8_MMA(0, 1, At, B1); PG8_BAR;
            PG8_LDA(At, 0, 1); PG8_STAGE(PG8_SA(0, 0), a2, voffA);
            PG8_BAR; PG8_WAIT_L(0); PG8_MMA(1, 0, At, B0); PG8_BAR; PG8_SCHED;
            PG8_STAGE(PG8_SB(0, 1), b2 + hstep, voffB);
            PG8_WAIT_V(6); PG8_BAR; PG8_MMA(1, 1, At, B1); PG8_BAR;
            PG8_LDB(B0, 1, 0); PG8_SCHED; PG8_LDA(At, 1, 0); PG8_STAGE(PG8_SA(0, 1), a2 + hstep, voffA);
            PG8_WAIT_L(8); PG8_BAR; PG8_WAIT_L(0); PG8_MMA(0, 0, At, B0); PG8_BAR; PG8_SCHED;
            PG8_LDB(B1, 1, 1); PG8_STAGE(PG8_SB(1, 0), b3, voffB);
            PG8_BAR; PG8_WAIT_L(0); PG8_MMA(0, 1, At, B1); PG8_BAR;
            PG8_LDA(At, 1, 1); PG8_STAGE(PG8_SA(1, 0), a3, voffA);
            PG8_BAR; PG8_WAIT_L(0); PG8_MMA(1, 0, At, B0); PG8_BAR; PG8_SCHED;
            PG8_STAGE(PG8_SB(1, 1), b3 + hstep, voffB);
            PG8_WAIT_V(6); PG8_BAR; PG8_MMA(1, 1, At, B1); PG8_BAR;
        }
        PG8_STAMP();
        if constexpr (!Epi::AFTER_DRAIN) { E(acc, cur, wr, wc, fr, fq); S.done(cur); }
        PG8_STAMP();
        if (!has_next) break;
#pragma unroll
        for (int a = 0; a < 2; ++a)
#pragma unroll
            for (int b = 0; b < 2; ++b)
#pragma unroll
                for (int m = 0; m < 4; ++m)
#pragma unroll
                    for (int n = 0; n < 2; ++n) acc[a][b][m][n] = (f32x4){0.f, 0.f, 0.f, 0.f};
        cur = nxt; cA = nA; cB = nB; ++ui;
    }
    PG8_WAIT_V(0);
    if (wr == 0) PG8_BAR;
    PG8_BAR;
    if constexpr (Epi::AFTER_DRAIN) { E.fused(acc, cur, wr, wc, fr, fq, lds, wid, lane); S.done(cur); }
    PG8_STAMP();
#undef PG8_STAMP
#undef PG8_SA
#undef PG8_SB
#undef PG8_STAGE
#undef PG8_LDA
#undef PG8_LDB
#undef PG8_MMA
#undef PG8_WAIT_V
#undef PG8_WAIT_L
#undef PG8_BAR
#undef PG8_SCHED
}
}
#define XCD_TILE_LOOP(t, ntiles)                                                                      \
  for (int t0_ = 0; t0_ < (ntiles); t0_ += GSZ)                                                        \
    if (const int t = t0_ + ((BID >> 1) & 7) * (GSZ >> 3) + (((BID >> 4) << 1) | (BID & 1)); t < (ntiles))
__device__ __forceinline__ void conv_weight(const float* src, int K, int ld, int N, bf16_t* dst, int mode, float* sm) {
  const int ntn = N >> 7, ntk = K >> 6;
  const int tid = TID;
  for (int t = BID; t < ntn * ntk; t += GSZ) {
    const int tn = t % ntn, tk = t / ntn;
    const int n0 = tn * 128, k0 = tk * 64;
    __syncthreads();
    {
      const int j = tid & 127, i = tid >> 7;
      const int n = n0 + j;
      int col = n;
      if (mode == 2) {
        const int P = n >> 8, c = n & 255;
        col = (c < 128) ? (128 * P + c) : (DFF + 128 * P + c - 128);
      } else if (mode == 3) {
        if (n < 2048) {
          const int P = n >> 8, c = n & 255, sx = c >> 7, c1 = c & 127;
          col = P * 256 + (c1 >> 6) * 128 + ((c1 >> 5) & 1) * 64 + (c1 & 31) + 32 * sx;
        }
      }
      float v[32];
#pragma unroll
      for (int r = 0; r < 32; ++r) v[r] = src[(long)(k0 + i + 2 * r) * ld + col];
#pragma unroll
      for (int r = 0; r < 32; ++r) sm[(i + 2 * r) * 129 + j] = v[r];
    }
    __syncthreads();
    {
      const int q = tid & 7, jj = tid >> 3;
#pragma unroll
      for (int r = 0; r < 4; ++r) {
        const int nn = jj + 32 * r;
        float v[8];
#pragma unroll
        for (int e = 0; e < 8; ++e) v[e] = sm[(q * 8 + e) * 129 + nn];
        u32x4 o;
        o.x = pk2(v[0], v[1]);
        o.y = pk2(v[2], v[3]);
        o.z = pk2(v[4], v[5]);
        o.w = pk2(v[6], v[7]);
        *(u32x4*)(dst + (long)(n0 + nn) * K + k0 + q * 8) = o;
      }
    }
  }
}

__device__ __forceinline__ void ph_mods_partial(const Params& p, float* sm) {
  float* part = (float*)(p.ws + OFF_MODSPART);
  for (int it = BID; it < 576; it += GSZ) {
    const int ks = it / 18, cch = it % 18;
    __syncthreads();
    if (TID < 128) {
      const int k = ks * 64 + (TID & 63);
      const float v = (TID < 64) ? p.c[k] : p.c_ctx[k];
      sm[TID] = v / (1.f + expf(-v));
    }
    __syncthreads();
    const int n = cch * 1024 + TID * 4;
    f32x4 a0 = (f32x4){0.f, 0.f, 0.f, 0.f}, a1 = a0;
    const float* wp = p.w_ada + (long)(ks * 64) * NMOD + n;
#pragma unroll 8
    for (int k = 0; k < 64; ++k) {
      const f32x4 w = *(const f32x4*)(wp + (long)k * NMOD);
      a0 += w * sm[k];
      a1 += w * sm[64 + k];
    }
    if (ks == 0) {
      const f32x4 bb = *(const f32x4*)(p.b_ada + n);
      a0 += bb;
      a1 += bb;
    }
    float* mods = (float*)(p.ws + OFF_MODS);
#pragma unroll
    for (int r = 0; r < 4; ++r) {
      atomicAdd(mods + n + r, a0[r]);
      atomicAdd(mods + NMOD + n + r, a1[r]);
    }
  }
}
__device__ __forceinline__ void ph_mods_reduce(const Params& p) {
  const float* part = (const float*)(p.ws + OFF_MODSPART);
  float* mods = (float*)(p.ws + OFF_MODS);
  for (int i = BID * 256 + TID; i < 2 * NMOD; i += GSZ * 256) {
    const int v = i / NMOD, n = i % NMOD;
    float s = p.b_ada[n];
    for (int ks = 0; ks < 32; ++ks) s += part[(long)(ks * 2 + v) * NMOD + n];
    mods[i] = s;
  }
}
__device__ __forceinline__ void ph_misc0(const Params& p) {
  float* sumsq = (float*)(p.ws + OFF_SUMSQ);
  float2* rope = (float2*)(p.ws + OFF_ROPE);
  bf16_t* h3 = (bf16_t*)(p.ws + OFF_H3B);
  const int gt = BID * 256 + TID, gs = GSZ * 256;
  for (int i = gt; i < 2048; i += gs) sumsq[i] = 0.f;
  for (int i = gt; i < 256 * 32; i += gs) {
    const int pos = i >> 5, k = i & 31;
    const float inv = exp2f(-(float)k * (13.287712379549449f / 32.f));
    const float ang = (float)pos * inv;
    rope[i] = make_float2(cosf(ang), sinf(ang));
  }
  const int lane = TID & 63;
  const int gw = BID * 4 + (TID >> 6), nw = GSZ * 4;
  const float fq = p.freq[lane];
  for (int j = gw; j < 16384; j += nw) {
    const float wj = (6.2831855f * (float)j) / 16384.f;
    float feat = 0.f;
    if (lane == 0)
      feat = (float)j / 16383.f;
    else if (lane <= 16) {
      const float f = 1e-4f + (float)(lane - 1) * ((15.f - 1e-4f) / 15.f);
      feat = cosf(f * wj);
    } else if (lane <= 32) {
      const float f = 1e-4f + (float)(lane - 17) * ((15.f - 1e-4f) / 15.f);
      feat = -sinf(f * wj);
    }
    float a = p.b1[lane];
    for (int e = 0; e < 33; ++e) a += __shfl(feat, e) * p.w1[e * 64 + lane];
    float h = sinf(fq * a);
    a = p.b2[lane];
    for (int k = 0; k < 64; ++k) a += __shfl(h, k) * p.w2[k * 64 + lane];
    h = sinf(fq * a);
    a = p.b3[lane];
    for (int k = 0; k < 64; ++k) a += __shfl(h, k) * p.w3[k * 64 + lane];
    h = sinf(fq * a);
    h3[j * 64 + lane] = f2bf(h);
  }
}
__device__ __forceinline__ void ph_prenorm(const Params& p, const float* xl, const float* xc, int rows, const float* g, int slot) {
  const float* mods = (const float*)(p.ws + OFF_MODS);
  bf16_t* A = (bf16_t*)(p.ws + OFF_AR);
  const int lane = TID & 63;
  const int gw = BID * 4 + (TID >> 6), nw = GSZ * 4;
  for (int r = gw; r < rows; r += nw) {
    const float* src = (r < T) ? xl + (long)r * D : xc + (long)(r - T) * D;
    const float* md = mods + ((r < T) ? 0 : NMOD);
    f32x4 v[8];
    float ss = 0.f;
#pragma unroll
    for (int i = 0; i < 8; ++i) {
      v[i] = *(const f32x4*)(src + i * 256 + lane * 4);
      ss += v[i][0] * v[i][0] + v[i][1] * v[i][1] + v[i][2] * v[i][2] + v[i][3] * v[i][3];
    }
    ss = wave_sum(ss);
    const float rstd = rsqrtf(ss * (1.f / 2048.f) + 1e-6f);
#pragma unroll
    for (int i = 0; i < 8; ++i) {
      const int c = i * 256 + lane * 4;
      const f32x4 gg = *(const f32x4*)(g + c);
      const f32x4 sh = *(const f32x4*)(md + (3 * slot) * D + c);
      const f32x4 sc = *(const f32x4*)(md + (3 * slot + 1) * D + c);
      const f32x4 y = v[i] * rstd * gg;
      const f32x4 o = y * (1.f + sc) + sh;
      *(u32x2*)(A + (long)r * D + c) = pk4(o);
    }
  }
}
__device__ __forceinline__ void ph_final_norm(const Params& p) {
  const int lane = TID & 63;
  const int gw = BID * 4 + (TID >> 6), nw = GSZ * 4;
  for (int r = gw; r < T; r += nw) {
    float* src = p.out + (long)r * D;
    f32x4 v[8];
    float ss = 0.f;
#pragma unroll
    for (int i = 0; i < 8; ++i) {
      v[i] = *(const f32x4*)(src + i * 256 + lane * 4);
      ss += v[i][0] * v[i][0] + v[i][1] * v[i][1] + v[i][2] * v[i][2] + v[i][3] * v[i][3];
    }
    ss = wave_sum(ss);
    const float rstd = rsqrtf(ss * (1.f / 2048.f) + 1e-6f);
#pragma unroll
    for (int i = 0; i < 8; ++i) {
      const int c = i * 256 + lane * 4;
      const f32x4 gg = *(const f32x4*)(p.fin_g + c);
      *(f32x4*)(src + c) = v[i] * rstd * gg;
    }
  }
}

#define GEMM_IDS                                                                       \
  const int lane = TID & 63, wv = TID >> 6, wm = wv >> 1, wn = wv & 1; \
  const int l15 = lane & 15, l4 = lane >> 4;                                           \
  (void)l15; (void)l4; (void)wm; (void)wn;

__device__ __forceinline__ void ph_gemm_up(const Params& p, int rows, bf16_t* lds) {
  GEMM_IDS
  const bf16_t* A = (const bf16_t*)(p.ws + OFF_AR);
  const bf16_t* Bt = (const bf16_t*)(p.ws + OFF_WBIG);
  bf16_t* H = (bf16_t*)(p.ws + OFF_H);
  const int ntm = rows >> 7, ntn = 88;
  bool primed = false;
  XCD_TILE_LOOP(t, ntm * ntn) {
    int tm, tn;
    tile_map(t, ntm, ntn, tm, tn);
    f32x4 acc[4][4];
    acc_zero(acc);
    const bf16_t *nA = nullptr, *nB = nullptr;
    if (t + (int)GSZ < ntm * ntn) { int tm2, tn2; tile_map(t + GSZ, ntm, ntn, tm2, tn2); nA = A + (long)tm2 * 128 * D; nB = Bt + (long)tn2 * 128 * D; }
    gemm_acc<true>(acc, A + (long)tm * 128 * D, D, Bt + (long)tn * 128 * D, D, D, lds, nA, nB, primed);
    primed = nA != nullptr;
#pragma unroll
    for (int mi = 0; mi < 4; ++mi) {
      const int m = tm * 128 + 64 * wm + 16 * mi + l15;
#pragma unroll
      for (int ni = 0; ni < 2; ++ni) {
        const int hc = (tn * 2 + wn) * 32 + 16 * ni + 4 * l4;
        f32x4 o;
#pragma unroll
        for (int r = 0; r < 4; ++r) o[r] = silu_f(acc[mi][ni][r]) * acc[mi][ni + 2][r];
        *(u32x2*)(H + (long)m * DFF + hc) = pk4(o);
      }
    }
  }
}
__device__ __forceinline__ void ph_gemm_down(const Params& p, int rows, int slot, const float* resl, const float* resc, float* outl, float* outc,
                             bf16_t* lds) {
  GEMM_IDS
  const bf16_t* A = (const bf16_t*)(p.ws + OFF_H);
  const bf16_t* Bt = (const bf16_t*)(p.ws + OFF_WDOWN);
  const float* mods = (const float*)(p.ws + OFF_MODS);
  const int ntm = rows >> 7, ntn = 16;
  bool primed = false;
  XCD_TILE_LOOP(t, ntm * ntn) {
    int tm, tn;
    tile_map(t, ntm, ntn, tm, tn);
    f32x4 acc[4][4];
    acc_zero(acc);
    const bf16_t *nA = nullptr, *nB = nullptr;
    if (t + (int)GSZ < ntm * ntn) { int tm2, tn2; tile_map(t + GSZ, ntm, ntn, tm2, tn2); nA = A + (long)tm2 * 128 * DFF; nB = Bt + (long)tn2 * 128 * DFF; }
    gemm_acc<true>(acc, A + (long)tm * 128 * DFF, DFF, Bt + (long)tn * 128 * DFF, DFF, DFF, lds, nA, nB, primed);
    primed = nA != nullptr;
    const bool lat = tm < 128;
    const float* gate = mods + (lat ? 0 : NMOD) + (3 * slot + 2) * D;
#pragma unroll
    for (int mi = 0; mi < 4; ++mi) {
      const int m = tm * 128 + 64 * wm + 16 * mi + l15;
      const float* rp = lat ? resl + (long)m * D : resc + (long)(m - T) * D;
      float* op = lat ? outl + (long)m * D : outc + (long)(m - T) * D;
#pragma unroll
      for (int ni = 0; ni < 4; ++ni) {
        const int n = tn * 128 + 64 * wn + 16 * ni + 4 * l4;
        const f32x4 gt = *(const f32x4*)(gate + n);
        const f32x4 rs = *(const f32x4*)(rp + n);
        *(f32x4*)(op + n) = rs + 0.5f * gt * acc[mi][ni];
      }
    }
  }
}
__device__ __forceinline__ void ph_gemm_plain(const bf16_t* A, const bf16_t* Bt, bf16_t* C, int M, int N, int K, bf16_t* lds) {
  GEMM_IDS
  const int ntm = M >> 7, ntn = N >> 7;
  bool primed = false;
  XCD_TILE_LOOP(t, ntm * ntn) {
    int tm, tn;
    tile_map(t, ntm, ntn, tm, tn);
    f32x4 acc[4][4];
    acc_zero(acc);
    const bf16_t *nA = nullptr, *nB = nullptr;
    if (t + (int)GSZ < ntm * ntn) { int tm2, tn2; tile_map(t + GSZ, ntm, ntn, tm2, tn2); nA = A + (long)tm2 * 128 * K; nB = Bt + (long)tn2 * 128 * K; }
    gemm_acc<true>(acc, A + (long)tm * 128 * K, K, Bt + (long)tn * 128 * K, K, K, lds, nA, nB, primed);
    primed = nA != nullptr;
#pragma unroll
    for (int mi = 0; mi < 4; ++mi) {
      const int m = tm * 128 + 64 * wm + 16 * mi + l15;
#pragma unroll
      for (int ni = 0; ni < 4; ++ni) {
        const int n = tn * 128 + 64 * wn + 16 * ni + 4 * l4;
        *(u32x2*)(C + (long)m * N + n) = pk4(acc[mi][ni]);
      }
    }
  }
}
__device__ __forceinline__ void ph_gemm_win_a(const Params& p, bf16_t* lds) {
  GEMM_IDS
  const bf16_t* A = (const bf16_t*)(p.ws + OFF_AR);
  const bf16_t* Bt = (const bf16_t*)(p.ws + OFF_WBIG);
  bf16_t* q = (bf16_t*)(p.ws + OFF_Q);
  bf16_t* kk = (bf16_t*)(p.ws + OFF_K);
  bf16_t* kTf = (bf16_t*)(p.ws + OFF_KTF);
  bf16_t* kTb = (bf16_t*)(p.ws + OFF_KTB);
  bf16_t* vT = (bf16_t*)(p.ws + OFF_VT);
  bf16_t* sg = (bf16_t*)(p.ws + OFF_SG);
  const float2* rope = (const float2*)(p.ws + OFF_ROPE);
  const int n_lat = 128 * 48, n_ctx = 2 * 24;
  XCD_TILE_LOOP(t, n_lat + n_ctx) {
    int tm, tn;
    if (t < n_lat)
      tile_map(t, 128, 48, tm, tn);
    else {
      const int u = t - n_lat;
      tm = 128 + u / 24;
      tn = 8 + u % 24;
    }
    f32x4 acc[4][4];
    acc_zero(acc);
    const bf16_t* Ap = A + (long)tm * 128 * D;
    const bf16_t* Bp = Bt + (long)tn * 128 * D;
    if (tn >= 16 && tn < 32) {
      gemm_acc<false>(acc, Ap, D, Bp, D, D, lds);
#pragma unroll
      for (int mi = 0; mi < 4; ++mi) {
        const int m0 = tm * 128 + 64 * wm + 16 * mi + 4 * l4;
#pragma unroll
        for (int ni = 0; ni < 4; ++ni) {
          const int ch = (tn - 16) * 128 + 64 * wn + 16 * ni + l15;
          *(u32x2*)(vT + (long)ch * TT + m0) = pk4(acc[mi][ni]);
        }
      }
    } else {
      gemm_acc<true>(acc, Ap, D, Bp, D, D, lds);
      if (tn < 8) {
        const float scl = 0.08838834764831845f;
#pragma unroll
        for (int mi = 0; mi < 4; ++mi) {
          const int m = tm * 128 + 64 * wm + 16 * mi + l15;
          const int pos = (wn == 0) ? (m >> 6) : (m & 63);
#pragma unroll
          for (int ni = 0; ni < 2; ++ni) {
            const int i0 = 16 * ni + 4 * l4;
            f32x4 o1, o2;
#pragma unroll
            for (int r = 0; r < 4; ++r) {
              const float2 cs = rope[pos * 32 + i0 + r];
              const float x1 = acc[mi][ni][r] * scl, x2 = acc[mi][ni + 2][r] * scl;
              o1[r] = x1 * cs.x - x2 * cs.y;
              o2[r] = x1 * cs.y + x2 * cs.x;
            }
            bf16_t* dp = q + (long)m * 1024 + tn * 128 + 64 * wn + i0;
            *(u32x2*)(dp) = pk4(o1);
            *(u32x2*)(dp + 32) = pk4(o2);
          }
        }
      } else if (tn < 16) {
        const int head = tn - 8;
        const float lgf = p.lg[head], lgb = p.lg[8 + head];
#pragma unroll
        for (int mi = 0; mi < 4; ++mi) {
          const int m = tm * 128 + 64 * wm + 16 * mi + l15;
          const bool lat = m < T;
          const int pos = (wn == 0) ? ((m >> 6) & 255) : (m & 63);
          const int j = m & 127;
          const float zf = __expf(lgf * (float)(127 - j)), zb = __expf(lgb * (float)j);
#pragma unroll
          for (int ni = 0; ni < 2; ++ni) {
            const int i0 = 16 * ni + 4 * l4;
            f32x4 o1, o2;
#pragma unroll
            for (int r = 0; r < 4; ++r) {
              float2 cs = rope[pos * 32 + i0 + r];
              if (!lat) cs = make_float2(1.f, 0.f);
              const float x1 = acc[mi][ni][r], x2 = acc[mi][ni + 2][r];
              o1[r] = x1 * cs.x - x2 * cs.y;
              o2[r] = x1 * cs.y + x2 * cs.x;
            }
            const int cb = head * 128 + 64 * wn + i0;
            if (lat) {
              bf16_t* dp = kk + (long)m * 1024 + cb;
              *(u32x2*)(dp) = pk4(o1);
              *(u32x2*)(dp + 32) = pk4(o2);
            }
#pragma unroll
            for (int r = 0; r < 4; ++r) {
              kTf[(long)(cb + r) * TT + m] = f2bf(o1[r] * zf);
              kTb[(long)(cb + r) * TT + m] = f2bf(o1[r] * zb);
              kTf[(long)(cb + 32 + r) * TT + m] = f2bf(o2[r] * zf);
              kTb[(long)(cb + 32 + r) * TT + m] = f2bf(o2[r] * zb);
            }
          }
        }
      } else {
#pragma unroll
        for (int mi = 0; mi < 4; ++mi) {
          const int m = tm * 128 + 64 * wm + 16 * mi + l15;
#pragma unroll
          for (int ni = 0; ni < 4; ++ni) {
            const int n = (tn - 32) * 128 + 64 * wn + 16 * ni + 4 * l4;
            f32x4 o;
#pragma unroll
            for (int r = 0; r < 4; ++r) o[r] = silu_f(acc[mi][ni][r]);
            *(u32x2*)(sg + (long)m * D + n) = pk4(o);
          }
        }
      }
    }
  }
}
__device__ __forceinline__ void ph_gemm_win_b(const Params& p, bf16_t* lds) {
  GEMM_IDS
  const bf16_t* A = (const bf16_t*)(p.ws + OFF_AR);
  const bf16_t* Bt = (const bf16_t*)(p.ws + OFF_WBIG);
  bf16_t* phy = (bf16_t*)(p.ws + OFF_PHY);
  bf16_t* gates = (bf16_t*)(p.ws + OFF_GATES);
  bool primed = false;
  XCD_TILE_LOOP(t, 128 * 80) {
    int tm, tn;
    tile_map(t, 128, 80, tm, tn);
    tn += 48;
    f32x4 acc[4][4];
    acc_zero(acc);
    const bf16_t *nA = nullptr, *nB = nullptr;
    if (t + (int)GSZ < 128 * 80) { int tm2, tn2; tile_map(t + GSZ, 128, 80, tm2, tn2); tn2 += 48; nA = A + (long)tm2 * 128 * D; nB = Bt + (long)tn2 * 128 * D; }
    gemm_acc<true>(acc, A + (long)tm * 128 * D, D, Bt + (long)tn * 128 * D, D, D, lds, nA, nB, primed);
    primed = nA != nullptr;
#pragma unroll
    for (int mi = 0; mi < 4; ++mi) {
      const int m = tm * 128 + 64 * wm + 16 * mi + l15;
#pragma unroll
      for (int ni = 0; ni < 4; ++ni) {
        const int nl = 64 * wn + 16 * ni + 4 * l4;
        if (tn < 96) {
          *(u32x2*)(phy + (long)m * 6144 + (tn - 48) * 128 + nl) = pk4(acc[mi][ni]);
        } else {
          f32x4 o;
#pragma unroll
          for (int r = 0; r < 4; ++r) o[r] = sigm_f(acc[mi][ni][r]);
          *(u32x2*)(gates + (long)m * 4096 + (tn - 96) * 128 + nl) = pk4(o);
        }
      }
    }
  }
}
__device__ __forceinline__ void ph_ret_kv_p(const Params& p, bf16_t* lds) {
  GEMM_IDS
  const bf16_t* q = (const bf16_t*)(p.ws + OFF_Q);
  const bf16_t* kk = (const bf16_t*)(p.ws + OFF_K);
  const bf16_t* kTf = (const bf16_t*)(p.ws + OFF_KTF);
  const bf16_t* kTb = (const bf16_t*)(p.ws + OFF_KTB);
  const bf16_t* vT = (const bf16_t*)(p.ws + OFF_VT);
  bf16_t* kvT = (bf16_t*)(p.ws + OFF_KVT);
  bf16_t* P = (bf16_t*)(p.ws + OFF_P);
  const int n1 = 130 * 8 * 2 * 2, n2 = 128 * 8;
  bool primed = false;
  for (int t = BID; t < n1; t += GSZ) {
    f32x4 acc[4][4];
    acc_zero(acc);
    {
      const int half = t & 1, d = (t >> 1) & 1, h = (t >> 2) & 7, ci = t >> 5;
      const bf16_t* Ap = vT + (long)(h * 256 + half * 128) * TT + ci * 128;
      const bf16_t* Bp = (d ? kTb : kTf) + (long)(h * 128) * TT + ci * 128;
      const bf16_t *nAp = nullptr, *nBp = nullptr;
      if (t + GSZ < n1) {
        const int t2 = t + GSZ, half2 = t2 & 1, d2 = (t2 >> 1) & 1, h2 = (t2 >> 2) & 7, ci2 = t2 >> 5;
        nAp = vT + (long)(h2 * 256 + half2 * 128) * TT + ci2 * 128;
        nBp = (d2 ? kTb : kTf) + (long)(h2 * 128) * TT + ci2 * 128;
      }
      gemm_acc<true>(acc, Ap, TT, Bp, TT, 128, lds, nAp, nBp, primed);
      primed = nAp != nullptr;
      bf16_t* o = kvT + ((long)(d * 130 + ci) * 8 + h) * 32768 + (long)(half * 128) * 128;
#pragma unroll
      for (int mi = 0; mi < 4; ++mi) {
        const int m = 64 * wm + 16 * mi + l15;
#pragma unroll
        for (int ni = 0; ni < 4; ++ni) {
          const int n = 64 * wn + 16 * ni + 4 * l4;
          *(u32x2*)(o + m * 128 + n) = pk4(acc[mi][ni]);
        }
      }
    }
  }
  bool primed2 = false;
  for (int u = BID; u < n2; u += GSZ) {
    f32x4 acc[4][4];
    acc_zero(acc);
    {
      const int h = u & 7, ci = u >> 3;
      const bf16_t* Ap = q + (long)ci * 128 * 1024 + h * 128;
      const bf16_t* Bp = kk + (long)ci * 128 * 1024 + h * 128;
      const bf16_t *nAp = nullptr, *nBp = nullptr;
      if (u + GSZ < n2) {
        const int u2 = u + GSZ, h2 = u2 & 7, ci2 = u2 >> 3;
        nAp = q + (long)ci2 * 128 * 1024 + h2 * 128;
        nBp = kk + (long)ci2 * 128 * 1024 + h2 * 128;
      }
      gemm_acc<true>(acc, Ap, 1024, Bp, 1024, 128, lds, nAp, nBp, primed2);
      primed2 = nAp != nullptr;
      const float lgf = p.lg[h], nlgb = -p.lg[8 + h];
      bf16_t* o = P + (long)(ci * 8 + h) * 16384;
#pragma unroll
      for (int mi = 0; mi < 4; ++mi) {
        const int a = 64 * wm + 16 * mi + l15;
#pragma unroll
        for (int ni = 0; ni < 4; ++ni) {
          const int b0 = 64 * wn + 16 * ni + 4 * l4;
          f32x4 ov;
#pragma unroll
          for (int r = 0; r < 4; ++r) {
            const int b = b0 + r;
            const int dd = a - b;
            const float dcy = (dd == 0) ? 2.f : __expf((dd > 0 ? lgf : nlgb) * (float)dd);
            ov[r] = acc[mi][ni][r] * dcy;
          }
          *(u32x2*)(o + a * 128 + b0) = pk4(ov);
        }
      }
    }
  }
}
__device__ __forceinline__ void ph_ret_scan(const Params& p) {
  unsigned* kv = (unsigned*)(p.ws + OFF_KVT);
  for (int it = BID * 256 + TID; it < 262144; it += GSZ * 256) {
    const int d = it >> 17, e2 = it & 131071, h = e2 >> 14, off = e2 & 16383;
    const float dec = expf(p.lg[d * 8 + h] * 128.f);
    unsigned* base = kv + ((long)d * 130 * 8 + h) * 16384 + off;
    float s0 = 0.f, s1 = 0.f;
    for (int sb = 0; sb < 130; sb += 10) {
      unsigned vv[10];
#pragma unroll
      for (int k = 0; k < 10; ++k) {
        const int step = sb + k;
        const int ci = (d == 0) ? ((step < 2) ? (128 + step) : (step - 2)) : (129 - step);
        vv[k] = base[(long)ci * 131072];
      }
#pragma unroll
      for (int k = 0; k < 10; ++k) {
        const int step = sb + k;
        const int ci = (d == 0) ? ((step < 2) ? (128 + step) : (step - 2)) : (129 - step);
        base[(long)ci * 131072] = pk2(s0, s1);
        s0 = s0 * dec + bf2f(vv[k] & 0xffffu);
        s1 = s1 * dec + bf2f(vv[k] >> 16);
      }
    }
  }
}
__device__ __forceinline__ void ph_ret_out(const Params& p, char* lds_all) {
  GEMM_IDS
  const int half = fresh_tid() >> 8;
  bf16_t* lds = (bf16_t*)(lds_all + half * LDS_HALF);
  float2* part = (float2*)(lds_all + 65536);
  const bf16_t* q = (const bf16_t*)(p.ws + OFF_Q);
  const bf16_t* vT = (const bf16_t*)(p.ws + OFF_VT);
  const bf16_t* kvT = (const bf16_t*)(p.ws + OFF_KVT);
  const bf16_t* P = (const bf16_t*)(p.ws + OFF_P);
  const bf16_t* sg = (const bf16_t*)(p.ws + OFF_SG);
  bf16_t* Y = (bf16_t*)(p.ws + OFF_Y);
  bool primed = false;
  for (int it = (int)blockIdx.x; it < 1024; it += (int)gridDim.x) {
    const int h = it & 7, ci = it >> 3;
    const float lgf = p.lg[h], lgb = p.lg[8 + h];
    f32x4 acc[4][4];
    acc_zero(acc);
    const bf16_t* Aq = q + (long)ci * 128 * 1024 + h * 128;
    const bf16_t* Sb = kvT + ((long)(130 + ci) * 8 + h) * 32768 + (long)(half * 128) * 128;
    const bf16_t* Sf = kvT + ((long)(ci)*8 + h) * 32768 + (long)(half * 128) * 128;
    const bf16_t* Ap = P + (long)(ci * 8 + h) * 16384;
    const bf16_t* Vp = vT + (long)(h * 256 + half * 128) * TT + ci * 128;
    const bf16_t *nAq = nullptr, *nSb = nullptr;
    if (it + (int)gridDim.x < 1024) {
      const int it2 = it + (int)gridDim.x, h2 = it2 & 7, ci2 = it2 >> 3;
      nAq = q + (long)ci2 * 128 * 1024 + h2 * 128;
      nSb = kvT + ((long)(130 + ci2) * 8 + h2) * 32768 + (long)(half * 128) * 128;
    }
    gemm_acc<true>(acc, Aq, 1024, Sb, 128, 128, lds, Aq, Sf, primed);
#pragma unroll
    for (int mi = 0; mi < 4; ++mi) {
      const int a = 64 * wm + 16 * mi + l15;
      const float ratio = __expf(lgb * (float)(128 - a) - lgf * (float)(a + 1));
#pragma unroll
      for (int ni = 0; ni < 4; ++ni) acc[mi][ni] *= ratio;
    }
    gemm_acc<true>(acc, Aq, 1024, Sf, 128, 128, lds, Ap, Vp, true, 128, TT);
#pragma unroll
    for (int mi = 0; mi < 4; ++mi) {
      const int a = 64 * wm + 16 * mi + l15;
      const float xf = __expf(lgf * (float)(a + 1));
#pragma unroll
      for (int ni = 0; ni < 4; ++ni) acc[mi][ni] *= xf;
    }
    gemm_acc<true>(acc, Ap, 128, Vp, TT, 128, lds, nAq, nSb, true, 1024, 128);
    primed = nAq != nullptr;
#pragma unroll
    for (int mi = 0; mi < 4; ++mi) {
      float s1 = 0.f, s2 = 0.f;
#pragma unroll
      for (int ni = 0; ni < 4; ++ni)
#pragma unroll
        for (int r = 0; r < 4; ++r) {
          const float v = acc[mi][ni][r];
          s1 += v;
          s2 += v * v;
        }
      s1 += __shfl_xor(s1, 16);
      s2 += __shfl_xor(s2, 16);
      s1 += __shfl_xor(s1, 32);
      s2 += __shfl_xor(s2, 32);
      if (l4 == 0) part[(half * 2 + wn) * 128 + 64 * wm + 16 * mi + l15] = make_float2(s1, s2);
    }
    __syncthreads();
#pragma unroll
    for (int mi = 0; mi < 4; ++mi) {
      const int a = 64 * wm + 16 * mi + l15;
      const float2 p0 = part[a], p1 = part[128 + a], p2 = part[256 + a], p3 = part[384 + a];
      const float mean = ((p0.x + p1.x) + (p2.x + p3.x)) * (1.f / 256.f);
      const float ex2 = ((p0.y + p1.y) + (p2.y + p3.y)) * (1.f / 256.f);
      const float rs = rsqrtf(fmaxf(ex2 - mean * mean, 0.f) + 1e-6f);
      const long t = (long)ci * 128 + a;
#pragma unroll
      for (int ni = 0; ni < 4; ++ni) {
        const int c = h * 256 + half * 128 + 64 * wn + 16 * ni + 4 * l4;
        const u32x2 graw = *(const u32x2*)(sg + t * D + c);
        const f32x4 gg = *(const f32x4*)(p.gn_g + c), gb = *(const f32x4*)(p.gn_b + c);
        f32x4 o;
        o[0] = ((acc[mi][ni][0] - mean) * rs * gg[0] + gb[0]) * bf2f(graw.x & 0xffffu);
        o[1] = ((acc[mi][ni][1] - mean) * rs * gg[1] + gb[1]) * bf2f(graw.x >> 16);
        o[2] = ((acc[mi][ni][2] - mean) * rs * gg[2] + gb[2]) * bf2f(graw.y & 0xffffu);
        o[3] = ((acc[mi][ni][3] - mean) * rs * gg[3] + gb[3]) * bf2f(graw.y >> 16);
        *(u32x2*)(Y + t * D + c) = pk4(o);
      }
    }
  }
}
__device__ __forceinline__ void ph_ret_gn(const Params& p) {
  bf16_t* Y = (bf16_t*)(p.ws + OFF_Y);
  const bf16_t* sg = (const bf16_t*)(p.ws + OFF_SG);
  const int lane = TID & 63;
  const int gw = BID * 4 + (TID >> 6), nw = GSZ * 4;
  for (int t = gw; t < T; t += nw) {
    u32x2 raw[8], graw[8];
#pragma unroll
    for (int h = 0; h < 8; ++h) {
      raw[h] = *(const u32x2*)(Y + (long)t * D + h * 256 + lane * 4);
      graw[h] = *(const u32x2*)(sg + (long)t * D + h * 256 + lane * 4);
    }
#pragma unroll
    for (int h = 0; h < 8; ++h) {
      const int c = h * 256 + lane * 4;
      float v[4] = {bf2f(raw[h].x & 0xffffu), bf2f(raw[h].x >> 16), bf2f(raw[h].y & 0xffffu), bf2f(raw[h].y >> 16)};
      const float mean = wave_sum(v[0] + v[1] + v[2] + v[3]) * (1.f / 256.f);
      float q = 0.f;
#pragma unroll
      for (int r = 0; r < 4; ++r) {
        v[r] -= mean;
        q += v[r] * v[r];
      }
      const float rs = rsqrtf(wave_sum(q) * (1.f / 256.f) + 1e-6f);
      const float gv[4] = {bf2f(graw[h].x & 0xffffu), bf2f(graw[h].x >> 16), bf2f(graw[h].y & 0xffffu), bf2f(graw[h].y >> 16)};
      const f32x4 gg = *(const f32x4*)(p.gn_g + c), gb = *(const f32x4*)(p.gn_b + c);
      f32x4 o;
#pragma unroll
      for (int r = 0; r < 4; ++r) o[r] = (v[r] * rs * gg[r] + gb[r]) * gv[r];
      *(u32x2*)(Y + (long)t * D + c) = pk4(o);
    }
  }
}
__device__ __forceinline__ void hy_conv_row(const u32x4 (&rm)[3], const u32x4 (&r0)[3], const u32x4 (&rp)[3], const float (&wv)[3][3][8],
                                            const float (&bv)[3][8], bf16_t* x0p, bf16_t* zp) {
  float u[3][8];
#pragma unroll
  for (int s3 = 0; s3 < 3; ++s3) {
#pragma unroll
    for (int e = 0; e < 8; ++e) u[s3][e] = bv[s3][e];
#pragma unroll
    for (int dt = 0; dt < 3; ++dt) {
      const u32x4 raw = (dt == 0) ? rm[s3] : ((dt == 1) ? r0[s3] : rp[s3]);
      const unsigned rw[4] = {raw.x, raw.y, raw.z, raw.w};
#pragma unroll
      for (int e = 0; e < 4; ++e) {
        u[s3][2 * e] += bf2f(rw[e] & 0xffffu) * wv[s3][dt][2 * e];
        u[s3][2 * e + 1] += bf2f(rw[e] >> 16) * wv[s3][dt][2 * e + 1];
      }
    }
  }
  u32x4 o0, oz;
  o0.x = pk2(u[0][0], u[0][1]);
  o0.y = pk2(u[0][2], u[0][3]);
  o0.z = pk2(u[0][4], u[0][5]);
  o0.w = pk2(u[0][6], u[0][7]);
  oz.x = pk2(u[1][0] * u[2][0], u[1][1] * u[2][1]);
  oz.y = pk2(u[1][2] * u[2][2], u[1][3] * u[2][3]);
  oz.z = pk2(u[1][4] * u[2][4], u[1][5] * u[2][5]);
  oz.w = pk2(u[1][6] * u[2][6], u[1][7] * u[2][7]);
  *(u32x4*)x0p = o0;
  *(u32x4*)zp = oz;
}
__device__ __forceinline__ void ph_hy_conv(const Params& p) {
  const bf16_t* phy = (const bf16_t*)(p.ws + OFF_PHY);
  bf16_t* x0 = (bf16_t*)(p.ws + OFF_X0);
  bf16_t* z = (bf16_t*)(p.ws + OFF_Z);
  const int c0 = TID * 8;
  float wv[3][3][8], bv[3][8];
#pragma unroll
  for (int s3 = 0; s3 < 3; ++s3) {
#pragma unroll
    for (int e = 0; e < 8; ++e) bv[s3][e] = p.conv_b[s3 * 2048 + c0 + e];
#pragma unroll
    for (int dt = 0; dt < 3; ++dt)
#pragma unroll
      for (int e = 0; e < 8; ++e) wv[s3][dt][e] = p.conv_w[dt * 6144 + s3 * 2048 + c0 + e];
  }
  const int nrows = T / GSZ;
  const int t0 = BID * nrows;
  u32x4 w0[3], w1[3], w2[3], w3[3], n0[3], n1[3];
#define HYC_LD(dst, tt)                                                                                   \
  {                                                                                                       \
    const int tt_ = (tt);                                                                                 \
    _Pragma("unroll") for (int s3 = 0; s3 < 3; ++s3)                                                      \
      dst[s3] = (tt_ >= 0 && tt_ < T) ? *(const u32x4*)(phy + (long)tt_ * 6144 + s3 * 2048 + c0) : (u32x4){0u, 0u, 0u, 0u}; \
  }
  HYC_LD(w0, t0 - 1)
  HYC_LD(w1, t0)
  HYC_LD(w2, t0 + 1)
  HYC_LD(w3, t0 + 2)
  for (int k = 0; k < nrows; k += 2) {
    const int t = t0 + k;
    HYC_LD(n0, t + 3)
    HYC_LD(n1, t + 4)
    hy_conv_row(w0, w1, w2, wv, bv, x0 + (long)t * D + c0, z + (long)t * D + c0);
    hy_conv_row(w1, w2, w3, wv, bv, x0 + (long)(t + 1) * D + c0, z + (long)(t + 1) * D + c0);
#pragma unroll
    for (int s3 = 0; s3 < 3; ++s3) { w0[s3] = w2[s3]; w1[s3] = w3[s3]; w2[s3] = n0[s3]; w3[s3] = n1[s3]; }
  }
#undef HYC_LD
}

typedef float c2f __attribute__((ext_vector_type(2)));
__device__ __forceinline__ c2f mk2(float a, float b) { return (c2f){a, b}; }
__device__ __forceinline__ c2f cmul(c2f a, c2f b) { return a.xx * b + a.yy * (c2f){-b.y, b.x}; }
__device__ __forceinline__ c2f cmulc(c2f a, c2f b) { return a.xx * (c2f){b.x, -b.y} + a.yy * (c2f){b.y, b.x}; }
__device__ __forceinline__ c2f cadd(c2f a, c2f b) { return a + b; }
__device__ __forceinline__ c2f csub(c2f a, c2f b) { return a - b; }
__device__ __forceinline__ constexpr float w16c(int m) {
  m &= 15;
  return m == 0 ? 1.f : m == 1 ? 0.92387953251f : m == 2 ? 0.70710678119f : m == 3 ? 0.38268343237f : m == 4 ? 0.f
       : m == 5 ? -0.38268343237f : m == 6 ? -0.70710678119f : m == 7 ? -0.92387953251f : m == 8 ? -1.f
       : m == 9 ? -0.92387953251f : m == 10 ? -0.70710678119f : m == 11 ? -0.38268343237f : m == 12 ? 0.f
       : m == 13 ? 0.38268343237f : m == 14 ? 0.70710678119f : 0.92387953251f;
}
__device__ __forceinline__ constexpr float w16s(int m) { return w16c(m - 4); }
template <int SGN>
__device__ __forceinline__ void dft4(c2f& a0, c2f& a1, c2f& a2, c2f& a3) {
  const c2f s02 = cadd(a0, a2), d02 = csub(a0, a2), s13 = cadd(a1, a3), d13 = csub(a1, a3);
  const c2f jd = mk2(-(float)SGN * d13.y, (float)SGN * d13.x);
  a0 = cadd(s02, s13);
  a1 = cadd(d02, jd);
  a2 = csub(s02, s13);
  a3 = csub(d02, jd);
}
template <int SGN>
__device__ __forceinline__ void dft16(c2f (&v)[16]) {
#pragma unroll
  for (int b = 0; b < 4; ++b) dft4<SGN>(v[b], v[4 + b], v[8 + b], v[12 + b]);
#pragma unroll
  for (int c = 1; c < 4; ++c)
#pragma unroll
    for (int b = 1; b < 4; ++b) {
      const float wr = w16c(b * c), wi = (float)SGN * w16s(b * c);
      const c2f t = v[4 * c + b];
      v[4 * c + b] = t.xx * (c2f){wr, wi} + t.yy * (c2f){-wi, wr};
    }
#pragma unroll
  for (int c = 0; c < 4; ++c) dft4<SGN>(v[4 * c], v[4 * c + 1], v[4 * c + 2], v[4 * c + 3]);
}
template <int SGN>
__device__ __forceinline__ void dft8(c2f (&v)[8]) {
  dft4<SGN>(v[0], v[2], v[4], v[6]);
  dft4<SGN>(v[1], v[3], v[5], v[7]);
#pragma unroll
  for (int c = 1; c < 4; ++c) {
    const float wr = w16c(2 * c), wi = (float)SGN * w16s(2 * c);
    const c2f t = v[2 * c + 1];
    v[2 * c + 1] = t.xx * (c2f){wr, wi} + t.yy * (c2f){-wi, wr};
  }
#pragma unroll
  for (int c = 0; c < 4; ++c) {
    const c2f t = v[2 * c], u = v[2 * c + 1];
    v[2 * c] = cadd(t, u);
    v[2 * c + 1] = csub(t, u);
  }
}
__device__ __forceinline__ void fft_tw_init(c2f* TW) {
  __syncthreads();
  {
    float s, c;
    sincospif((float)TID * (1.f / 128.f), &s, &c);
    TW[TID] = mk2(c, -s);
  }
  __syncthreads();
}
__device__ __forceinline__ c2f big_tw(int f1, int t2) {
  const float rev = (float)(f1 * t2) * (1.f / 32768.f);
  return mk2(__builtin_amdgcn_cosf(rev), -__builtin_amdgcn_sinf(rev));
}
__device__ __forceinline__ void ph_taps(const Params& p, int g, bf16_t* lds) {
  GEMM_IDS
  const bf16_t* A = (const bf16_t*)(p.ws + OFF_H3B);
  const bf16_t* W = (const bf16_t*)(p.ws + OFF_W4T);
  bf16_t* TP = (bf16_t*)(p.ws + (g ? OFF_TAPS1 : OFF_TAPS));
  bool primed = false;
  for (int t = BID; t < 128 * 16; t += GSZ) {
    const int tn = t & 15, tm = t >> 4;
    const int wrow = (tn < 8) ? (g * 1024 + tn * 128) : (2048 + g * 1024 + (tn - 8) * 128);
    f32x4 acc[4][4];
    acc_zero(acc);
    const bf16_t *nA = nullptr, *nB = nullptr;
    if (t + GSZ < 128 * 16) {
      const int t2 = t + GSZ, tn2 = t2 & 15, tm2 = t2 >> 4;
      const int wrow2 = (tn2 < 8) ? (g * 1024 + tn2 * 128) : (2048 + g * 1024 + (tn2 - 8) * 128);
      nA = A + (long)tm2 * 128 * 64;
      nB = W + (long)wrow2 * 64;
    }
    gemm_acc<true>(acc, A + (long)tm * 128 * 64, 64, W + (long)wrow * 64, 64, 64, lds, nA, nB, primed);
    primed = nA != nullptr;
#pragma unroll
    for (int mi = 0; mi < 4; ++mi) {
      const int m = tm * 128 + 64 * wm + 16 * mi + l15;
#pragma unroll
      for (int ni = 0; ni < 4; ++ni) {
        const int n = tn * 128 + 64 * wn + 16 * ni + 4 * l4;
        *(u32x2*)(TP + (long)m * 2048 + n) = pk4(acc[mi][ni]);
      }
    }
  }
}
constexpr float KSCALE = 2.0f;
__device__ __forceinline__ void ph_fft_a(const Params& p, int g, char* ldsc) {
  c2f* X = (c2f*)ldsc;
  c2f* TW = (c2f*)(ldsc + 65536);
  const bf16_t* z = (const bf16_t*)(p.ws + OFF_Z);
  const bf16_t* TP = (const bf16_t*)(p.ws + (g ? OFF_TAPS1 : OFF_TAPS));
  float* sumsq = (float*)(p.ws + OFF_SUMSQ);
  unsigned* S = (unsigned*)(p.ws + OFF_S);
  const int ch = TID & 31, rg = TID >> 5;
  fft_tw_init(TW);
  for (int it = BID; it < 4096; it += GSZ) {
    const int t2 = it & 127, cc = it >> 7;
    const int c = g * 1024 + cc * 32 + ch;
    __syncthreads();
    {
      const float dec = fabsf(p.decay[c]);
      float ssq = 0.f;
      unsigned short rz[16], rt[32];
#pragma unroll
      for (int i = 0; i < 16; ++i) rz[i] = z[(long)(128 * (rg + 8 * i) + t2) * D + c];
#pragma unroll
      for (int i = 0; i < 32; ++i) {
        const int half = i >> 4, t1 = half * 128 + rg + 8 * (i & 15), j = 128 * t1 + t2;
        int jj = half ? (32768 - j) : j;
        if (jj >= 16384) jj = 0;
        rt[i] = TP[(long)jj * 2048 + half * 1024 + cc * 32 + ch];
      }
      const float cdec = dec * (1.f / 16383.f);
      const float rho = __expf(-1024.f * cdec), rinv = __expf(1024.f * cdec);
      float w0 = __expf(-(float)(128 * rg + t2) * cdec);
      float w1 = __expf(-(float)(16384 - 128 * rg - t2) * cdec);
#pragma unroll
      for (int i = 0; i < 32; ++i) {
        const int half = i >> 4, t1 = half * 128 + rg + 8 * (i & 15);
        float val = bf2f(rt[i]) * (half ? w1 : w0);
        if (half) w1 *= rinv; else w0 *= rho;
        if (i == 16 && rg == 0 && t2 == 0) val = 0.f;
        ssq += val * val;
        const float zr = (i < 16) ? bf2f(rz[i & 15]) : 0.f;
        X[t1 * 32 + ch] = mk2(zr, val * KSCALE);
      }
      ((float*)(ldsc + 65536 + 2048))[TID] = ssq;
    }
    __syncthreads();
    if (TID < 32) {
      const float* red = (const float*)(ldsc + 65536 + 2048);
      float tot = 0.f;
#pragma unroll
      for (int r8 = 0; r8 < 8; ++r8) tot += red[r8 * 32 + TID];
      atomicAdd(&sumsq[c], tot);
    }
#pragma unroll
    for (int u = 0; u < 2; ++u) {
      const int j = rg + 8 * u;
      c2f v[16];
#pragma unroll
      for (int k = 0; k < 16; ++k) v[k] = X[(16 * k + j) * 32 + ch];
      dft16<-1>(v);
#pragma unroll
      for (int i = 0; i < 16; ++i) {
        const int q = (i >> 2) + 4 * (i & 3);
        X[(16 * q + j) * 32 + ch] = cmul(v[i], TW[(j * q) & 255]);
      }
    }
    __syncthreads();
#pragma unroll
    for (int u = 0; u < 2; ++u) {
      const int q = rg + 8 * u;
      c2f v[16];
#pragma unroll
      for (int j = 0; j < 16; ++j) v[j] = X[(16 * q + j) * 32 + ch];
      dft16<-1>(v);
      c2f twv[16];
      {
        const c2f st = big_tw(16, t2);
        twv[0] = big_tw(q, t2);
#pragma unroll
        for (int pp = 1; pp < 16; ++pp) twv[pp] = cmul(twv[pp - 1], st);
      }
#pragma unroll
      for (int i = 0; i < 16; ++i) {
        const int pp = (i >> 2) + 4 * (i & 3);
        const int r = 16 * q + pp;
        const c2f o = cmul(v[i], twv[pp]);
        S[((long)cc * 32768 + r * 128 + t2) * 32 + ch] = pk2(o.x, o.y);
      }
    }
  }
}
__device__ __forceinline__ void ph_fft_mid(const Params& p, char* lds_all) {
  const int hv = fresh_tid() >> 8;
  char* my = lds_all + hv * LDS_HALF;
  c2f* XS = (c2f*)my;
  c2f* TW = (c2f*)(my + 65536);
  unsigned* S = (unsigned*)(p.ws + OFF_S);
  const int ch = TID & 31, rg = TID >> 5;
  fft_tw_init(TW);
  unsigned rs[16];
  {
    const int pi0 = (int)blockIdx.x;
    const int P0 = pi0 & 127, cc0 = pi0 >> 7;
    const int f10 = (P0 == 0) ? (hv ? 128 : 0) : (hv ? 256 - P0 : P0);
    const int r0 = 16 * (f10 & 15) + (f10 >> 4);
    const long gb0 = ((long)cc0 * 32768 + r0 * 128) * 32 + ch;
#pragma unroll
    for (int k = 0; k < 16; ++k) rs[k] = S[gb0 + (8 * k + rg) * 32];
  }
  for (int pi = (int)blockIdx.x; pi < 4096; pi += (int)gridDim.x) {
    const int P = pi & 127, cc = pi >> 7;
    const int f1 = (P == 0) ? (hv ? 128 : 0) : (hv ? 256 - P : P);
    const int r = 16 * (f1 & 15) + (f1 >> 4);
    const long gbase = ((long)cc * 32768 + r * 128) * 32 + ch;
    const c2f* XP = (P == 0) ? (const c2f*)XS : (const c2f*)(lds_all + (hv ^ 1) * LDS_HALF);
    __syncthreads();
    {
      const int j = rg;
      c2f v[16];
#pragma unroll
      for (int k = 0; k < 16; ++k) { const unsigned w_ = rs[k]; v[k] = mk2(bf2f(w_ & 0xffffu), bf2f(w_ >> 16)); }
      dft16<-1>(v);
#pragma unroll
      for (int i = 0; i < 16; ++i) {
        const int q = (i >> 2) + 4 * (i & 3);
        XS[(8 * q + j) * 32 + ch] = cmul(v[i], TW[(2 * j * q) & 255]);
      }
    }
    {
      const int pin = pi + (int)gridDim.x;
      if (pin < 4096) {
        const int Pn = pin & 127, ccn = pin >> 7;
        const int f1n = (Pn == 0) ? (hv ? 128 : 0) : (hv ? 256 - Pn : Pn);
        const int rn = 16 * (f1n & 15) + (f1n >> 4);
        const long gbn = ((long)ccn * 32768 + rn * 128) * 32 + ch;
#pragma unroll
        for (int k = 0; k < 16; ++k) rs[k] = S[gbn + (8 * k + rg) * 32];
      }
    }
    __syncthreads();
    c2f a[2][8];
#pragma unroll
    for (int u = 0; u < 2; ++u) {
      const int q = rg + 8 * u;
#pragma unroll
      for (int j = 0; j < 8; ++j) a[u][j] = XS[(8 * q + j) * 32 + ch];
      dft8<-1>(a[u]);
#pragma unroll
      for (int pp = 0; pp < 8; ++pp) XS[(8 * q + pp) * 32 + ch] = a[u][2 * (pp & 3) + (pp >> 2)];
    }
    __syncthreads();
    c2f m[2][8];
#pragma unroll
    for (int u = 0; u < 2; ++u) {
      const int q = rg + 8 * u;
      const int sbase = (f1 != 0) ? (127 - 8 * q) : ((q > 0) ? (135 - 8 * q) : 8);
      const c2f* xpb = XP + sbase * 32 + ch;
      const c2f bw0 = (f1 == 0 && q == 0) ? XP[ch] : xpb[0];
#pragma unroll
      for (int pp = 0; pp < 8; ++pp) {
        const c2f bw = (pp == 0) ? bw0 : xpb[-32 * pp];
        const c2f aw = a[u][2 * (pp & 3) + (pp >> 2)];
        const c2f bc = (c2f){bw.x, -bw.y};
        const c2f dd = cmul(aw, aw) - cmul(bc, bc);
        m[u][pp] = (c2f){0.25f * dd.y, -0.25f * dd.x};
      }
      dft8<1>(m[u]);
    }
    __syncthreads();
#pragma unroll
    for (int u = 0; u < 2; ++u) {
      const int q = rg + 8 * u;
#pragma unroll
      for (int i = 0; i < 8; ++i) {
        const int j = (i >> 1) + 4 * (i & 1);
        XS[(8 * q + j) * 32 + ch] = cmulc(m[u][i], TW[(2 * q * j) & 255]);
      }
    }
    __syncthreads();
    {
      const int j = rg;
      c2f v[16];
#pragma unroll
      for (int q = 0; q < 16; ++q) v[q] = XS[(8 * q + j) * 32 + ch];
      dft16<1>(v);
      c2f twv[16];
      {
        const c2f st = big_tw(f1, 8);
        twv[0] = big_tw(f1, j);
#pragma unroll
        for (int k = 1; k < 16; ++k) twv[k] = cmul(twv[k - 1], st);
      }
#pragma unroll
      for (int i = 0; i < 16; ++i) {
        const int k = (i >> 2) + 4 * (i & 3);
        const int t2 = 8 * k + j;
        const c2f o = cmulc(v[i], twv[k]);
        S[gbase + t2 * 32] = pk2(o.x, o.y);
      }
    }
  }
}
__device__ __forceinline__ void ph_fft_c(const Params& p, int g, char* ldsc) {
  c2f* X = (c2f*)ldsc;
  c2f* TW = (c2f*)(ldsc + 65536);
  const unsigned* S = (const unsigned*)(p.ws + OFF_S);
  const bf16_t* z = (const bf16_t*)(p.ws + OFF_Z);
  bf16_t* x0 = (bf16_t*)(p.ws + OFF_X0);
  const float* sumsq = (const float*)(p.ws + OFF_SUMSQ);
  const int ch = TID & 31, rg = TID >> 5;
  fft_tw_init(TW);
  unsigned raw[2][16];
  {
    const int it0 = BID;
    const int t20 = it0 & 127, cc0 = it0 >> 7;
#pragma unroll
    for (int u = 0; u < 2; ++u)
#pragma unroll
      for (int pp = 0; pp < 16; ++pp) raw[u][pp] = S[((long)cc0 * 32768 + (16 * (rg + 8 * u) + pp) * 128 + t20) * 32 + ch];
  }
  for (int it = BID; it < 4096; it += GSZ) {
    const int t2 = it & 127, cc = it >> 7;
    const int c = g * 1024 + cc * 32 + ch;
    __syncthreads();
    unsigned short zz[2][8], xx[2][8];
#pragma unroll
    for (int u = 0; u < 2; ++u)
#pragma unroll
      for (int k = 0; k < 8; ++k) {
        const long gi = (long)(128 * (16 * k + rg + 8 * u) + t2) * D + c;
        zz[u][k] = z[gi];
        xx[u][k] = x0[gi];
      }
#pragma unroll
    for (int u = 0; u < 2; ++u) {
      const int q = rg + 8 * u;
      c2f v[16];
#pragma unroll
      for (int pp = 0; pp < 16; ++pp) { const unsigned w_ = raw[u][pp]; v[pp] = mk2(bf2f(w_ & 0xffffu), bf2f(w_ >> 16)); }
      dft16<1>(v);
#pragma unroll
      for (int i = 0; i < 16; ++i) {
        const int j = (i >> 2) + 4 * (i & 3);
        X[(16 * q + j) * 32 + ch] = cmulc(v[i], TW[(q * j) & 255]);
      }
    }
    {
      const int itn = it + GSZ;
      if (itn < 4096) {
        const int t2n = itn & 127, ccn = itn >> 7;
#pragma unroll
        for (int u = 0; u < 2; ++u)
#pragma unroll
          for (int pp = 0; pp < 16; ++pp) raw[u][pp] = S[((long)ccn * 32768 + (16 * (rg + 8 * u) + pp) * 128 + t2n) * 32 + ch];
      }
    }
    __syncthreads();
    const float nrm = rsqrtf(sumsq[c] + 1e-6f) * (1.f / (32768.f * KSCALE));
    const float sk = p.skip[c];
#pragma unroll
    for (int u = 0; u < 2; ++u) {
      const int j = rg + 8 * u;
      c2f v[16];
#pragma unroll
      for (int q = 0; q < 16; ++q) v[q] = X[(16 * q + j) * 32 + ch];
      dft16<1>(v);
#pragma unroll
      for (int i = 0; i < 16; ++i) {
        const int k = (i >> 2) + 4 * (i & 3);
        if (k < 8) {
          const int t1 = 16 * k + j;
          const long gi = (long)(128 * t1 + t2) * D + c;
          const float y = v[i].x * nrm + sk * bf2f(zz[u][k]);
          x0[gi] = f2bf(bf2f(xx[u][k]) * y);
        }
      }
    }
  }
}
__device__ __forceinline__ void ph_gemm_hyo(const Params& p, bf16_t* lds) {
  GEMM_IDS
  const bf16_t* A = (const bf16_t*)(p.ws + OFF_X0);
  const bf16_t* Bt = (const bf16_t*)(p.ws + OFF_WHO);
  bf16_t* ro = (bf16_t*)(p.ws + OFF_RETOUT);
  const bf16_t* gates = (const bf16_t*)(p.ws + OFF_GATES);
  bool primed = false;
  XCD_TILE_LOOP(t, 128 * 16) {
    int tm, tn;
    tile_map(t, 128, 16, tm, tn);
    f32x4 acc[4][4];
    acc_zero(acc);
#if !SKIP_HY
    const bf16_t *nA = nullptr, *nB = nullptr;
    if (t + (int)GSZ < 128 * 16) { int tm2, tn2; tile_map(t + GSZ, 128, 16, tm2, tn2); nA = A + (long)tm2 * 128 * D; nB = Bt + (long)tn2 * 128 * D; }
    gemm_acc<true>(acc, A + (long)tm * 128 * D, D, Bt + (long)tn * 128 * D, D, D, lds, nA, nB, primed);
    primed = nA != nullptr;
#endif
#pragma unroll
    for (int mi = 0; mi < 4; ++mi) {
      const int m = tm * 128 + 64 * wm + 16 * mi + l15;
#pragma unroll
      for (int ni = 0; ni < 4; ++ni) {
        const int n = tn * 128 + 64 * wn + 16 * ni + 4 * l4;
        const u32x2 r0 = *(const u32x2*)(ro + (long)m * D + n);
        const u32x2 g0 = *(const u32x2*)(gates + (long)m * 4096 + n);
        const u32x2 g1 = *(const u32x2*)(gates + (long)m * 4096 + 2048 + n);
        f32x4 o;
        o[0] = bf2f(g0.x & 0xffffu) * bf2f(r0.x & 0xffffu) + bf2f(g1.x & 0xffffu) * acc[mi][ni][0];
        o[1] = bf2f(g0.x >> 16) * bf2f(r0.x >> 16) + bf2f(g1.x >> 16) * acc[mi][ni][1];
        o[2] = bf2f(g0.y & 0xffffu) * bf2f(r0.y & 0xffffu) + bf2f(g1.y & 0xffffu) * acc[mi][ni][2];
        o[3] = bf2f(g0.y >> 16) * bf2f(r0.y >> 16) + bf2f(g1.y >> 16) * acc[mi][ni][3];
        *(u32x2*)(ro + (long)m * D + n) = pk4(o);
      }
    }
  }
}
__device__ __forceinline__ void ph_gemm_wout(const Params& p, bf16_t* lds) {
  GEMM_IDS
  const bf16_t* A = (const bf16_t*)(p.ws + OFF_RETOUT);
  const bf16_t* Bt = (const bf16_t*)(p.ws + OFF_WOUT);
  const float* gate = (const float*)(p.ws + OFF_MODS) + 5 * D;
  bool primed = false;
  XCD_TILE_LOOP(t, 128 * 16) {
    int tm, tn;
    tile_map(t, 128, 16, tm, tn);
    f32x4 acc[4][4];
    acc_zero(acc);
    const bf16_t *nA = nullptr, *nB = nullptr;
    if (t + (int)GSZ < 128 * 16) { int tm2, tn2; tile_map(t + GSZ, 128, 16, tm2, tn2); nA = A + (long)tm2 * 128 * D; nB = Bt + (long)tn2 * 128 * D; }
    gemm_acc<true>(acc, A + (long)tm * 128 * D, D, Bt + (long)tn * 128 * D, D, D, lds, nA, nB, primed);
    primed = nA != nullptr;
#pragma unroll
    for (int mi = 0; mi < 4; ++mi) {
      const int m = tm * 128 + 64 * wm + 16 * mi + l15;
#pragma unroll
      for (int ni = 0; ni < 4; ++ni) {
        const int n = tn * 128 + 64 * wn + 16 * ni + 4 * l4;
        float* op = p.out + (long)m * D + n;
        const f32x4 gt = *(const f32x4*)(gate + n);
        const f32x4 rs = *(const f32x4*)(op);
        *(f32x4*)(op) = rs + gt * acc[mi][ni];
      }
    }
  }
}


#define EPI_HEAD static constexpr bool PERM = false, AFTER_DRAIN = false;
typedef const f32x4 (&acc8_t)[2][2][4][2];
struct EpiSwiglu {
  EPI_HEAD
  bf16_t* H;
  __device__ __forceinline__ void operator()(acc8_t acc, const pg8::Unit& u, int wr, int wc, int fr, int fq) const {
#pragma unroll
    for (int ai = 0; ai < 2; ++ai)
#pragma unroll
      for (int m = 0; m < 4; ++m) {
        const int row = u.pm * 256 + ai * 128 + wr * 64 + m * 16 + fr;
#pragma unroll
        for (int n = 0; n < 2; ++n) {
          f32x4 o;
#pragma unroll
          for (int j = 0; j < 4; ++j) o[j] = silu_f(acc[ai][0][m][n][j]) * acc[ai][1][m][n][j];
          *(u32x2*)(H + (long)row * DFF + u.pn * 128 + wc * 32 + n * 16 + fq * 4) = pk4(o);
        }
      }
  }
};
struct EpiDown {
  EPI_HEAD
  const float* res; float* out; const float* gate;
  __device__ __forceinline__ void operator()(acc8_t acc, const pg8::Unit& u, int wr, int wc, int fr, int fq) const {
#pragma unroll
    for (int ai = 0; ai < 2; ++ai)
#pragma unroll
      for (int m = 0; m < 4; ++m) {
        const long ro = (long)(u.pm * 256 + ai * 128 + wr * 64 + m * 16 + fr) * D;
#pragma unroll
        for (int bj = 0; bj < 2; ++bj)
#pragma unroll
          for (int n = 0; n < 2; ++n) {
            const int col = u.pn * 256 + bj * 128 + wc * 32 + n * 16 + fq * 4;
            const f32x4 gt = *(const f32x4*)(gate + col);
            const f32x4 rs = *(const f32x4*)(res + ro + col);
            *(f32x4*)(out + ro + col) = rs + 0.5f * gt * acc[ai][bj][m][n];
          }
      }
  }
};
struct EpiPlain {
  EPI_HEAD
  bf16_t* C; int ldc;
  __device__ __forceinline__ void operator()(acc8_t acc, const pg8::Unit& u, int wr, int wc, int fr, int fq) const {
#pragma unroll
    for (int ai = 0; ai < 2; ++ai)
#pragma unroll
      for (int m = 0; m < 4; ++m) {
        const long ro = (long)(u.pm * 256 + ai * 128 + wr * 64 + m * 16 + fr) * ldc;
#pragma unroll
        for (int bj = 0; bj < 2; ++bj)
#pragma unroll
          for (int n = 0; n < 2; ++n) {
            const int col = u.pn * 256 + bj * 128 + wc * 32 + n * 16 + fq * 4;
            *(u32x2*)(C + ro + col) = pk4(acc[ai][bj][m][n]);
          }
      }
  }
};
struct EpiHyo {
  EPI_HEAD
  bf16_t* ro; const bf16_t* gates;
  __device__ __forceinline__ void operator()(acc8_t acc, const pg8::Unit& u, int wr, int wc, int fr, int fq) const {
#pragma unroll
    for (int ai = 0; ai < 2; ++ai)
#pragma unroll
      for (int m = 0; m < 4; ++m) {
        const long row = u.pm * 256 + ai * 128 + wr * 64 + m * 16 + fr;
#pragma unroll
        for (int bj = 0; bj < 2; ++bj)
#pragma unroll
          for (int n = 0; n < 2; ++n) {
            const int col = u.pn * 256 + bj * 128 + wc * 32 + n * 16 + fq * 4;
            const u32x2 r0 = *(const u32x2*)(ro + row * D + col);
            const u32x2 g0 = *(const u32x2*)(gates + row * 4096 + col);
            const u32x2 g1 = *(const u32x2*)(gates + row * 4096 + 2048 + col);
            const f32x4 a = acc[ai][bj][m][n];
            f32x4 o;
            o[0] = bf2f(g0.x & 0xffffu) * bf2f(r0.x & 0xffffu) + bf2f(g1.x & 0xffffu) * a[0];
            o[1] = bf2f(g0.x >> 16) * bf2f(r0.x >> 16) + bf2f(g1.x >> 16) * a[1];
            o[2] = bf2f(g0.y & 0xffffu) * bf2f(r0.y & 0xffffu) + bf2f(g1.y & 0xffffu) * a[2];
            o[3] = bf2f(g0.y >> 16) * bf2f(r0.y >> 16) + bf2f(g1.y >> 16) * a[3];
            *(u32x2*)(ro + row * D + col) = pk4(o);
          }
      }
  }
};
struct EpiWout {
  EPI_HEAD
  float* out; const float* gate;
  __device__ __forceinline__ void operator()(acc8_t acc, const pg8::Unit& u, int wr, int wc, int fr, int fq) const {
#pragma unroll
    for (int ai = 0; ai < 2; ++ai)
#pragma unroll
      for (int m = 0; m < 4; ++m) {
        const long ro = (long)(u.pm * 256 + ai * 128 + wr * 64 + m * 16 + fr) * D;
#pragma unroll
        for (int bj = 0; bj < 2; ++bj)
#pragma unroll
          for (int n = 0; n < 2; ++n) {
            const int col = u.pn * 256 + bj * 128 + wc * 32 + n * 16 + fq * 4;
            const f32x4 gt = *(const f32x4*)(gate + col);
            const f32x4 rs = *(const f32x4*)(out + ro + col);
            *(f32x4*)(out + ro + col) = rs + gt * acc[ai][bj][m][n];
          }
      }
  }
};
struct EpiWinA {
  EPI_HEAD
  bf16_t *q, *kk, *kTf, *kTb, *vT, *sg; const float2* rope; const float* lg;
  __device__ __forceinline__ void operator()(acc8_t acc, const pg8::Unit& u, int wr, int wc, int fr, int fq) const {
    const int pn = u.pn;
    if (pn < 8) {
      const bool isq = pn < 4;
      const int hh = wc >> 1, hf = wc & 1;
      const int head = 2 * (isq ? pn : pn - 4) + hh;
      const float scl = isq ? 0.08838834764831845f : 1.f;
      const float lgf = lg[head], lgb = lg[8 + head];
#pragma unroll
      for (int ai = 0; ai < 2; ++ai)
#pragma unroll
        for (int m = 0; m < 4; ++m) {
          const int t = u.pm * 256 + ai * 128 + wr * 64 + m * 16 + fr;
          const int pos = hf ? (t & 63) : (t >> 6);
          const int jc = t & 127;
          const float zf = __expf(lgf * (float)(127 - jc)), zb = __expf(lgb * (float)jc);
#pragma unroll
          for (int n = 0; n < 2; ++n) {
            const int i0 = 16 * n + 4 * fq;
            f32x4 o1, o2;
#pragma unroll
            for (int j = 0; j < 4; ++j) {
              const float2 cs = rope[pos * 32 + i0 + j];
              const float x1 = acc[ai][0][m][n][j] * scl, x2 = acc[ai][1][m][n][j] * scl;
              o1[j] = x1 * cs.x - x2 * cs.y;
              o2[j] = x1 * cs.y + x2 * cs.x;
            }
            const int cb = head * 128 + hf * 64 + i0;
            bf16_t* dp = (isq ? q : kk) + (long)t * 1024 + cb;
            *(u32x2*)(dp) = pk4(o1);
            *(u32x2*)(dp + 32) = pk4(o2);
            if (!isq) {
#pragma unroll
              for (int j = 0; j < 4; ++j) {
                kTf[(long)(cb + j) * TT + t] = f2bf(o1[j] * zf);
                kTb[(long)(cb + j) * TT + t] = f2bf(o1[j] * zb);
                kTf[(long)(cb + 32 + j) * TT + t] = f2bf(o2[j] * zf);
                kTb[(long)(cb + 32 + j) * TT + t] = f2bf(o2[j] * zb);
              }
            }
          }
        }
    } else if (pn < 16) {
#pragma unroll
      for (int ai = 0; ai < 2; ++ai)
#pragma unroll
        for (int m = 0; m < 4; ++m) {
          const int t = u.pm * 256 + ai * 128 + wr * 64 + m * 16 + fr;
#pragma unroll
          for (int bj = 0; bj < 2; ++bj)
#pragma unroll
            for (int n = 0; n < 2; ++n) {
              const int ch = (pn - 8) * 256 + bj * 128 + wc * 32 + n * 16 + fq * 4;
#pragma unroll
              for (int j = 0; j < 4; ++j) vT[(long)(ch + j) * TT + t] = f2bf(acc[ai][bj][m][n][j]);
            }
        }
    } else {
#pragma unroll
      for (int ai = 0; ai < 2; ++ai)
#pragma unroll
        for (int m = 0; m < 4; ++m) {
          const long t = u.pm * 256 + ai * 128 + wr * 64 + m * 16 + fr;
#pragma unroll
          for (int bj = 0; bj < 2; ++bj)
#pragma unroll
            for (int n = 0; n < 2; ++n) {
              const int col = (pn - 16) * 256 + bj * 128 + wc * 32 + n * 16 + fq * 4;
              f32x4 o;
#pragma unroll
              for (int j = 0; j < 4; ++j) o[j] = silu_f(acc[ai][bj][m][n][j]);
              *(u32x2*)(sg + t * D + col) = pk4(o);
            }
        }
    }
  }
};
struct EpiWinB {
  EPI_HEAD
  bf16_t *phy, *gates;
  __device__ __forceinline__ void operator()(acc8_t acc, const pg8::Unit& u, int wr, int wc, int fr, int fq) const {
    const int pn = u.pn;
#pragma unroll
    for (int ai = 0; ai < 2; ++ai)
#pragma unroll
      for (int m = 0; m < 4; ++m) {
        const long t = u.pm * 256 + ai * 128 + wr * 64 + m * 16 + fr;
#pragma unroll
        for (int bj = 0; bj < 2; ++bj)
#pragma unroll
          for (int n = 0; n < 2; ++n) {
            const int cl = bj * 128 + wc * 32 + n * 16 + fq * 4;
            if (pn < 48) {
              *(u32x2*)(phy + t * 6144 + (pn - 24) * 256 + cl) = pk4(acc[ai][bj][m][n]);
            } else {
              f32x4 o;
#pragma unroll
              for (int j = 0; j < 4; ++j) o[j] = sigm_f(acc[ai][bj][m][n][j]);
              *(u32x2*)(gates + t * 4096 + (pn - 48) * 256 + cl) = pk4(o);
            }
          }
      }
  }
};
template <class Epi>
__device__ __forceinline__ void big_gemm(char* lds_all, const bf16_t* A, const bf16_t* Bt, int K, int nM, int nN, int pn0, const Epi& E) {
  pg8::Gemm g;
  g.A = A; g.Bt = Bt; g.M = nM * 256; g.N = 0; g.K = K;
  pg8::TileOrder S;
  S.init(nM, nN, pn0, (int)gridDim.x, (int)blockIdx.x);
  pg8::gemm_phase(( __attribute__((address_space(3))) unsigned char*)lds_all, g, S, E);
}

__device__ __forceinline__ void ph_ctx_up(const Params& p, char* lds_all) {
  GEMM_IDS
  const int hv = fresh_tid() >> 8;
  bf16_t* lds = (bf16_t*)(lds_all + hv * LDS_HALF);
  u32x2* xch = (u32x2*)lds_all;
  const bf16_t* A = (const bf16_t*)(p.ws + OFF_AR) + (long)T * D;
  const bf16_t* Bt = (const bf16_t*)(p.ws + OFF_WBIG);
  bf16_t* H = (bf16_t*)(p.ws + OFF_H);
  for (int it = (int)blockIdx.x; it < 88; it += (int)gridDim.x) {
    const int tmc = it / 44, P = it % 44;
    f32x4 acc[4][4];
    acc_zero(acc);
    gemm_acc<true>(acc, A + (long)tmc * 128 * D, D, Bt + (long)(256 * P + 128 * hv) * D, D, D, lds);
    if (hv == 0) {
#pragma unroll
      for (int mi = 0; mi < 4; ++mi)
#pragma unroll
        for (int ni = 0; ni < 4; ++ni) {
          f32x4 o;
#pragma unroll
          for (int r = 0; r < 4; ++r) o[r] = silu_f(acc[mi][ni][r]);
          xch[(mi * 4 + ni) * 256 + TID] = pk4(o);
        }
    }
    __syncthreads();
    if (hv == 1) {
#pragma unroll
      for (int mi = 0; mi < 4; ++mi) {
        const int m = T + tmc * 128 + 64 * wm + 16 * mi + l15;
#pragma unroll
        for (int ni = 0; ni < 4; ++ni) {
          const int n = 128 * P + 64 * wn + 16 * ni + 4 * l4;
          const u32x2 w = xch[(mi * 4 + ni) * 256 + TID];
          f32x4 o;
          o[0] = bf2f(w.x & 0xffffu) * acc[mi][ni][0];
          o[1] = bf2f(w.x >> 16) * acc[mi][ni][1];
          o[2] = bf2f(w.y & 0xffffu) * acc[mi][ni][2];
          o[3] = bf2f(w.y >> 16) * acc[mi][ni][3];
          *(u32x2*)(H + (long)m * DFF + n) = pk4(o);
        }
      }
    }
  }
}
__device__ __forceinline__ void ph_ctx_down(const Params& p, bf16_t* lds) {
  GEMM_IDS
  const bf16_t* A = (const bf16_t*)(p.ws + OFF_H) + (long)T * DFF;
  const bf16_t* Bt = (const bf16_t*)(p.ws + OFF_WDOWN);
  const float* gate = (const float*)(p.ws + OFF_MODS) + NMOD + 2 * D;
  float* outc = (float*)(p.ws + OFF_CTX1);
  for (int it = BID; it < 128; it += GSZ) {
    const int ks = it & 3, tn = (it >> 2) & 15, tmc = it >> 6;
    f32x4 acc[4][4];
    acc_zero(acc);
    gemm_acc<true>(acc, A + (long)tmc * 128 * DFF + ks * 1408, DFF, Bt + (long)tn * 128 * DFF + ks * 1408, DFF, 1408, lds);
#pragma unroll
    for (int mi = 0; mi < 4; ++mi) {
      const int m = tmc * 128 + 64 * wm + 16 * mi + l15;
#pragma unroll
      for (int ni = 0; ni < 4; ++ni) {
        const int n = tn * 128 + 64 * wn + 16 * ni + 4 * l4;
        const f32x4 gt = *(const f32x4*)(gate + n);
#pragma unroll
        for (int r = 0; r < 4; ++r) atomicAdd(outc + (long)m * D + n + r, 0.5f * gt[r] * acc[mi][ni][r]);
      }
    }
  }
}
__device__ __forceinline__ void ph_ctx1_init(const Params& p) {
  f32x4* o = (f32x4*)(p.ws + OFF_CTX1);
  const f32x4* src = (const f32x4*)p.ctx;
  for (int i = BID * 256 + TID; i < 256 * D / 4; i += GSZ * 256) o[i] = src[i];
}
__device__ __forceinline__ void ph_ctx_win(const Params& p, char* lds_all) {
  GEMM_IDS
  const int hv = fresh_tid() >> 8;
  bf16_t* lds = (bf16_t*)(lds_all + hv * LDS_HALF);
  float* xacc = (float*)(lds_all + LDS_HALF);
  const bf16_t* A = (const bf16_t*)(p.ws + OFF_AR) + (long)T * D + hv * 1024;
  const bf16_t* Bt = (const bf16_t*)(p.ws + OFF_WBIG) + hv * 1024;
  bf16_t* kTf = (bf16_t*)(p.ws + OFF_KTF);
  bf16_t* kTb = (bf16_t*)(p.ws + OFF_KTB);
  bf16_t* vT = (bf16_t*)(p.ws + OFF_VT);
  for (int it = (int)blockIdx.x; it < 48; it += (int)gridDim.x) {
    f32x4 acc[4][4];
    acc_zero(acc);
    const bool isk = it < 16;
    const int u2 = it - 16;
    const int tmc = isk ? (it >> 3) : (u2 >> 4);
    const int kt8 = it & 7, tv = u2 & 15;
    if (isk)
      gemm_acc<true>(acc, A + (long)tmc * 128 * D, D, Bt + (long)(1024 + kt8 * 128) * D, D, 1024, lds);
    else
      gemm_acc<false>(acc, A + (long)tmc * 128 * D, D, Bt + (long)(2048 + tv * 128) * D, D, 1024, lds);
    if (hv == 1) {
#pragma unroll
      for (int mi = 0; mi < 4; ++mi)
#pragma unroll
        for (int ni = 0; ni < 4; ++ni) *(f32x4*)(xacc + ((mi * 4 + ni) * 256 + TID) * 4) = acc[mi][ni];
    }
    __syncthreads();
    if (hv == 0) {
#pragma unroll
      for (int mi = 0; mi < 4; ++mi)
#pragma unroll
        for (int ni = 0; ni < 4; ++ni) acc[mi][ni] += *(const f32x4*)(xacc + ((mi * 4 + ni) * 256 + TID) * 4);
      if (isk) {
        const int P = kt8 >> 1, sx = kt8 & 1;
        const int head = 2 * P + wn;
        const float lgf = p.lg[head], lgb = p.lg[8 + head];
#pragma unroll
        for (int mi = 0; mi < 4; ++mi) {
          const int m = T + tmc * 128 + 64 * wm + 16 * mi + l15;
          const int jc = m & 127;
          const float zf = __expf(lgf * (float)(127 - jc)), zb = __expf(lgb * (float)jc);
#pragma unroll
          for (int ni = 0; ni < 4; ++ni) {
            const int hf = ni >> 1, i0 = 16 * (ni & 1) + 4 * l4;
            const int cb = head * 128 + hf * 64 + i0 + 32 * sx;
#pragma unroll
            for (int r = 0; r < 4; ++r) {
              kTf[(long)(cb + r) * TT + m] = f2bf(acc[mi][ni][r] * zf);
              kTb[(long)(cb + r) * TT + m] = f2bf(acc[mi][ni][r] * zb);
            }
          }
        }
      } else {
#pragma unroll
        for (int mi = 0; mi < 4; ++mi) {
          const int m0 = T + tmc * 128 + 64 * wm + 16 * mi + 4 * l4;
#pragma unroll
          for (int ni = 0; ni < 4; ++ni) {
            const int ch = tv * 128 + 64 * wn + 16 * ni + l15;
            *(u32x2*)(vT + (long)ch * TT + m0) = pk4(acc[mi][ni]);
          }
        }
      }
    }
  }
}

#define XB_TMO      128
#define XB_XCNT(j)  (256  + 64 * (j))
#define XB_XSUB(j)  (1280 + 64 * (j))
#define XB_XGEN(j)  (2304 + 64 * (j))
#define XB_TOP      3328
#define XB_TOPGEN   3392
#define XCD_BAR_WORDS 3456
#define XB_SPIN_CAP (1u << 18)
#define LAS __attribute__((address_space(3)))

__device__ __forceinline__ unsigned xb_ld(unsigned* p)              { return __hip_atomic_load(p, __ATOMIC_RELAXED, __HIP_MEMORY_SCOPE_AGENT); }
__device__ __forceinline__ unsigned xb_add(unsigned* p, unsigned v) { return __hip_atomic_fetch_add(p, v, __ATOMIC_RELAXED, __HIP_MEMORY_SCOPE_AGENT); }
__device__ __forceinline__ unsigned xb_xcc_id() { return (unsigned)__builtin_amdgcn_s_getreg((3 << 11) | 20) & 0xFu; }
#define XB_SPIN(cond, bar) do { unsigned _sp = 0; while (cond) { __builtin_amdgcn_s_sleep(1); \
    if ((++_sp & 255u) == 0u) { if (xb_ld(&(bar)[XB_TMO])) break; if (_sp > XB_SPIN_CAP) { atomicAdd(&(bar)[XB_TMO], 1u); break; } } } } while (0)

struct XcdBarrier {
    unsigned* bar; unsigned x;
    volatile LAS unsigned* st;
};

__device__ __forceinline__ XcdBarrier xcd_barrier_post(unsigned* bar, volatile LAS unsigned* st) {
    XcdBarrier b; b.bar = bar; b.x = xb_xcc_id(); b.st = st;
    if (threadIdx.x == 0) (void)xb_add(&bar[XB_XCNT(b.x)], 1u);
    return b;
}
__device__ __forceinline__ void xcd_barrier_complete(unsigned* bar, unsigned x, unsigned& nloc, unsigned& nx) {
    const unsigned G = gridDim.x * gridDim.y * gridDim.z;
    unsigned sum, cnt, mine, sp = 0u;
    for (;;) {
        sum = 0u; cnt = 0u; mine = 0u;
#pragma unroll
        for (unsigned j = 0; j < 16; ++j) { const unsigned c = xb_ld(&bar[XB_XCNT(j)]); sum += c; cnt += (c > 0u) ? 1u : 0u; mine = (j == x) ? c : mine; }
        if (sum == G) break;
        __builtin_amdgcn_s_sleep(1);
        if ((++sp & 255u) == 0u) { if (xb_ld(&bar[XB_TMO])) break; if (sp > XB_SPIN_CAP) { atomicAdd(&bar[XB_TMO], 1u); break; } }
    }
    nloc = mine > 0u ? mine : 1u; nx = cnt > 0u ? cnt : 1u;
}

__device__ __forceinline__ void xcd_barrier(const XcdBarrier& b) {
    asm volatile("s_waitcnt vmcnt(0)" ::: "memory");
    __syncthreads();
    if (threadIdx.x == 0) {
        unsigned* bar = b.bar;
        __builtin_amdgcn_s_waitcnt(0);
        unsigned nloc = b.st[0], nx = b.st[1];
        if (nloc == 0u) { xcd_barrier_complete(bar, b.x, nloc, nx); b.st[0] = nloc; b.st[1] = nx; }
        const unsigned old = xb_add(&bar[XB_XSUB(b.x)], 1u);
        const unsigned gen = old / nloc;
        if (old + 1u == (gen + 1u) * nloc) {
            __builtin_amdgcn_fence(__ATOMIC_RELEASE, "agent");
            asm volatile("s_waitcnt vmcnt(0)" ::: "memory");
            const unsigned og = xb_add(&bar[XB_TOP], 1u);
            const unsigned tg = og / nx;
            if (og + 1u == (tg + 1u) * nx) xb_add(&bar[XB_TOPGEN], 1u);
            else XB_SPIN(xb_ld(&bar[XB_TOPGEN]) == tg, bar);
            __builtin_amdgcn_fence(__ATOMIC_ACQUIRE, "agent");
            xb_add(&bar[XB_XGEN(b.x)], 1u);
            asm volatile("s_waitcnt vmcnt(0)" ::: "memory");
        } else {
            XB_SPIN(xb_ld(&bar[XB_XGEN(b.x)]) == gen, bar);
            __builtin_amdgcn_fence(__ATOMIC_ACQUIRE, "agent");
            asm volatile("s_waitcnt vmcnt(0)" ::: "memory");
        }
    }
    __syncthreads();
}


__device__ __forceinline__ void gbar(unsigned* ctr, unsigned target) {
  asm volatile("s_waitcnt vmcnt(0) lgkmcnt(0)" ::: "memory");
  __syncthreads();
  if (threadIdx.x == 0) {
    __builtin_amdgcn_fence(__ATOMIC_RELEASE, "agent");
    asm volatile("s_waitcnt vmcnt(0)" ::: "memory");
    __hip_atomic_fetch_add(ctr, 1u, __ATOMIC_RELAXED, __HIP_MEMORY_SCOPE_AGENT);
    unsigned spins = 0;
    while (__hip_atomic_load(ctr, __ATOMIC_RELAXED, __HIP_MEMORY_SCOPE_AGENT) < target) {
      __builtin_amdgcn_s_sleep(2);
      if (++spins > (1u << 20)) break;
    }
    __builtin_amdgcn_fence(__ATOMIC_ACQUIRE, "agent");
    asm volatile("s_waitcnt vmcnt(0)" ::: "memory");
  }
  __syncthreads();
}
#ifndef SKIP_HY
#define SKIP_HY 0
#endif
#ifndef ONLY_NORM
#define ONLY_NORM 0
#endif
#ifndef SKIP_MIXER
#define SKIP_MIXER 0
#endif

__global__ void __launch_bounds__(512, 2) mega(Params p, int lo, int hi) {
  __shared__ __attribute__((aligned(1024))) char ldsc_all[LDS_BYTES];
#define ldsc (ldsc_all + (fresh_tid() >> 8) * LDS_HALF)
  cg::grid_group grid = cg::this_grid();
#define lds ((bf16_t*)ldsc)
#define ldsf ((float*)ldsc)
  char* ws = p.ws;
  volatile LAS unsigned* xb_st = (volatile LAS unsigned*)(ldsc_all + LDS_BYTES - 16);
  if (threadIdx.x == 0) { xb_st[0] = 0u; xb_st[1] = 0u; }
  __syncthreads();
  const XcdBarrier xb = xcd_barrier_post((unsigned*)(ws + OFF_BAR), xb_st);
#define PH(k, body) if (lo <= (k) && (k) < hi) { body; if ((k) + 1 < hi) xcd_barrier(xb); }
  if (lo < 0) grid.sync();
  PH(0, ph_mods_partial(p, ldsf))
  PH(2, ph_prenorm(p, p.x, p.ctx, TT, p.norm_g, 0);
        conv_weight(p.ffn_up, 2048, 11264, 11264, (bf16_t*)(ws + OFF_WBIG), 2, ldsf);
        conv_weight(p.ffn_down, 5632, 2048, 2048, (bf16_t*)(ws + OFF_WDOWN), 0, ldsf);
        conv_weight(p.w4, 64, 4096, 4096, (bf16_t*)(ws + OFF_W4T), 0, ldsf);
        conv_weight(p.w_ret_o, 2048, 2048, 2048, (bf16_t*)(ws + OFF_WRO), 0, ldsf);
        conv_weight(p.w_hy_o, 2048, 2048, 2048, (bf16_t*)(ws + OFF_WHO), 0, ldsf);
        conv_weight(p.w_out, 2048, 2048, 2048, (bf16_t*)(ws + OFF_WOUT), 0, ldsf);
        ph_misc0(p))
  PH(3, big_gemm(ldsc_all, (const bf16_t*)(ws + OFF_AR), (const bf16_t*)(ws + OFF_WBIG), 2048, 64, 44, 0, EpiSwiglu{(bf16_t*)(ws + OFF_H)});
        ph_ctx_up(p, ldsc_all); ph_ctx1_init(p))
  PH(4, big_gemm(ldsc_all, (const bf16_t*)(ws + OFF_H), (const bf16_t*)(ws + OFF_WDOWN), 5632, 64, 8, 0, EpiDown{p.x, p.out, (const float*)(ws + OFF_MODS) + 2 * D});
        ph_ctx_down(p, lds))
  PH(5, ph_prenorm(p, p.out, (const float*)(ws + OFF_CTX1), TT, p.norm_g + D, 1);
        conv_weight(p.w_in, 2048, 16384, 16384, (bf16_t*)(ws + OFF_WBIG), 3, ldsf))
#if !SKIP_MIXER
  PH(6, big_gemm(ldsc_all, (const bf16_t*)(ws + OFF_AR), (const bf16_t*)(ws + OFF_WBIG), 2048, 64, 24, 0,
                 EpiWinA{(bf16_t*)(ws + OFF_Q), (bf16_t*)(ws + OFF_K), (bf16_t*)(ws + OFF_KTF), (bf16_t*)(ws + OFF_KTB), (bf16_t*)(ws + OFF_VT), (bf16_t*)(ws + OFF_SG), (const float2*)(ws + OFF_ROPE), p.lg});
        ph_ctx_win(p, ldsc_all))
  PH(7, ph_ret_kv_p(p, lds))
  PH(8, ph_ret_scan(p))
  PH(9, ph_ret_out(p, ldsc_all))
  PH(11, big_gemm(ldsc_all, (const bf16_t*)(ws + OFF_Y), (const bf16_t*)(ws + OFF_WRO), 2048, 64, 8, 0, EpiPlain{(bf16_t*)(ws + OFF_RETOUT), D}))
  PH(12, big_gemm(ldsc_all, (const bf16_t*)(ws + OFF_AR), (const bf16_t*)(ws + OFF_WBIG), 2048, 64, 40, 24, EpiWinB{(bf16_t*)(ws + OFF_PHY), (bf16_t*)(ws + OFF_GATES)}))
#if !SKIP_HY
  PH(13, ph_hy_conv(p); ph_taps(p, 0, lds); ph_taps(p, 1, lds))
#endif
#if !SKIP_HY
  PH(15, ph_fft_a(p, 0, ldsc))
  PH(16, ph_fft_mid(p, ldsc_all))
  PH(17, ph_fft_c(p, 0, ldsc))
  PH(19, ph_fft_a(p, 1, ldsc))
  PH(20, ph_fft_mid(p, ldsc_all))
  PH(21, ph_fft_c(p, 1, ldsc))
#endif
  PH(26, big_gemm(ldsc_all, (const bf16_t*)(ws + OFF_X0), (const bf16_t*)(ws + OFF_WHO), 2048, 64, 8, 0, EpiHyo{(bf16_t*)(ws + OFF_RETOUT), (const bf16_t*)(ws + OFF_GATES)}))
  PH(27, big_gemm(ldsc_all, (const bf16_t*)(ws + OFF_RETOUT), (const bf16_t*)(ws + OFF_WOUT), 2048, 64, 8, 0, EpiWout{p.out, (const float*)(ws + OFF_MODS) + 5 * D}))
#endif
  PH(28, ph_prenorm(p, p.out, p.out, T, p.norm_g + 2 * D, 2);
         conv_weight(p.ffn_up + (long)2048 * 11264, 2048, 11264, 11264, (bf16_t*)(ws + OFF_WBIG), 2, ldsf);
         conv_weight(p.ffn_down + (long)5632 * 2048, 5632, 2048, 2048, (bf16_t*)(ws + OFF_WDOWN), 0, ldsf))
  PH(29, big_gemm(ldsc_all, (const bf16_t*)(ws + OFF_AR), (const bf16_t*)(ws + OFF_WBIG), 2048, 64, 44, 0, EpiSwiglu{(bf16_t*)(ws + OFF_H)}))
  PH(30, big_gemm(ldsc_all, (const bf16_t*)(ws + OFF_H), (const bf16_t*)(ws + OFF_WDOWN), 5632, 64, 8, 0, EpiDown{p.out, p.out, (const float*)(ws + OFF_MODS) + 8 * D}))
  PH(31, ph_final_norm(p))
}

extern "C" void kernel_launch(void* const* d_in, const int* in_sizes, int n_in, void* d_out, int out_size, void* d_ws,
                              size_t ws_size, hipStream_t stream) {
  if (ws_size < (size_t)WS_NEED || n_in < 29) {
    fprintf(stderr, "workspace too small: %zu\n", ws_size);
    return;
  }
  static int grid_blocks = 0;
  if (!grid_blocks) {
    int dev = 0, cus = 0, per_cu = 0;
    hipGetDevice(&dev);
    hipDeviceGetAttribute(&cus, hipDeviceAttributeMultiprocessorCount, dev);
    hipOccupancyMaxActiveBlocksPerMultiprocessor(&per_cu, mega, 512, 0);
    if (per_cu > 1) per_cu = 1;
    if (per_cu < 1) per_cu = 1;
    grid_blocks = cus * per_cu;
  }
  Params p{};
  const float** pp = (const float**)&p;
  for (int i = 0; i < 29; ++i) pp[i] = (const float*)d_in[i];
  p.out = (float*)d_out;
  p.ws = (char*)d_ws;
  hipMemsetAsync((char*)d_ws + OFF_BAR, 0, XCD_BAR_WORDS * 4, stream);
  hipMemsetAsync((char*)d_ws + OFF_MODS, 0, 2 * NMOD * 4, stream);
  int lo = 0, hi = NPH;
  void* args[] = {&p, &lo, &hi};
  hipError_t e = hipLaunchCooperativeKernel((void*)mega, dim3(grid_blocks), dim3(512), args, 0, stream);
  if (e != hipSuccess) fprintf(stderr, "cooperative launch failed: %s (grid %d)\n", hipGetErrorString(e), grid_blocks);
}
```
